# Optimizing an MI355X kernel written in HIP

```python
import math
import jax
import jax.numpy as jnp
from jax import lax
import numpy as np

D_MODEL = 2048
BATCH = 2
SEQ = 8192
DEPTH = 2

F32 = jnp.float32
HEAD_DIM = 64
GROUP_WIDTH = D_MODEL // 4
D_MIX = 4 * GROUP_WIDTH
CONV_WIDTH = 3
RWKV_HEADS = GROUP_WIDTH // HEAD_DIM
RWKV_DECAY_RANK = 96
RWKV_A_RANK = 96
RWKV_GATE_RANK = 128
RWKV_GN_EPS = 64e-5
ATT_HEADS = GROUP_WIDTH // HEAD_DIM
ATT_KV_HEADS = max(1, ATT_HEADS // 4)
WINDOW = 128
ATT_BLOCK = 128
N_BUCKETS = 32
NEG_INF = -1e30
S5_CH = 16
S5_GROUPS = GROUP_WIDTH // S5_CH
S5_STATE = 64
N_EXPERT_GROUPS = 4
EXPERTS_PER_GROUP = 8
N_EXPERTS = N_EXPERT_GROUPS * EXPERTS_PER_GROUP
TOP_K = 2
D_EXPERT = D_MODEL // 4
MOE_BLOCK = 128
ALPHA = (2 * DEPTH) ** 0.25
BETA = (8 * DEPTH) ** -0.25
LN_EPS = 1e-5
RW_OFF = 3 * GROUP_WIDTH
RW_COLS = 3 * GROUP_WIDTH + RWKV_DECAY_RANK + RWKV_A_RANK + RWKV_GATE_RANK
ATT_OFF = RW_OFF + RW_COLS
ATT_Q = ATT_HEADS * HEAD_DIM
ATT_KV = ATT_KV_HEADS * HEAD_DIM
S5_OFF = ATT_OFF + ATT_Q + 2 * ATT_KV
N_IN = S5_OFF + GROUP_WIDTH

kernel_name = 'hybrid_parallel_heads_hmoe_deepnorm'


def layer_norm(x, gain=None, bias=None, eps=LN_EPS):
    x32 = x.astype(F32)
    mean = jnp.mean(x32, axis=-1, keepdims=True)
    var = jnp.mean(jnp.square(x32 - mean), axis=-1, keepdims=True)
    y = (x32 - mean) * lax.rsqrt(var + eps)
    if gain is not None:
        y = y * gain.astype(F32) + bias.astype(F32)
    return y


def ada_input(x, shift, scale):
    return (layer_norm(x) * (1.0 + scale[:, None, :]) + shift[:, None, :]).astype(x.dtype)


def short_conv_mixer(b_gate, c_gate, h, conv_w):
    z = c_gate * h
    z = lax.conv_general_dilated(z, conv_w[:, None, :].astype(z.dtype), window_strides=(1,),
                                 padding=[(CONV_WIDTH - 1, 0)],
                                 dimension_numbers=('NWC', 'WIO', 'NWC'),
                                 feature_group_count=z.shape[-1])
    return b_gate * z


def wkv7_scan(r, decay, k, v, a_vec, b_vec):
    Bsz, _, H, N = r.shape

    def step(state, inp):
        r_t, w_t, k_t, v_t, a_t, b_t = inp
        sa = jnp.einsum('bhvk,bhk->bhv', state, a_t)
        state = (state * w_t[:, :, None, :] + v_t[..., :, None] * k_t[..., None, :]
                 + sa[..., :, None] * b_t[..., None, :])
        return state, jnp.einsum('bhvk,bhk->bhv', state, r_t)

    xs = tuple(jnp.swapaxes(t, 0, 1) for t in (r, decay, k, v, a_vec, b_vec))
    _, ys = lax.scan(step, jnp.zeros((Bsz, H, N, N), F32), xs)
    return jnp.swapaxes(ys, 0, 1)


def rwkv7_mixer(cols, mu, w0, w2, a0, a2, g2, k_k, k_a, r_k, gn_g, gn_b):
    Bsz, S, _ = cols.shape
    G = GROUP_WIDTH
    p = cols.astype(F32)
    p_prev = jnp.pad(p, ((0, 0), (1, 0), (0, 0)))[:, :-1]
    p = p + (p_prev - p) * mu.astype(F32)
    r, k, v = p[..., :G], p[..., G:2 * G], p[..., 2 * G:3 * G]
    o = 3 * G
    w_lo = p[..., o:o + RWKV_DECAY_RANK]
    o += RWKV_DECAY_RANK
    a_lo = p[..., o:o + RWKV_A_RANK]
    o += RWKV_A_RANK
    g_lo = p[..., o:o + RWKV_GATE_RANK]
    w = -jax.nn.softplus(-(w0 + jnp.tanh(w_lo) @ w2)) - 0.5
    decay = jnp.exp(-jnp.exp(w))
    a = jax.nn.sigmoid(a0 + a_lo @ a2)
    g = jax.nn.sigmoid(g_lo) @ g2

    def heads(t):
        return t.reshape(Bsz, S, RWKV_HEADS, HEAD_DIM)

    kk = heads(k * k_k)
    kk = kk / jnp.maximum(jnp.sqrt(jnp.sum(kk * kk, axis=-1, keepdims=True)), 1e-12)
    k = k * (1.0 + (a - 1.0) * k_a)
    rh, kh, vh = heads(r), heads(k), heads(v)
    y = wkv7_scan(rh, heads(decay), kh, vh, -kk, kk * heads(a))
    mean = jnp.mean(y, axis=-1, keepdims=True)
    var = jnp.mean(jnp.square(y - mean), axis=-1, keepdims=True)
    y = ((y - mean) * lax.rsqrt(var + RWKV_GN_EPS)).reshape(Bsz, S, G) * gn_g + gn_b
    bonus = jnp.sum(rh * kh * r_k, axis=-1, keepdims=True) * vh
    return (y + bonus.reshape(Bsz, S, G)) * g


def t5_bucket(rel):
    n = jnp.maximum(rel, 0)
    max_exact = N_BUCKETS // 2
    n_f = jnp.maximum(n, 1).astype(F32)
    large = max_exact + (jnp.log(n_f / max_exact) / math.log(WINDOW / max_exact)
                         * (N_BUCKETS - max_exact)).astype(jnp.int32)
    return jnp.where(n < max_exact, n, jnp.minimum(large, N_BUCKETS - 1))


def swa_sink_attention(q, k, v, sinks, rel_bias):
    Bsz, S, _ = q.shape
    nb = S // ATT_BLOCK
    rep = ATT_HEADS // ATT_KV_HEADS
    qb = q.astype(F32).reshape(Bsz, nb, ATT_BLOCK, ATT_KV_HEADS, rep, HEAD_DIM)

    def with_prev(t):
        t = t.astype(F32).reshape(Bsz, nb, ATT_BLOCK, ATT_KV_HEADS, HEAD_DIM)
        prev = jnp.concatenate([jnp.zeros_like(t[:, :1]), t[:, :-1]], axis=1)
        return jnp.concatenate([prev, t], axis=2)

    kw, vw = with_prev(k), with_prev(v)
    scores = jnp.einsum('bnqgrd,bnkgd->bngrqk', qb, kw) * (HEAD_DIM ** -0.5)
    qi = jnp.arange(ATT_BLOCK)[:, None]
    kj = jnp.arange(2 * ATT_BLOCK)[None, :]
    rel = qi + ATT_BLOCK - kj
    bias = rel_bias.astype(F32)[t5_bucket(rel)]
    bias = jnp.transpose(bias, (2, 0, 1)).reshape(ATT_KV_HEADS, rep, ATT_BLOCK, 2 * ATT_BLOCK)
    key_pos = jnp.arange(nb)[:, None] * ATT_BLOCK + kj - ATT_BLOCK
    valid = ((rel >= 0) & (rel < WINDOW))[None] & (key_pos >= 0)[:, None, :]
    scores = jnp.where(valid[None, :, None, None], scores + bias, NEG_INF)
    sink = jnp.broadcast_to(sinks.astype(F32).reshape(1, 1, ATT_KV_HEADS, rep, 1, 1),
                            scores.shape[:-1] + (1,))
    probs = jax.nn.softmax(jnp.concatenate([scores, sink], axis=-1), axis=-1)[..., :-1]
    out = jnp.einsum('bngrqk,bnkgd->bnqgrd', probs, vw)
    return out.reshape(Bsz, S, ATT_Q)


def s5_mixer(u, lam_re, lam_im, log_dt, b_re, b_im, c_re, c_im, d_skip, glu_w, glu_b):
    Bsz, S, _ = u.shape
    u32 = u.astype(F32).reshape(Bsz, S, S5_GROUPS, S5_CH)
    lr, li = lam_re.astype(F32), lam_im.astype(F32)
    delta = jnp.exp(log_dt.astype(F32))[:, None]
    mag = jnp.exp(lr * delta)
    ab_re, ab_im = mag * jnp.cos(li * delta), mag * jnp.sin(li * delta)
    den = lr * lr + li * li
    z_re = ((ab_re - 1.0) * lr + ab_im * li) / den
    z_im = (ab_im * lr - (ab_re - 1.0) * li) / den
    br, bi = b_re.astype(F32), b_im.astype(F32)
    bb_re = z_re[..., None] * br - z_im[..., None] * bi
    bb_im = z_re[..., None] * bi + z_im[..., None] * br
    bu_re = jnp.einsum('gpc,bsgc->bsgp', bb_re, u32)
    bu_im = jnp.einsum('gpc,bsgc->bsgp', bb_im, u32)
    a_re = jnp.broadcast_to(ab_re, (1, S) + ab_re.shape)
    a_im = jnp.broadcast_to(ab_im, (1, S) + ab_im.shape)

    def combine(e1, e2):
        a1r, a1i, b1r, b1i = e1
        a2r, a2i, b2r, b2i = e2
        return (a2r * a1r - a2i * a1i, a2r * a1i + a2i * a1r,
                a2r * b1r - a2i * b1i + b2r, a2r * b1i + a2i * b1r + b2i)

    _, _, xr, xi = lax.associative_scan(combine, (a_re, a_im, bu_re, bu_im), axis=1)
    y = (jnp.einsum('gcp,bsgp->bsgc', c_re.astype(F32), xr)
         - jnp.einsum('gcp,bsgp->bsgc', c_im.astype(F32), xi)
         + d_skip.astype(F32) * u32)
    y = jax.nn.gelu(y.reshape(Bsz, S, GROUP_WIDTH))
    return y * jax.nn.sigmoid(y @ glu_w.astype(F32) + glu_b.astype(F32))


def hierarchical_moe(h, wg, bg, we, be, w1, w3, w2):
    Bsz, S, D = h.shape
    T = Bsz * S
    ht = h.reshape(T, D)
    h32 = ht.astype(F32)
    g_probs = jax.nn.softmax(h32 @ wg.astype(F32) + bg.astype(F32), axis=-1)
    g_val, g_idx = lax.top_k(g_probs, 1)
    e_logits = (h32 @ we.astype(F32) + be.astype(F32)).reshape(T, N_EXPERT_GROUPS, EXPERTS_PER_GROUP)
    e_logits = jnp.take_along_axis(e_logits, g_idx[:, :, None], axis=1)[:, 0]
    e_val, e_idx = lax.top_k(e_logits, TOP_K)
    weights = jax.nn.softmax(e_val, axis=-1) * g_val
    expert_id = g_idx * EXPERTS_PER_GROUP + e_idx
    n_assign = T * TOP_K
    n_rows = ((n_assign + N_EXPERTS * (MOE_BLOCK - 1) + MOE_BLOCK - 1) // MOE_BLOCK) * MOE_BLOCK
    n_blocks = n_rows // MOE_BLOCK
    flat_e = expert_id.reshape(n_assign)
    flat_tok = jnp.repeat(jnp.arange(T, dtype=jnp.int32), TOP_K)
    order = jnp.argsort(flat_e)
    se, stok, sw = flat_e[order], flat_tok[order], weights.reshape(n_assign)[order]
    counts = jnp.bincount(flat_e, length=N_EXPERTS)
    padded = ((counts + MOE_BLOCK - 1) // MOE_BLOCK) * MOE_BLOCK
    pad_end = jnp.cumsum(padded)
    pad_start = pad_end - padded
    raw_start = jnp.cumsum(counts) - counts
    dest = pad_start[se] + (jnp.arange(n_assign) - raw_start[se])
    row_tok = jnp.zeros((n_rows,), jnp.int32).at[dest].set(stok)
    block_expert = jnp.minimum(
        jnp.searchsorted(pad_end, jnp.arange(n_blocks) * MOE_BLOCK, side='right'), N_EXPERTS - 1)
    xb = ht[row_tok].reshape(n_blocks, MOE_BLOCK, D)

    def expert_block(args):
        xblk, e = args
        return (jax.nn.silu(xblk @ w1[e]) * (xblk @ w3[e])) @ w2[e]

    yr = lax.map(expert_block, (xb, block_expert)).reshape(n_rows, D)
    ya = yr[dest].astype(F32) * sw[:, None]
    return jax.ops.segment_sum(ya, stok, num_segments=T).reshape(Bsz, S, D)


def setup_inputs(seed: int = 0) -> dict:
    key = jax.random.key(seed)
    keys = jax.random.split(key, 48)
    counter = [0]

    def nxt():
        k = keys[counter[0]]
        counter[0] += 1
        return k

    def nrm(shape, scale):
        return jax.random.normal(nxt(), shape, F32) * scale

    def unif(shape, lo, hi):
        return jax.random.uniform(nxt(), shape, F32, lo, hi)

    L, D, G = DEPTH, D_MODEL, GROUP_WIDTH
    col_scale = np.ones((N_IN,), np.float32)
    col_scale[RW_OFF + 2 * G:RW_OFF + 3 * G] = BETA
    col_scale[ATT_OFF + ATT_Q + ATT_KV:ATT_OFF + ATT_Q + 2 * ATT_KV] = BETA
    return {
        'x': nrm((BATCH, SEQ, D), 1.0),
        'c': nrm((BATCH, D), 1.0),
        'w_ada': nrm((L, D, 6 * D), 0.2 * D ** -0.5),
        'b_ada': nrm((L, 6 * D), 0.02),
        'ln_g': 1.0 + nrm((L, 2, D), 0.02),
        'ln_b': nrm((L, 2, D), 0.02),
        'w_in': nrm((L, D, N_IN), D ** -0.5) * jnp.asarray(col_scale),
        'w_out': nrm((L, D_MIX, D), BETA * D_MIX ** -0.5),
        'conv_w': nrm((L, CONV_WIDTH, G), CONV_WIDTH ** -0.5),
        'rwkv_mu': unif((L, RW_COLS), 0.0, 1.0),
        'rwkv_w0': jnp.linspace(-6.0, -1.0, G, dtype=F32)[None] + nrm((L, G), 0.1),
        'rwkv_w2': nrm((L, RWKV_DECAY_RANK, G), 0.1 * RWKV_DECAY_RANK ** -0.5),
        'rwkv_a0': nrm((L, G), 0.1),
        'rwkv_a2': nrm((L, RWKV_A_RANK, G), 0.5 * RWKV_A_RANK ** -0.5),
        'rwkv_g2': nrm((L, RWKV_GATE_RANK, G), RWKV_GATE_RANK ** -0.5),
        'rwkv_kk': 0.85 + nrm((L, G), 0.02),
        'rwkv_ka': 1.0 + nrm((L, G), 0.02),
        'rwkv_rk': -0.04 + nrm((L, RWKV_HEADS, HEAD_DIM), 0.02),
        'rwkv_gn_g': 1.0 + nrm((L, G), 0.02),
        'rwkv_gn_b': nrm((L, G), 0.02),
        'attn_sinks': nrm((L, ATT_HEADS), 0.5),
        'rel_bias': nrm((N_BUCKETS, ATT_HEADS), 0.5),
        's5_lambda_re': -0.5 + nrm((L, S5_GROUPS, S5_STATE), 0.01),
        's5_lambda_im': math.pi * jnp.arange(S5_STATE, dtype=F32)[None, None] + nrm((L, S5_GROUPS, S5_STATE), 0.01),
        's5_log_dt': unif((L, S5_GROUPS), math.log(1e-3), math.log(1e-1)),
        's5_b_re': nrm((L, S5_GROUPS, S5_STATE, S5_CH), (2 * S5_CH) ** -0.5),
        's5_b_im': nrm((L, S5_GROUPS, S5_STATE, S5_CH), (2 * S5_CH) ** -0.5),
        's5_c_re': nrm((L, S5_GROUPS, S5_CH, S5_STATE), S5_STATE ** -0.5),
        's5_c_im': nrm((L, S5_GROUPS, S5_CH, S5_STATE), S5_STATE ** -0.5),
        's5_d': nrm((L, S5_GROUPS, S5_CH), 0.5),
        's5_glu_w': nrm((L, G, G), G ** -0.5),
        's5_glu_b': nrm((L, G), 0.02),
        'router_group_w': nrm((L, D, N_EXPERT_GROUPS), D ** -0.5),
        'router_group_b': nrm((L, N_EXPERT_GROUPS), 0.01),
        'router_expert_w': nrm((L, D, N_EXPERTS), D ** -0.5),
        'router_expert_b': nrm((L, N_EXPERTS), 0.01),
        'moe_w1': nrm((L, N_EXPERTS, D, D_EXPERT), BETA * D ** -0.5),
        'moe_w3': nrm((L, N_EXPERTS, D, D_EXPERT), BETA * D ** -0.5),
        'moe_w2': nrm((L, N_EXPERTS, D_EXPERT, D), BETA * D_EXPERT ** -0.5),
    }


def reference(x, c, w_ada, b_ada, ln_g, ln_b, w_in, w_out, conv_w, rwkv_mu, rwkv_w0, rwkv_w2,
              rwkv_a0, rwkv_a2, rwkv_g2, rwkv_kk, rwkv_ka, rwkv_rk, rwkv_gn_g, rwkv_gn_b,
              attn_sinks, rel_bias, s5_lambda_re, s5_lambda_im, s5_log_dt, s5_b_re, s5_b_im,
              s5_c_re, s5_c_im, s5_d, s5_glu_w, s5_glu_b, router_group_w, router_group_b,
              router_expert_w, router_expert_b, moe_w1, moe_w3, moe_w2):
    dt = x.dtype
    G = GROUP_WIDTH
    for l in range(DEPTH):
        mod = (jax.nn.silu(c) @ w_ada[l] + b_ada[l]).astype(F32)
        sh1, sc1, gt1, sh2, sc2, gt2 = jnp.split(mod, 6, axis=-1)
        h = ada_input(x, sh1, sc1)
        p = h @ w_in[l]
        y_conv = short_conv_mixer(p[..., 0:G], p[..., G:2 * G], p[..., 2 * G:3 * G], conv_w[l])
        y_rwkv = rwkv7_mixer(p[..., RW_OFF:ATT_OFF], rwkv_mu[l], rwkv_w0[l], rwkv_w2[l],
                             rwkv_a0[l], rwkv_a2[l], rwkv_g2[l], rwkv_kk[l], rwkv_ka[l],
                             rwkv_rk[l], rwkv_gn_g[l], rwkv_gn_b[l])
        y_att = swa_sink_attention(p[..., ATT_OFF:ATT_OFF + ATT_Q],
                                   p[..., ATT_OFF + ATT_Q:ATT_OFF + ATT_Q + ATT_KV],
                                   p[..., ATT_OFF + ATT_Q + ATT_KV:S5_OFF],
                                   attn_sinks[l], rel_bias)
        y_ssm = s5_mixer(p[..., S5_OFF:N_IN], s5_lambda_re[l], s5_lambda_im[l], s5_log_dt[l],
                         s5_b_re[l], s5_b_im[l], s5_c_re[l], s5_c_im[l], s5_d[l],
                         s5_glu_w[l], s5_glu_b[l])
        y_mix = jnp.concatenate([t.astype(dt) for t in (y_conv, y_rwkv, y_att, y_ssm)], axis=-1) @ w_out[l]
        x = layer_norm(ALPHA * x.astype(F32) + (1.0 + gt1)[:, None, :] * y_mix.astype(F32),
                       ln_g[l, 0], ln_b[l, 0]).astype(dt)
        h = ada_input(x, sh2, sc2)
        y_moe = hierarchical_moe(h, router_group_w[l], router_group_b[l], router_expert_w[l],
                                 router_expert_b[l], moe_w1[l], moe_w3[l], moe_w2[l])
        x = layer_norm(ALPHA * x.astype(F32) + (1.0 + gt2)[:, None, :] * y_moe.astype(F32),
                       ln_g[l, 1], ln_b[l, 1]).astype(dt)
    return x
```

```cpp
#include <hip/hip_runtime.h>
#include <cstdio>
#include <cstdint>
namespace pg8 {
#define PG8_LAS __attribute__((address_space(3)))
typedef unsigned short bf16_t;
typedef short bf16x8 __attribute__((ext_vector_type(8)));
typedef float f32x4 __attribute__((ext_vector_type(4)));
typedef unsigned u32x4 __attribute__((ext_vector_type(4)));
constexpr int BM = 256, BK = 64, HALF = 128, HTB = HALF * BK * 2  , STAGE_BYTES = 8 * HTB, NXCD = 8, WGM = 8;

__host__ __device__ __forceinline__ int lds_byte(int r, int c) { const int st = (r >> 4) * 2 + (c >> 5), rr = r & 15, cc = c & 31, ob = rr * 64 + cc * 2; return st * 1024 + (ob ^ (((ob >> 9) & 1) << 5)); }
__host__ __device__ __forceinline__ void stage_rc(int b, int& R, int& C) { const int st = b / 1024, sb = b % 1024, swz = sb ^ (((sb >> 9) & 1) << 5); R = (st >> 1) * 16 + swz / 64; C = (st & 1) * 32 + (swz % 64) / 2; }
__host__ __device__ __forceinline__ int perm32(int rho) { const int n = rho >> 4, i = rho & 15; return 8 * (i >> 2) + 4 * n + (i & 3); }


struct Unit { int pm, pn, po; };
struct Gemm { const bf16_t* A; const bf16_t* Bt; int K; };

struct StaticOrder {
    int nM, nN, nwg, G, c;
    __device__ void init(int M, int N, int G_, int c_) { nM = M / BM; nN = N / BM; nwg = nM * nN; G = G_; c = c_; }
    __device__ bool next(int i, Unit& u) const {
        const long L = (long)i * G + c; if (L >= nwg) return false;
        int wgid = (int)L; { const int q = nwg / NXCD, r = nwg % NXCD, xcd = wgid % NXCD, off = wgid / NXCD; wgid = (xcd < r ? xcd * (q + 1) : r * (q + 1) + (xcd - r) * q) + off; }
        const int nig = WGM * nN, gid = wgid / nig, fm = gid * WGM, gsz = (nM - fm) < WGM ? (nM - fm) : WGM;
        u.pm = fm + ((wgid % nig) % gsz); u.pn = (wgid % nig) / gsz; u.po = u.pn; return true;
    }
    __device__ __forceinline__ void a_ready(const Unit&) const {}
    __device__ __forceinline__ void done(const Unit&) const {}
};
struct GroupedOrder {
    int ntiles, npn, G, c; const int* tile_e;
    __device__ bool next(int i, Unit& u) const {
        const int idx = c >> 3, pn = idx % npn, rpx = (G >> 3) / npn, t = (i * 8 + (c & 7)) * rpx + idx / npn; if (t >= ntiles) return false;
        u.pm = t; u.po = pn; u.pn = tile_e[t] * npn + pn; return true;
    }
    __device__ __forceinline__ void a_ready(const Unit&) const {}
    __device__ __forceinline__ void done(const Unit&) const {}
};
__device__ __forceinline__ unsigned cvt_pk_bf16(float lo, float hi) { unsigned r; asm volatile("s_nop 0\n\tv_cvt_pk_bf16_f32 %0, %1, %2" : "=v"(r) : "v"(lo), "v"(hi)); return r; }
template <class Epi, class Sched, bool ALIGN_EPI = false, bool SP2 = false>
__device__ __forceinline__ void gemm_phase(PG8_LAS unsigned char* lds, const Gemm g, const Sched& S, const Epi& E, int wv) {
    int tid_ = (wv << 6) | (int)__builtin_amdgcn_mbcnt_hi(~0u, __builtin_amdgcn_mbcnt_lo(~0u, 0u)); asm volatile("" : "+v"(tid_));
    const int tid = tid_, wid = __builtin_amdgcn_readfirstlane(tid >> 6), lane = tid & 63, wr = wid >> 2, wc = wid & 3, fr = lane & 15, fq = lane >> 4;
    const int K = g.K, nt = K / BK;
    unsigned voffA[2], voffB[2];
#pragma unroll
    for (int i = 0; i < 2; ++i) { int R, C; stage_rc(tid * 16 + i * 8192, R, C); const int Rb = Epi::PERM ? ((R & ~31) + perm32(R & 31)) : R;
        voffA[i] = (unsigned)(R * K + C) * 2u; voffB[i] = (unsigned)(Rb * K + C) * 2u; }
    const size_t kstep = (size_t)(BK * 2);
    const size_t hstep = (size_t)HALF * K * 2;
    const size_t tstep = 2 * hstep;
    const unsigned ldsw = (unsigned)wid * 1024u;
    const int aoff = lds_byte(wr * 64 + fr, fq * 8), boff = lds_byte(wc * 32 + fr, fq * 8);
#define PG8_SA(b, h) (((b) * 2 + (h)) * HTB)
#define PG8_SB(b, h) ((4 + (b) * 2 + (h)) * HTB)
#define PG8_STAGE(bufoff, gbase, voff) do { _Pragma("unroll") for (int _i = 0; _i < 2; ++_i) \
        __builtin_amdgcn_global_load_lds((const unsigned*)((const char*)(gbase) + (voff)[_i]), (PG8_LAS unsigned*)(lds + (bufoff) + ldsw + _i * 8192), 16, 0, 0); } while (0)
#define PG8_LDA(dst, b, h) do { _Pragma("unroll") for (int m = 0; m < 4; ++m) _Pragma("unroll") for (int k = 0; k < 2; ++k) dst[m][k] = *(const PG8_LAS bf16x8*)(lds + PG8_SA(b, h) + aoff + m * 2048 + k * 1024); } while (0)
#define PG8_LDB(dst, b, h) do { _Pragma("unroll") for (int n = 0; n < 2; ++n) _Pragma("unroll") for (int k = 0; k < 2; ++k) dst[n][k] = *(const PG8_LAS bf16x8*)(lds + PG8_SB(b, h) + boff + n * 2048 + k * 1024); } while (0)
#define PG8_MMA(ai, bj, At, Bt) do { __builtin_amdgcn_s_setprio(1); _Pragma("unroll") for (int m = 0; m < 4; ++m) _Pragma("unroll") for (int n = 0; n < 2; ++n) _Pragma("unroll") for (int k = 0; k < 2; ++k) \
        acc[ai][bj][m][n] = __builtin_amdgcn_mfma_f32_16x16x32_bf16(Bt[n][k], At[m][k], acc[ai][bj][m][n], 0, 0, 0); __builtin_amdgcn_s_setprio(0); } while (0)
#define PG8_WAIT_V(n) asm volatile("s_waitcnt vmcnt(" #n ")" ::: "memory")
#define PG8_WAIT_L(n) asm volatile("s_waitcnt lgkmcnt(" #n ")" ::: "memory")
#define PG8_BAR __builtin_amdgcn_s_barrier()
#define PG8_SCHED __builtin_amdgcn_sched_barrier(0)
    Unit cur, nxt; int ui = 0;
    if (!S.next(0, cur)) return;
    f32x4 acc[2][2][4][2];
#pragma unroll
    for (int a = 0; a < 2; ++a)
#pragma unroll
        for (int b = 0; b < 2; ++b)
#pragma unroll
            for (int m = 0; m < 4; ++m)
#pragma unroll
                for (int n = 0; n < 2; ++n) acc[a][b][m][n] = (f32x4){0.f, 0.f, 0.f, 0.f};
    bf16x8 At[4][2], B0[2][2], B1[2][2];
    const char* cA = (const char*)g.A + (size_t)cur.pm * tstep; const char* cB = (const char*)g.Bt + (size_t)cur.pn * tstep;
    S.a_ready(cur);
    if constexpr (SP2) {
        PG8_STAGE(PG8_SB(0, 0), cB, voffB); PG8_STAGE(PG8_SB(0, 1), cB + hstep, voffB); PG8_STAGE(PG8_SA(0, 0), cA, voffA); PG8_STAGE(PG8_SA(0, 1), cA + hstep, voffA);
        if (wr == 1) PG8_BAR;
        PG8_WAIT_V(2); PG8_BAR;
        PG8_STAGE(PG8_SB(1, 0), cB + kstep, voffB); PG8_STAGE(PG8_SA(1, 0), cA + kstep, voffA); PG8_STAGE(PG8_SB(1, 1), cB + hstep + kstep, voffB);
        PG8_WAIT_V(6); PG8_BAR;
    } else {
        PG8_STAGE(PG8_SB(0, 0), cB, voffB); PG8_STAGE(PG8_SA(0, 0), cA, voffA); PG8_STAGE(PG8_SB(0, 1), cB + hstep, voffB); PG8_STAGE(PG8_SA(0, 1), cA + hstep, voffA);
        if (wr == 1) PG8_BAR;
        PG8_WAIT_V(4); PG8_BAR;
        PG8_STAGE(PG8_SB(1, 0), cB + kstep, voffB); PG8_STAGE(PG8_SA(1, 0), cA + kstep, voffA); PG8_STAGE(PG8_SB(1, 1), cB + hstep + kstep, voffB);
        PG8_WAIT_V(6); PG8_BAR;
    }
    for (;;) {
        const bool has_next = S.next(ui + 1, nxt);
        const char* nA = has_next ? (const char*)g.A + (size_t)nxt.pm * tstep : cA; const char* nB = has_next ? (const char*)g.Bt + (size_t)nxt.pn * tstep : cB;
        for (int t = 0; t < nt; t += 2) {
            const bool last = (t == nt - 2);
            const char* a1 = cA + (size_t)(t + 1) * kstep;
            const char* a2 = last ? nA : cA + (size_t)(t + 2) * kstep; const char* b2 = last ? nB : cB + (size_t)(t + 2) * kstep;
            const char* a3 = a2 + kstep; const char* b3 = b2 + kstep;
            if (last && has_next) S.a_ready(nxt);
            if constexpr (SP2) {
            PG8_LDB(B0, 0, 0); PG8_LDB(B1, 0, 1); PG8_SCHED; PG8_LDA(At, 0, 0); PG8_STAGE(PG8_SA(1, 1), a1 + hstep, voffA);
            PG8_WAIT_V(8); PG8_WAIT_L(0); PG8_BAR; PG8_MMA(0, 0, At, B0); PG8_MMA(0, 1, At, B1); PG8_BAR; PG8_SCHED;
            PG8_LDA(At, 0, 1); PG8_STAGE(PG8_SB(0, 0), b2, voffB); PG8_STAGE(PG8_SB(0, 1), b2 + hstep, voffB); PG8_STAGE(PG8_SA(0, 0), a2, voffA);
            PG8_WAIT_V(8); PG8_WAIT_L(0); PG8_BAR; PG8_MMA(1, 0, At, B0); PG8_MMA(1, 1, At, B1); PG8_BAR; PG8_SCHED;
            PG8_LDB(B0, 1, 0); PG8_LDB(B1, 1, 1); PG8_SCHED; PG8_LDA(At, 1, 0); PG8_STAGE(PG8_SA(0, 1), a2 + hstep, voffA);
            PG8_WAIT_V(8); PG8_WAIT_L(0); PG8_BAR; PG8_MMA(0, 0, At, B0); PG8_MMA(0, 1, At, B1); PG8_BAR; PG8_SCHED;
            PG8_LDA(At, 1, 1); PG8_STAGE(PG8_SB(1, 0), b3, voffB); PG8_STAGE(PG8_SB(1, 1), b3 + hstep, voffB); PG8_STAGE(PG8_SA(1, 0), a3, voffA);
            PG8_WAIT_V(8); PG8_WAIT_L(0); PG8_BAR; PG8_MMA(1, 0, At, B0); PG8_MMA(1, 1, At, B1); PG8_BAR; PG8_SCHED;
            } else {
            PG8_LDB(B0, 0, 0); PG8_SCHED; PG8_LDA(At, 0, 0); PG8_STAGE(PG8_SA(1, 1), a1 + hstep, voffA);
            PG8_WAIT_L(8); PG8_BAR; PG8_WAIT_L(0); PG8_MMA(0, 0, At, B0); PG8_BAR; PG8_SCHED;
            PG8_LDB(B1, 0, 1); PG8_STAGE(PG8_SB(0, 0), b2, voffB);
            PG8_BAR; PG8_WAIT_L(0); PG8_MMA(0, 1, At, B1); PG8_BAR;
            PG8_LDA(At, 0, 1); PG8_STAGE(PG8_SA(0, 0), a2, voffA);
            PG8_BAR; PG8_WAIT_L(0); PG8_MMA(1, 0, At, B0); PG8_BAR; PG8_SCHED;
            PG8_STAGE(PG8_SB(0, 1), b2 + hstep, voffB);
            PG8_WAIT_V(6); PG8_BAR; PG8_MMA(1, 1, At, B1); PG8_BAR;
            PG8_LDB(B0, 1, 0); PG8_SCHED; PG8_LDA(At, 1, 0); PG8_STAGE(PG8_SA(0, 1), a2 + hstep, voffA);
            PG8_WAIT_L(8); PG8_BAR; PG8_WAIT_L(0); PG8_MMA(0, 0, At, B0); PG8_BAR; PG8_SCHED;
            PG8_LDB(B1, 1, 1); PG8_STAGE(PG8_SB(1, 0), b3, voffB);
            PG8_BAR; PG8_WAIT_L(0); PG8_MMA(0, 1, At, B1); PG8_BAR;
            PG8_LDA(At, 1, 1); PG8_STAGE(PG8_SA(1, 0), a3, voffA);
            PG8_BAR; PG8_WAIT_L(0); PG8_MMA(1, 0, At, B0); PG8_BAR; PG8_SCHED;
            PG8_STAGE(PG8_SB(1, 1), b3 + hstep, voffB);
            PG8_WAIT_V(6); PG8_BAR; PG8_MMA(1, 1, At, B1); PG8_BAR;
            }
        }
        if constexpr (ALIGN_EPI) { if (wr == 0) PG8_BAR; }
        if constexpr (!Epi::AFTER_DRAIN) { E(acc, cur, wr, wc, fr, fq); S.done(cur); }
        if (!has_next) break;
#pragma unroll
        for (int a = 0; a < 2; ++a)
#pragma unroll
            for (int b = 0; b < 2; ++b)
#pragma unroll
                for (int m = 0; m < 4; ++m)
#pragma unroll
                    for (int n = 0; n < 2; ++n) acc[a][b][m][n] = (f32x4){0.f, 0.f, 0.f, 0.f};
        cur = nxt; cA = nA; cB = nB; ++ui;
        if constexpr (ALIGN_EPI) { if (wr == 1) PG8_BAR; }
    }
    PG8_WAIT_V(0);
    if constexpr (!ALIGN_EPI) { if (wr == 0) PG8_BAR; }
    PG8_BAR;
    if constexpr (Epi::AFTER_DRAIN) { E.fused(acc, cur, wr, wc, fr, fq, lds, wid, lane); S.done(cur); }
#undef PG8_SA
#undef PG8_SB
#undef PG8_STAGE
#undef PG8_LDA
#undef PG8_LDB
#undef PG8_MMA
#undef PG8_WAIT_V
#undef PG8_WAIT_L
#undef PG8_BAR
#undef PG8_SCHED
}
}

constexpr int D = 2048, BATCH = 2, SEQ = 8192, T = BATCH * SEQ, DEPTH = 2, GW = 512;
constexpr int RW_OFF = 3 * GW, RW_COLS = 3 * GW + 96 + 96 + 128, ATT_OFF = RW_OFF + RW_COLS, S5_OFF = ATT_OFF + 512 + 256, NIN = S5_OFF + GW, NINP = 4864;
static_assert(NIN == 4672 && ATT_OFF == 3392 && S5_OFF == 4160, "column layout");
constexpr int NEXP = 32, DEXP = 512, MAXTILES = 160, MAXROWS = MAXTILES * 256;
constexpr float ALPHA = 1.41421356237f, LN_EPS = 1e-5f, GN_EPS = 64e-5f;
constexpr int NWAVES = 8, NT = 512;
constexpr int KS_MOD = 8;

constexpr size_t MiB = 1u << 20;
constexpr size_t WS_CTL = 0, CTL_ZERO_BYTES = 1 * MiB;
constexpr size_t WS_MODP = 1 * MiB;
constexpr size_t WS_MODF = 4 * MiB;
constexpr size_t WS_WIN = 5 * MiB;
constexpr size_t WS_WOUT = 24 * MiB;
constexpr size_t WS_GLU = 32 * MiB;
constexpr size_t WS_LORA = WS_GLU + MiB / 2;
constexpr size_t WS_ROUT = 33 * MiB;
constexpr size_t WS_S5C = WS_ROUT + MiB / 2;
constexpr size_t WS_MISC = 34 * MiB;
constexpr size_t WS_W13 = 36 * MiB;
constexpr size_t WS_W2 = 164 * MiB;
constexpr size_t WS_H = 228 * MiB;
constexpr size_t WS_Z = 292 * MiB;
constexpr size_t WS_P = 420 * MiB;
constexpr size_t WS_YCAT = 572 * MiB;
constexpr size_t WS_RW = 636 * MiB;
constexpr size_t WS_RWSC = 892 * MiB;
constexpr size_t WS_YS = 894 * MiB;
constexpr size_t WS_S5E = 910 * MiB;
constexpr size_t WS_S5X = 914 * MiB;
constexpr size_t WS_WIN2 = 918 * MiB;
constexpr size_t WS_LORA2 = 937 * MiB, WS_S5C2 = 938 * MiB;
constexpr size_t WS_CK = 939 * MiB;
constexpr size_t WS_END = 1164 * MiB;
constexpr size_t WS_XB = WS_P;
constexpr size_t WS_YR = WS_P;
constexpr size_t WS_HLO = WS_RW;
constexpr size_t WS_HMID = WS_RW + 64 * MiB;
static_assert(WS_P + (size_t)MAXROWS * 2048 * 2 <= WS_RW, "XB overlay");
constexpr size_t MI_COUNTS = 0;
constexpr size_t MI_TILEE = 64 * 1024;
constexpr size_t MI_ROUTE_E = 128 * 1024;
constexpr size_t MI_ROUTE_W = 256 * 1024;
constexpr size_t MI_DEST = 384 * 1024;
constexpr size_t MI_ROWW = 512 * 1024;
constexpr size_t MI_S5POW = 1280 * 1024;
constexpr size_t MI_S5BBF = MI_S5POW + 320 * 1024;
constexpr size_t MI_STATS = 1024 * 1024;
constexpr size_t S5C_LAM = 0;
constexpr size_t S5C_BB = 32 * 1024;
constexpr size_t S5C_CP = 32 * 1024 + 256 * 1024;
static_assert(S5C_CP + 32 * 16 * 128 * 2 <= MiB / 2, "S5C");
__device__ __forceinline__ constexpr size_t ws_win(int l) { return (l & 1) ? WS_WIN2 : WS_WIN; }
__device__ __forceinline__ constexpr size_t ws_lora(int l) { return (l & 1) ? WS_LORA2 : WS_LORA; }
__device__ __forceinline__ constexpr size_t ws_s5c(int l) { return (l & 1) ? WS_S5C2 : WS_S5C; }
constexpr int CW_BAR = 4096;

constexpr int RING_OFF = 0, RING_BYTES = 131072;
constexpr int XTRA_OFF = RING_BYTES;
constexpr int LDSCTL_OFF = XTRA_OFF + 16384, MISC_OFF = LDSCTL_OFF + 320;
constexpr int LDS_BYTES = LDSCTL_OFF + 1024;
static_assert(LDS_BYTES <= 163840, "LDS");

#define GAS __attribute__((address_space(1)))
#define LAS __attribute__((address_space(3)))
#define DI __device__ __forceinline__
typedef unsigned short bf16;
typedef unsigned v4u __attribute__((ext_vector_type(4)));
typedef unsigned v2u __attribute__((ext_vector_type(2)));
typedef float f32x4 __attribute__((ext_vector_type(4)));
typedef float f32x2 __attribute__((ext_vector_type(2)));
typedef int i32x2 __attribute__((ext_vector_type(2)));
typedef short bf16x8 __attribute__((ext_vector_type(8)));
typedef GAS unsigned gu32;
#define RLX_AGENT __ATOMIC_RELAXED, __HIP_MEMORY_SCOPE_AGENT
#define LDS_WAIT() asm volatile("s_waitcnt lgkmcnt(0)" ::: "memory")
#define VM_WAIT() asm volatile("s_waitcnt vmcnt(0)" ::: "memory")
using pg8::cvt_pk_bf16;
typedef __bf16 bf2_t __attribute__((ext_vector_type(2)));
DI unsigned cvt_pk_safe(float lo, float hi) { const bf2_t r = __builtin_convertvector((f32x2){lo, hi}, bf2_t); return __builtin_bit_cast(unsigned, r); }
DI float bf_lo(unsigned u) { return __builtin_bit_cast(float, u << 16); }
DI float bf_hi(unsigned u) { return __builtin_bit_cast(float, u & 0xffff0000u); }
DI float bf1(bf16 b) { return __builtin_bit_cast(float, (unsigned)b << 16); }
DI float rcpf_(float x) { return __builtin_amdgcn_rcpf(x); }
DI float sigmoidf_(float x) { return rcpf_(1.f + __expf(-x)); }
DI float siluf_(float x) { return x * rcpf_(1.f + __expf(-x)); }
DI float tanhf_(float x) { const float e = __expf(-2.f * fabsf(x)); const float t = (1.f - e) * rcpf_(1.f + e); return x < 0.f ? -t : t; }
DI float gelu_tanh(float x) { const float u = 0.7978845608028654f * (x + 0.044715f * x * x * x); return 0.5f * x * (1.f + tanhf_(u)); }
template <int CTRL> DI float dppf(float x) { return __builtin_bit_cast(float, __builtin_amdgcn_update_dpp(0, __builtin_bit_cast(int, x), CTRL, 0xF, 0xF, true)); }
DI float allsum16(float x) { x += dppf<0xB1>(x); x += dppf<0x4E>(x); x += dppf<0x141>(x); x += dppf<0x140>(x); return x; }
DI float rdlane(float x, int l) { return __builtin_bit_cast(float, __builtin_amdgcn_readlane(__builtin_bit_cast(int, x), l)); }
DI float wave_sum(float v) { v = allsum16(v); return (rdlane(v, 0) + rdlane(v, 16)) + (rdlane(v, 32) + rdlane(v, 48)); }
DI bf16x8 as_frag(v4u v) { return __builtin_bit_cast(bf16x8, v); }
#define MFMA16(a, b, c) __builtin_amdgcn_mfma_f32_16x16x32_bf16((a), (b), (c), 0, 0, 0)

#define XB_TMO      128
#define XB_XCNT(j)  (256  + 64 * (j))
#define XB_XSUB(j)  (1280 + 64 * (j))
#define XB_XGEN(j)  (2304 + 64 * (j))
#define XB_TOP      3328
#define XB_TOPGEN   3392
#define XCD_BAR_WORDS 3456
#define XB_SPIN_CAP (1u << 18)
__device__ __forceinline__ unsigned xb_ld(unsigned* p)              { return __hip_atomic_load(p, __ATOMIC_RELAXED, __HIP_MEMORY_SCOPE_AGENT); }
__device__ __forceinline__ unsigned xb_add(unsigned* p, unsigned v) { return __hip_atomic_fetch_add(p, v, __ATOMIC_RELAXED, __HIP_MEMORY_SCOPE_AGENT); }
__device__ __forceinline__ unsigned xb_xcc_id() { return (unsigned)__builtin_amdgcn_s_getreg((3 << 11) | 20) & 0xFu; }
#define XB_SPIN(cond, bar) do { unsigned _sp = 0; while (cond) { __builtin_amdgcn_s_sleep(1); \
    if ((++_sp & 255u) == 0u) { if (xb_ld(&(bar)[XB_TMO])) break; if (_sp > XB_SPIN_CAP) { atomicAdd(&(bar)[XB_TMO], 1u); break; } } } } while (0)
struct XcdBarrier { unsigned* bar; unsigned x; volatile LAS unsigned* st; int wv; };
__device__ __forceinline__ XcdBarrier xcd_barrier_post(unsigned* bar, volatile LAS unsigned* st) {
    XcdBarrier b; b.bar = bar; b.x = xb_xcc_id(); b.st = st; b.wv = __builtin_amdgcn_readfirstlane((int)threadIdx.x >> 6);
    if (threadIdx.x == 0) (void)xb_add(&bar[XB_XCNT(b.x)], 1u);
    return b;
}
__device__ __forceinline__ void xcd_barrier_complete(unsigned* bar, unsigned x, unsigned& nloc, unsigned& nx) {
    const unsigned G = gridDim.x * gridDim.y * gridDim.z;
    unsigned sum, cnt, mine, sp = 0u;
    for (;;) {
        sum = 0u; cnt = 0u; mine = 0u;
#pragma unroll
        for (unsigned j = 0; j < 16; ++j) { const unsigned c = xb_ld(&bar[XB_XCNT(j)]); sum += c; cnt += (c > 0u) ? 1u : 0u; mine = (j == x) ? c : mine; }
        if (sum == G) break;
        __builtin_amdgcn_s_sleep(1);
        if ((++sp & 255u) == 0u) { if (xb_ld(&bar[XB_TMO])) break; if (sp > XB_SPIN_CAP) { atomicAdd(&bar[XB_TMO], 1u); break; } }
    }
    nloc = mine > 0u ? mine : 1u; nx = cnt > 0u ? cnt : 1u;
}
__device__ __forceinline__ void xcd_barrier(const XcdBarrier& b) {
    asm volatile("s_waitcnt vmcnt(0)" ::: "memory");
    __syncthreads();
    if (b.wv == 0 && __builtin_amdgcn_mbcnt_hi(~0u, __builtin_amdgcn_mbcnt_lo(~0u, 0u)) == 0u) {
        unsigned* bar = b.bar;
        __builtin_amdgcn_s_waitcnt(0);
        unsigned nloc = b.st[0], nx = b.st[1];
        if (nloc == 0u) { xcd_barrier_complete(bar, b.x, nloc, nx); b.st[0] = nloc; b.st[1] = nx; }
        const unsigned old = xb_add(&bar[XB_XSUB(b.x)], 1u);
        const unsigned gen = old / nloc;
        if (old + 1u == (gen + 1u) * nloc) {
            __builtin_amdgcn_fence(__ATOMIC_RELEASE, "agent");
            asm volatile("s_waitcnt vmcnt(0)" ::: "memory");
            const unsigned og = xb_add(&bar[XB_TOP], 1u);
            const unsigned tg = og / nx;
            if (og + 1u == (tg + 1u) * nx) xb_add(&bar[XB_TOPGEN], 1u);
            else XB_SPIN(xb_ld(&bar[XB_TOPGEN]) == tg, bar);
            __builtin_amdgcn_fence(__ATOMIC_ACQUIRE, "agent");
            xb_add(&bar[XB_XGEN(b.x)], 1u);
            asm volatile("s_waitcnt vmcnt(0)" ::: "memory");
        } else {
            XB_SPIN(xb_ld(&bar[XB_XGEN(b.x)]) == gen, bar);
            __builtin_amdgcn_fence(__ATOMIC_ACQUIRE, "agent");
            asm volatile("s_waitcnt vmcnt(0)" ::: "memory");
        }
    }
    __syncthreads();
}

struct Frame {
    LAS unsigned char* lds;
    int tid, lane, wave, G, blk;
};
struct Args { const float* in[39]; float* out; unsigned char* ws; int ph_lo, ph_hi; };
typedef const __attribute__((address_space(4))) Args* KArgs;
DI KArgs launder(KArgs p) { asm volatile("" : "+s"(p)); return p; }
enum { I_X = 0, I_C, I_WADA, I_BADA, I_LNG, I_LNB, I_WIN, I_WOUT, I_CONVW, I_MU, I_W0, I_W2, I_A0, I_A2, I_G2, I_KK, I_KA, I_RK, I_GNG, I_GNB,
       I_SINKS, I_RELB, I_LRE, I_LIM, I_LOGDT, I_BRE, I_BIM, I_CRE, I_CIM, I_S5D, I_GLUW, I_GLUB, I_RGW, I_RGB, I_REW, I_REB, I_MW1, I_MW3, I_MW2 };

DI Frame mkframe(LAS unsigned char* lds, int wv) {
    Frame F; int w_ = wv; asm volatile("" : "+s"(w_)); int t = (w_ << 6) | (int)__builtin_amdgcn_mbcnt_hi(~0u, __builtin_amdgcn_mbcnt_lo(~0u, 0u)); asm volatile("" : "+v"(t)); int g = gridDim.x, b = blockIdx.x; asm volatile("" : "+s"(g), "+s"(b));
    F.lds = lds; F.tid = t; F.lane = t & 63; F.wave = __builtin_amdgcn_readfirstlane(t >> 6); F.G = g; F.blk = b; return F;
}
DI float mod_val(KArgs A, int l, int b, int col) {
    const float* mp = (const float*)(A->ws + WS_MODP) + ((size_t)(l * KS_MOD) * 2 + b) * 12288 + col;
    float s = A->in[I_BADA][l * 12288 + col];
#pragma unroll
    for (int ks = 0; ks < KS_MOD; ++ks) s += mp[(size_t)ks * 2 * 12288];
    return s;
}
template <bool PARTIAL = false>
DI void stage_mod(KArgs A, LAS float* dst, int l, int which, float add, int tid) {
    const float* mf = (const float*)(A->ws + WS_MODF) + (size_t)l * 2 * 12288 + which * 2048;
    for (int i = tid; i < 2 * 2048; i += NT) { const int b = i >> 11, c = i & 2047; dst[i] = add + (PARTIAL ? mod_val(A, l, b, which * 2048 + c) : mf[b * 12288 + c]); }
}
DI void mod_finalize(KArgs A, const Frame& F, int l) {
    float* mf = (float*)(A->ws + WS_MODF) + (size_t)l * 2 * 12288;
    for (int i = F.blk * NT + F.tid; i < 2 * 12288; i += F.G * NT) { const int b = i / 12288, c = i % 12288; mf[i] = mod_val(A, l, b, c); }
}
constexpr int TSCR = 64 * 65 * 4;
DI void transpose_item(const float* W, int K, int N, bf16* WT, int k0, int n0, int drow0, LAS float* scr, int lane) {
    f32x4 r[16]; const int rs = lane >> 4, cj = 4 * (lane & 15);
#pragma unroll
    for (int i = 0; i < 16; ++i) r[i] = *(const GAS f32x4*)(W + (size_t)(k0 + 4 * i + rs) * N + n0 + cj);
#pragma unroll
    for (int i = 0; i < 16; ++i) { LAS float* d = scr + (4 * i + rs) * 65 + cj; d[0] = r[i].x; d[1] = r[i].y; d[2] = r[i].z; d[3] = r[i].w; }
    LDS_WAIT(); asm volatile("" ::: "memory");
    const int c = lane & 7;
#pragma unroll
    for (int j = 0; j < 8; ++j) { const int n = (lane >> 3) + 8 * j; const LAS float* q = scr + (8 * c) * 65 + n;
        v4u o; o.x = cvt_pk_bf16(q[0 * 65], q[1 * 65]); o.y = cvt_pk_bf16(q[2 * 65], q[3 * 65]); o.z = cvt_pk_bf16(q[4 * 65], q[5 * 65]); o.w = cvt_pk_bf16(q[6 * 65], q[7 * 65]);
        *(GAS v4u*)(WT + (size_t)(drow0 + n) * K + k0 + 8 * c) = o; }
    LDS_WAIT(); asm volatile("" ::: "memory");
}
DI void phase_wprep_a(KArgs A, const Frame& F, int l, int wid, int nw, int parts = 3) {
    LAS float* scr = (LAS float*)(F.lds + RING_OFF + F.wave * TSCR);
    const int gw = wid, NGW = nw;
    if (parts & 1) { const float* W = A->in[I_WIN] + (size_t)l * D * NIN; bf16* WT = (bf16*)(A->ws + ws_win(l));
      constexpr int NB = NIN / 64, ITEMS = (D / 64) * NB;
      for (int it = gw; it < ITEMS; it += NGW) { const int kb = it / NB, nb = it % NB; transpose_item(W, D, NIN, WT, 64 * kb, 64 * nb, 64 * nb, scr, F.lane); }
      for (int i = gw * 64 + F.lane; i < (NINP - NIN) * D / 8; i += NGW * 64) *(GAS v4u*)(WT + (size_t)NIN * D + (size_t)i * 8) = (v4u){0u, 0u, 0u, 0u};
    }
    if (!(parts & 2)) return;
    const int gt = wid * 64 + F.lane, NGT = nw * 64;
    { bf16* L0 = (bf16*)(A->ws + ws_lora(l)); bf16* L1 = L0 + 512 * 96; bf16* L2 = L1 + 512 * 96;
      const float* w2 = A->in[I_W2] + (size_t)l * 96 * 512; const float* a2 = A->in[I_A2] + (size_t)l * 96 * 512; const float* g2 = A->in[I_G2] + (size_t)l * 128 * 512;
      for (int i = gt; i < 512 * 96; i += NGT) { const int n = i / 96, k = i % 96; L0[i] = (bf16)(cvt_pk_bf16(w2[k * 512 + n], 0.f) & 0xffffu); L1[i] = (bf16)(cvt_pk_bf16(a2[k * 512 + n], 0.f) & 0xffffu); }
      for (int i = gt; i < 512 * 128; i += NGT) { const int n = i / 128, k = i % 128; L2[i] = (bf16)(cvt_pk_bf16(g2[k * 512 + n], 0.f) & 0xffffu); }
    }
    { unsigned char* sc = A->ws + ws_s5c(l);
      for (int i = gt; i < 32 * 64; i += NGT) { const int g = i >> 6;
          const float lr = A->in[I_LRE][l * 2048 + i], li = A->in[I_LIM][l * 2048 + i], dt = expf(A->in[I_LOGDT][l * 32 + g]);
          const float mag = expf(lr * dt), ar = mag * cosf(li * dt), ai = mag * sinf(li * dt);
          float pr = ar, pi = ai;
#pragma unroll
          for (int s = 0; s < 6; ++s) { const float nr = pr * pr - pi * pi, ni = 2.f * pr * pi; pr = nr; pi = ni; }
          ((f32x4*)(sc + S5C_LAM))[i] = (f32x4){ar, ai, pr, pi};
          const float den = lr * lr + li * li, zr = ((ar - 1.f) * lr + ai * li) / den, zi = (ai * lr - (ar - 1.f) * li) / den;
          float* bb = (float*)(sc + S5C_BB) + (size_t)i * 32;
          const float* br = A->in[I_BRE] + ((size_t)l * 2048 + i) * 16; const float* bi = A->in[I_BIM] + ((size_t)l * 2048 + i) * 16;
          float bbv[32];
#pragma unroll
          for (int c = 0; c < 16; ++c) { bbv[c] = zr * br[c] - zi * bi[c]; bbv[16 + c] = zr * bi[c] + zi * br[c]; bb[c] = bbv[c]; bb[16 + c] = bbv[16 + c]; }
          { f32x2* pw = (f32x2*)(A->ws + WS_MISC + MI_S5POW) + (size_t)i * 17; float qr = 1.f, qi = 0.f;
#pragma unroll 1
            for (int e = 0; e <= 16; ++e) { pw[e] = (f32x2){qr, qi}; const float nr = qr * ar - qi * ai, ni = qr * ai + qi * ar; qr = nr; qi = ni; } }
          { v2u* bfp = (v2u*)(A->ws + WS_MISC + MI_S5BBF); const int p = i & 63, nt = p >> 4, frl = p & 15;
#pragma unroll
            for (int ri = 0; ri < 2; ++ri)
#pragma unroll
                for (int q4 = 0; q4 < 4; ++q4) { const float* v = bbv + 16 * ri + 4 * q4;
                    const unsigned h0 = cvt_pk_bf16(v[0], v[1]), h1 = cvt_pk_bf16(v[2], v[3]);
                    const unsigned l0 = cvt_pk_bf16(v[0] - bf_lo(h0), v[1] - bf_hi(h0)), l1 = cvt_pk_bf16(v[2] - bf_lo(h1), v[3] - bf_hi(h1));
                    const size_t ix = ((size_t)((g * 4 + nt) * 2 + ri) * 2) * 64 + q4 * 16 + frl;
                    bfp[ix] = (v2u){h0, h1}; bfp[ix + 64] = (v2u){l0, l1}; } } }
      bf16* cp = (bf16*)(sc + S5C_CP);
      for (int i = gt; i < 32 * 16 * 128; i += NGT) { const int k = i & 127, gc = i >> 7, p = k >> 1;
          const float v = (k & 1) ? -A->in[I_CIM][((size_t)l * 512 + gc) * 64 + p] : A->in[I_CRE][((size_t)l * 512 + gc) * 64 + p];
          cp[i] = (bf16)(cvt_pk_bf16(v, 0.f) & 0xffffu); }
    }
    {
        constexpr int NCG = 12288 / 256, ITEMS = NCG * KS_MOD, ROWS = D / KS_MOD;
        for (int it = gw; it < ITEMS; it += NGW) {
            const int ll = l, r = it, cg = r / KS_MOD, ks = r % KS_MOD, col = cg * 256 + 4 * F.lane;
            const float* wp = A->in[I_WADA] + ((size_t)ll * D + ks * ROWS) * 12288 + col; const float* cv = A->in[I_C] + ks * ROWS;
            f32x4 a0 = {0.f, 0.f, 0.f, 0.f}, a1 = {0.f, 0.f, 0.f, 0.f};
#pragma unroll 8
            for (int k = 0; k < ROWS; ++k) { const f32x4 w = *(const GAS f32x4*)(wp + (size_t)k * 12288); const float s0 = siluf_(cv[k]), s1 = siluf_(cv[D + k]); a0 += w * s0; a1 += w * s1; }
            float* mp = (float*)(A->ws + WS_MODP) + ((size_t)(ll * KS_MOD + ks) * 2) * 12288 + col;
            *(GAS f32x4*)mp = a0; *(GAS f32x4*)(mp + 12288) = a1;
        }
    }
}
DI void phase_wprep_b(KArgs A, const Frame& F, int l, int gw, int NGW) {
    LAS float* scr = (LAS float*)(F.lds + RING_OFF + F.wave * TSCR);
    constexpr int IT_O = (D / 64) * (D / 64), IT_G = (512 / 64) * (512 / 64), IT_13 = (D / 64) * (DEXP / 64), IT_2 = (DEXP / 64) * (D / 64);
    constexpr int TOTAL = IT_O + IT_G + NEXP * (2 * IT_13 + IT_2);
    for (int it = gw; it < TOTAL; it += NGW) {
        int r = it;
        if (r < IT_O) { const int nbk = D / 64, kb = r / nbk, nb = r % nbk; transpose_item(A->in[I_WOUT] + (size_t)l * D * D, D, D, (bf16*)(A->ws + WS_WOUT), 64 * kb, 64 * nb, 64 * nb, scr, F.lane); continue; } r -= IT_O;
        if (r < IT_G) { const int nbk = 512 / 64, kb = r / nbk, nb = r % nbk; transpose_item(A->in[I_GLUW] + (size_t)l * 512 * 512, 512, 512, (bf16*)(A->ws + WS_GLU), 64 * kb, 64 * nb, 64 * nb, scr, F.lane); continue; } r -= IT_G;
        const int e = r / (2 * IT_13 + IT_2); r %= (2 * IT_13 + IT_2);
        if (r < 2 * IT_13) { const int which = r / IT_13, rr = r % IT_13, nbk = DEXP / 64, kb = rr / nbk, nb = rr % nbk, n0 = 64 * nb;
            const float* W = A->in[which ? I_MW3 : I_MW1] + ((size_t)l * NEXP + e) * D * DEXP;
            const int drow0 = e * 1024 + (n0 >> 7) * 256 + which * 128 + (n0 & 127);
            transpose_item(W, D, DEXP, (bf16*)(A->ws + WS_W13), 64 * kb, n0, drow0, scr, F.lane); continue; }
        r -= 2 * IT_13;
        { const int nbk = D / 64, kb = r / nbk, nb = r % nbk; const float* W = A->in[I_MW2] + ((size_t)l * NEXP + e) * DEXP * D;
          transpose_item(W, DEXP, D, (bf16*)(A->ws + WS_W2), 64 * kb, 64 * nb, e * 2048 + 64 * nb, scr, F.lane); }
    }
    { bf16* hi = (bf16*)(A->ws + WS_ROUT); bf16* lo = hi + 48 * 2048;
      for (int i = gw * 64 + F.lane; i < 48 * 2048; i += NGW * 64) { const int j = i >> 11, k = i & 2047;
          float w = 0.f; if (j < 4) w = A->in[I_RGW][((size_t)l * D + k) * 4 + j]; else if (j < 36) w = A->in[I_REW][((size_t)l * D + k) * 32 + (j - 4)];
          const unsigned h = cvt_pk_bf16(w, 0.f) & 0xffffu; const float wl = w - bf_lo(h);
          hi[i] = (bf16)h; lo[i] = (bf16)(cvt_pk_bf16(wl, 0.f) & 0xffffu); } }
}

DI void row_stats(const f32x4 (&v)[8], float& mean, float& rstd) {
    float s = 0.f;
#pragma unroll
    for (int j = 0; j < 8; ++j) s += (v[j].x + v[j].y) + (v[j].z + v[j].w);
    mean = wave_sum(s) * (1.f / D); float s2 = 0.f;
#pragma unroll
    for (int j = 0; j < 8; ++j) { const f32x4 d = v[j] - mean; s2 += (d.x * d.x + d.y * d.y) + (d.z * d.z + d.w * d.w); }
    rstd = 1.f / sqrtf(wave_sum(s2) * (1.f / D) + LN_EPS);
}
DI void ada_store(const f32x4 (&v)[8], const LAS float* sc1p, const LAS float* sh, bf16* hrow, bf16* lorow, int lane) {
    float mean, rstd; row_stats(v, mean, rstd);
#pragma unroll
    for (int j = 0; j < 8; ++j) { const int c = 4 * (lane + 64 * j);
        const f32x4 a = *(const LAS f32x4*)(sc1p + c), b = *(const LAS f32x4*)(sh + c);
        const f32x4 h = (v[j] - mean) * rstd * a + b;
        v2u o; o.x = cvt_pk_bf16(h.x, h.y); o.y = cvt_pk_bf16(h.z, h.w);
        *(GAS v2u*)(hrow + c) = o;
        if (lorow) { v2u q; q.x = cvt_pk_bf16(h.x - bf_lo(o.x), h.y - bf_hi(o.x)); q.y = cvt_pk_bf16(h.z - bf_lo(o.y), h.w - bf_hi(o.y)); *(GAS v2u*)(lorow + c) = q; } }
}
DI void phase_ln_in(KArgs A, const Frame& F, int l) {
    LAS float* ms = (LAS float*)(F.lds + RING_OFF);
    stage_mod<true>(A, ms + 4096, l, 0, 0.f, F.tid); stage_mod<true>(A, ms, l, 1, 1.f, F.tid);
    mod_finalize(A, F, l);
    __syncthreads();
    const int gw = F.blk * NWAVES + F.wave, NGW = F.G * NWAVES;
    const float* x = A->in[I_X]; bf16* H = (bf16*)(A->ws + WS_H);
    for (int row0 = gw; row0 < T; row0 += 2 * NGW) { f32x4 v[2][8];
#pragma unroll
        for (int r = 0; r < 2; ++r) { const GAS f32x4* xr = (const GAS f32x4*)(x + (size_t)(row0 + r * NGW) * D) + F.lane;
#pragma unroll
            for (int j = 0; j < 8; ++j) v[r][j] = xr[64 * j]; }
#pragma unroll
        for (int r = 0; r < 2; ++r) { const int row = row0 + r * NGW, b = row >> 13; ada_store(v[r], ms + b * 2048, ms + 4096 + b * 2048, H + (size_t)row * D, nullptr, F.lane); } }
    __syncthreads();
}

struct EpiP {
    static constexpr bool PERM = true, AFTER_DRAIN = false;
    bf16* O; int ldc;
    DI void operator()(const f32x4 (&acc)[2][2][4][2], const pg8::Unit& u, int wr, int wc, int fr, int fq) const {
        const int row0 = u.pm * 256 + wr * 64 + fr, col0 = u.po * 256 + wc * 32 + 8 * fq;
#pragma unroll
        for (int ai = 0; ai < 2; ++ai)
#pragma unroll
            for (int m = 0; m < 4; ++m) { bf16* rowp = O + (size_t)(row0 + ai * 128 + m * 16) * ldc + col0;
#pragma unroll
                for (int bj = 0; bj < 2; ++bj) { const f32x4 v0 = acc[ai][bj][m][0], v1 = acc[ai][bj][m][1];
                    v4u w; w.x = cvt_pk_bf16(v0[0], v0[1]); w.y = cvt_pk_bf16(v0[2], v0[3]); w.z = cvt_pk_bf16(v1[0], v1[1]); w.w = cvt_pk_bf16(v1[2], v1[3]);
                    *(GAS v4u*)(rowp + bj * 128) = w; } }
    }
};
struct EpiGlu {
    static constexpr bool PERM = true, AFTER_DRAIN = false;
    const bf16* YS; bf16* O; const float* bias;
    DI void operator()(const f32x4 (&acc)[2][2][4][2], const pg8::Unit& u, int wr, int wc, int fr, int fq) const {
        const int row0 = u.pm * 256 + wr * 64 + fr, col0 = u.po * 256 + wc * 32 + 8 * fq;
#pragma unroll
        for (int ai = 0; ai < 2; ++ai)
#pragma unroll
            for (int m = 0; m < 4; ++m) { const int row = row0 + ai * 128 + m * 16;
#pragma unroll
                for (int bj = 0; bj < 2; ++bj) { const int col = col0 + bj * 128;
                    const v4u y = *(const GAS v4u*)(YS + (size_t)row * 512 + col);
                    const f32x4 b0 = *(const GAS f32x4*)(bias + col), b1 = *(const GAS f32x4*)(bias + col + 4);
                    const f32x4 v0 = acc[ai][bj][m][0] + b0, v1 = acc[ai][bj][m][1] + b1;
                    v4u w;
                    w.x = cvt_pk_bf16(bf_lo(y.x) * sigmoidf_(v0[0]), bf_hi(y.x) * sigmoidf_(v0[1]));
                    w.y = cvt_pk_bf16(bf_lo(y.y) * sigmoidf_(v0[2]), bf_hi(y.y) * sigmoidf_(v0[3]));
                    w.z = cvt_pk_bf16(bf_lo(y.z) * sigmoidf_(v1[0]), bf_hi(y.z) * sigmoidf_(v1[1]));
                    w.w = cvt_pk_bf16(bf_lo(y.w) * sigmoidf_(v1[2]), bf_hi(y.w) * sigmoidf_(v1[3]));
                    *(GAS v4u*)(O + (size_t)row * D + 1536 + col) = w; } }
    }
};
struct EpiZ {
    static constexpr bool PERM = false, AFTER_DRAIN = false;
    const float* X; float* Z; const LAS float* g1p;
    DI void operator()(const f32x4 (&acc)[2][2][4][2], const pg8::Unit& u, int wr, int wc, int fr, int fq) const {
        const int row0 = u.pm * 256 + wr * 64 + fr, col0 = u.po * 256 + wc * 32 + 4 * fq; const int b = (u.pm * 256) >> 13;
        f32x4 gv[2][2];
#pragma unroll
        for (int bj = 0; bj < 2; ++bj)
#pragma unroll
            for (int n = 0; n < 2; ++n) gv[bj][n] = *(const LAS f32x4*)(g1p + b * 2048 + col0 + bj * 128 + n * 16);
#pragma unroll
        for (int ai = 0; ai < 2; ++ai)
#pragma unroll
            for (int m = 0; m < 4; ++m) { const size_t ro = (size_t)(row0 + ai * 128 + m * 16) * D + col0;
#pragma unroll
                for (int bj = 0; bj < 2; ++bj)
#pragma unroll
                    for (int n = 0; n < 2; ++n) { const f32x4 xv = *(const GAS f32x4*)(X + ro + bj * 128 + n * 16);
                        *(GAS f32x4*)(Z + ro + bj * 128 + n * 16) = xv * ALPHA + gv[bj][n] * acc[ai][bj][m][n]; } }
    }
};
struct EpiMoeA {
    static constexpr bool PERM = true, AFTER_DRAIN = false;
    bf16* O;
    DI void operator()(const f32x4 (&acc)[2][2][4][2], const pg8::Unit& u, int wr, int wc, int fr, int fq) const {
        const int row0 = u.pm * 256 + wr * 64 + fr, col0 = u.po * 128 + wc * 32 + 8 * fq;
#pragma unroll
        for (int ai = 0; ai < 2; ++ai)
#pragma unroll
            for (int m = 0; m < 4; ++m) { const f32x4 a0 = acc[ai][0][m][0], a1 = acc[ai][0][m][1], b0 = acc[ai][1][m][0], b1 = acc[ai][1][m][1];
                v4u w; w.x = cvt_pk_bf16(siluf_(a0[0]) * b0[0], siluf_(a0[1]) * b0[1]); w.y = cvt_pk_bf16(siluf_(a0[2]) * b0[2], siluf_(a0[3]) * b0[3]);
                w.z = cvt_pk_bf16(siluf_(a1[0]) * b1[0], siluf_(a1[1]) * b1[1]); w.w = cvt_pk_bf16(siluf_(a1[2]) * b1[2], siluf_(a1[3]) * b1[3]);
                *(GAS v4u*)(O + (size_t)(row0 + ai * 128 + m * 16) * DEXP + col0) = w; }
    }
};
struct EpiMoeB {
    static constexpr bool PERM = true, AFTER_DRAIN = false;
    bf16* O; const float* roww;
    DI void operator()(const f32x4 (&acc)[2][2][4][2], const pg8::Unit& u, int wr, int wc, int fr, int fq) const {
        const int row0 = u.pm * 256 + wr * 64 + fr, col0 = u.po * 256 + wc * 32 + 8 * fq;
#pragma unroll
        for (int ai = 0; ai < 2; ++ai)
#pragma unroll
            for (int m = 0; m < 4; ++m) { const int row = row0 + ai * 128 + m * 16; const float s = roww[row]; bf16* rowp = O + (size_t)row * D + col0;
#pragma unroll
                for (int bj = 0; bj < 2; ++bj) { const f32x4 v0 = acc[ai][bj][m][0] * s, v1 = acc[ai][bj][m][1] * s;
                    v4u w; w.x = cvt_pk_bf16(v0[0], v0[1]); w.y = cvt_pk_bf16(v0[2], v0[3]); w.z = cvt_pk_bf16(v1[0], v1[1]); w.w = cvt_pk_bf16(v1[2], v1[3]);
                    *(GAS v4u*)(rowp + bj * 128) = w; } }
    }
};

DI void conv_part(KArgs A, const Frame& F, int l, int gw, int NGW) {
    const bf16* P = (const bf16*)(A->ws + WS_P); bf16* Y = (bf16*)(A->ws + WS_YCAT); const float* cw = A->in[I_CONVW] + (size_t)l * 3 * GW;
    for (int i = gw * 64 + F.lane; i < T * 64; i += NGW * 64) { const int t = i >> 6, c = (i & 63) * 8, ts = t & (SEQ - 1);
        const bf16* pr = P + (size_t)t * NINP + c;
        const v4u bg = *(const GAS v4u*)pr, c0 = *(const GAS v4u*)(pr + 512), h0 = *(const GAS v4u*)(pr + 1024);
        v4u c1 = {0u, 0u, 0u, 0u}, h1 = c1, c2 = c1, h2 = c1;
        if (ts >= 1) { c1 = *(const GAS v4u*)(pr - NINP + 512); h1 = *(const GAS v4u*)(pr - NINP + 1024); }
        if (ts >= 2) { c2 = *(const GAS v4u*)(pr - 2 * NINP + 512); h2 = *(const GAS v4u*)(pr - 2 * NINP + 1024); }
        const unsigned bgv[4] = {bg.x, bg.y, bg.z, bg.w}, c0v[4] = {c0.x, c0.y, c0.z, c0.w}, h0v[4] = {h0.x, h0.y, h0.z, h0.w}, c1v[4] = {c1.x, c1.y, c1.z, c1.w},
                       h1v[4] = {h1.x, h1.y, h1.z, h1.w}, c2v[4] = {c2.x, c2.y, c2.z, c2.w}, h2v[4] = {h2.x, h2.y, h2.z, h2.w};
        unsigned o[4];
#pragma unroll
        for (int k = 0; k < 4; ++k) {
            const float w0a = cw[c + 2 * k], w1a = cw[GW + c + 2 * k], w2a = cw[2 * GW + c + 2 * k], w0b = cw[c + 2 * k + 1], w1b = cw[GW + c + 2 * k + 1], w2b = cw[2 * GW + c + 2 * k + 1];
            const float ya = bf_lo(bgv[k]) * (w0a * bf_lo(c2v[k]) * bf_lo(h2v[k]) + w1a * bf_lo(c1v[k]) * bf_lo(h1v[k]) + w2a * bf_lo(c0v[k]) * bf_lo(h0v[k]));
            const float yb = bf_hi(bgv[k]) * (w0b * bf_hi(c2v[k]) * bf_hi(h2v[k]) + w1b * bf_hi(c1v[k]) * bf_hi(h1v[k]) + w2b * bf_hi(c0v[k]) * bf_hi(h0v[k]));
            o[k] = cvt_pk_bf16(ya, yb); }
        *(GAS v4u*)(Y + (size_t)t * D + c) = (v4u){o[0], o[1], o[2], o[3]}; }
}

constexpr int AK_PITCH = 144, AV_PITCH = 528;
constexpr int ATT_K_OFF = 0, ATT_V_OFF = 256 * AK_PITCH, ATT_B_OFF = ATT_V_OFF + 64 * AV_PITCH;
DI void attn_part(KArgs A, const Frame& F, int l, int blk0, int nblk, int item0, int item1) {
    const bf16* P = (const bf16*)(A->ws + WS_P); bf16* Y = (bf16*)(A->ws + WS_YCAT);
    LAS unsigned char* Ks = F.lds + RING_OFF + ATT_K_OFF; LAS unsigned char* Vs = F.lds + RING_OFF + ATT_V_OFF; LAS float* Bs = (LAS float*)(F.lds + RING_OFF + ATT_B_OFF);
    const int lane = F.lane, fr = lane & 15, fq = lane >> 4, w = F.wave;
    for (int item = item0 + (F.blk - blk0); item < item1; item += nblk) {
        const int b = item >> 7, g = (item >> 6) & 1, n = item & 63;
        const int tok0 = b * SEQ + 128 * (n - 1);
        for (int id = F.tid; id < 2048; id += NT) { const int key = id & 255, part = id >> 8; const bool ok = (n > 0) || (key >= 128);
            v4u kv = {0u, 0u, 0u, 0u}, vv = {0u, 0u, 0u, 0u};
            if (ok) { const bf16* src = P + (size_t)(tok0 + key) * NINP + ATT_OFF + 512 + 64 * g + 8 * part; kv = *(const GAS v4u*)src; vv = *(const GAS v4u*)(src + 128); }
            *(LAS v4u*)(Ks + key * AK_PITCH + 16 * part) = kv;
            LAS bf16* vd = (LAS bf16*)(Vs + (8 * part) * AV_PITCH) + key;
            vd[0 * (AV_PITCH / 2)] = (bf16)(vv.x & 0xffffu); vd[1 * (AV_PITCH / 2)] = (bf16)(vv.x >> 16); vd[2 * (AV_PITCH / 2)] = (bf16)(vv.y & 0xffffu); vd[3 * (AV_PITCH / 2)] = (bf16)(vv.y >> 16);
            vd[4 * (AV_PITCH / 2)] = (bf16)(vv.z & 0xffffu); vd[5 * (AV_PITCH / 2)] = (bf16)(vv.z >> 16); vd[6 * (AV_PITCH / 2)] = (bf16)(vv.w & 0xffffu); vd[7 * (AV_PITCH / 2)] = (bf16)(vv.w >> 16); }
        { const int r = F.tid >> 7, rel = F.tid & 127;
          int bucket = rel; if (rel >= 16) { bucket = 16 + (int)(logf((float)rel * (1.f / 16.f)) / logf(8.f) * 16.f); bucket = bucket < 31 ? bucket : 31; }
          Bs[r * 128 + rel] = A->in[I_RELB][bucket * 8 + 4 * g + r]; }
        __syncthreads();
        const int qi = 16 * w + fr, qtok = b * SEQ + 128 * n + qi;
#pragma unroll 1
        for (int r = 0; r < 4; ++r) { const int h = 4 * g + r;
            const bf16* qp = P + (size_t)qtok * NINP + ATT_OFF + 64 * h + 8 * fq;
            const bf16x8 q0 = as_frag(*(const GAS v4u*)qp), q1 = as_frag(*(const GAS v4u*)(qp + 32));
            const float sink = A->in[I_SINKS][l * 8 + h];
            f32x4 s[9]; float mx = sink;
#pragma unroll
            for (int kt = 0; kt < 9; ++kt) { const int nt = w + kt;
                const LAS unsigned char* kp = Ks + (16 * nt + fr) * AK_PITCH + 16 * fq;
                f32x4 acc = {0.f, 0.f, 0.f, 0.f};
                acc = MFMA16(as_frag(*(const LAS v4u*)kp), q0, acc); acc = MFMA16(as_frag(*(const LAS v4u*)(kp + 64)), q1, acc);
#pragma unroll
                for (int i = 0; i < 4; ++i) { const int j = 16 * nt + 4 * fq + i, rel = qi + 128 - j; const bool ok = (rel >= 0) && (rel < 128) && ((n > 0) || (j >= 128));
                    const float sc = ok ? acc[i] * 0.125f + Bs[r * 128 + (rel & 127)] : -1e30f; acc[i] = sc; mx = fmaxf(mx, sc); }
                s[kt] = acc; }
            mx = fmaxf(mx, __shfl_xor(mx, 16)); mx = fmaxf(mx, __shfl_xor(mx, 32));
            float den = 0.f;
#pragma unroll
            for (int kt = 0; kt < 9; ++kt)
#pragma unroll
                for (int i = 0; i < 4; ++i) { const float p = s[kt][i] > -1e29f ? __expf(s[kt][i] - mx) : 0.f; s[kt][i] = p; den += p; }
            den += __shfl_xor(den, 16); den += __shfl_xor(den, 32); den += __expf(sink - mx);
            const float inv = 1.f / den;
            f32x4 o[4];
#pragma unroll
            for (int dt = 0; dt < 4; ++dt) o[dt] = (f32x4){0.f, 0.f, 0.f, 0.f};
#pragma unroll
            for (int sp = 0; sp < 5; ++sp) { const int k0 = 2 * sp, k1 = 2 * sp + 1;
                v4u pf; pf.x = cvt_pk_bf16(s[k0][0], s[k0][1]); pf.y = cvt_pk_bf16(s[k0][2], s[k0][3]);
                if (k1 < 9) { pf.z = cvt_pk_bf16(s[k1 < 9 ? k1 : 8][0], s[k1 < 9 ? k1 : 8][1]); pf.w = cvt_pk_bf16(s[k1 < 9 ? k1 : 8][2], s[k1 < 9 ? k1 : 8][3]); } else { pf.z = 0u; pf.w = 0u; }
                int t0 = w + k0, t1 = w + k1; t1 = t1 < 16 ? t1 : 15;
#pragma unroll
                for (int dt = 0; dt < 4; ++dt) { const LAS unsigned char* vp = Vs + (16 * dt + fr) * AV_PITCH + 8 * fq;
                    const v2u va = *(const LAS v2u*)(vp + 32 * t0), vb = *(const LAS v2u*)(vp + 32 * t1);
                    o[dt] = MFMA16(as_frag((v4u){va.x, va.y, vb.x, vb.y}), as_frag(pf), o[dt]); } }
            bf16* op = Y + (size_t)qtok * D + 1024 + 64 * h + 4 * fq;
#pragma unroll
            for (int dt = 0; dt < 4; ++dt) { v2u ov; ov.x = cvt_pk_bf16(o[dt][0] * inv, o[dt][1] * inv); ov.y = cvt_pk_bf16(o[dt][2] * inv, o[dt][3] * inv); *(GAS v2u*)(op + 16 * dt) = ov; }
        }
        __syncthreads();
    }
}

DI void lerp8(const bf16* cur, const bf16* prv, bool has_prev, const float* mu, float (&o)[8]) {
    const v4u a = *(const GAS v4u*)cur; v4u b = {0u, 0u, 0u, 0u}; if (has_prev) b = *(const GAS v4u*)prv;
    const f32x4 m0 = *(const GAS f32x4*)mu, m1 = *(const GAS f32x4*)(mu + 4);
    const float av[8] = {bf_lo(a.x), bf_hi(a.x), bf_lo(a.y), bf_hi(a.y), bf_lo(a.z), bf_hi(a.z), bf_lo(a.w), bf_hi(a.w)};
    const float bv[8] = {bf_lo(b.x), bf_hi(b.x), bf_lo(b.y), bf_hi(b.y), bf_lo(b.z), bf_hi(b.z), bf_lo(b.w), bf_hi(b.w)};
    const float mv[8] = {m0.x, m0.y, m0.z, m0.w, m1.x, m1.y, m1.z, m1.w};
#pragma unroll
    for (int i = 0; i < 8; ++i) o[i] = av[i] + (bv[i] - av[i]) * mv[i];
}
DI void lerp4(const bf16* cur, const bf16* prv, bool has_prev, const float* mu, float (&o)[4]) {
    const v2u a = *(const GAS v2u*)cur; v2u b = {0u, 0u}; if (has_prev) b = *(const GAS v2u*)prv;
    const f32x4 m0 = *(const GAS f32x4*)mu;
    o[0] = bf_lo(a.x) + (bf_lo(b.x) - bf_lo(a.x)) * m0.x; o[1] = bf_hi(a.x) + (bf_hi(b.x) - bf_hi(a.x)) * m0.y;
    o[2] = bf_lo(a.y) + (bf_lo(b.y) - bf_lo(a.y)) * m0.z; o[3] = bf_hi(a.y) + (bf_hi(b.y) - bf_hi(a.y)) * m0.w;
}
constexpr size_t RWB = (size_t)T * GW;
constexpr int RP_L0 = 0, RP_L1 = 64 * 208, RP_L2 = 2 * 64 * 208, RP_PRM = RP_L2 + 64 * 272, RP_MUL = RP_PRM + 2048, RP_END = RP_MUL + 1280;
DI void rwkv_prep_part(KArgs A, const Frame& F, int l, int blk0, int nblk) {
    const bf16* P = (const bf16*)(A->ws + WS_P); float* RW = (float*)(A->ws + WS_RW); f32x4* SC = (f32x4*)(A->ws + WS_RWSC);
    const bf16* L0 = (const bf16*)(A->ws + ws_lora(l)); const bf16* L1 = L0 + 512 * 96; const bf16* L2 = L1 + 512 * 96;
    const float* mu = A->in[I_MU] + (size_t)l * RW_COLS;
    const int lane = F.lane, fr = lane & 15, fq = lane >> 4, h = (F.blk - blk0) & 7;
    LAS unsigned char* lb = F.lds + RING_OFF;
    for (int i = F.tid; i < 64 * 12; i += NT) { const int r = i / 12, p = i % 12;
        *(LAS v4u*)(lb + RP_L0 + r * 208 + 16 * p) = *(const GAS v4u*)(L0 + (size_t)(64 * h + r) * 96 + 8 * p); *(LAS v4u*)(lb + RP_L1 + r * 208 + 16 * p) = *(const GAS v4u*)(L1 + (size_t)(64 * h + r) * 96 + 8 * p); }
    for (int i = F.tid; i < 64 * 16; i += NT) { const int r = i >> 4, p = i & 15; *(LAS v4u*)(lb + RP_L2 + r * 272 + 16 * p) = *(const GAS v4u*)(L2 + (size_t)(64 * h + r) * 128 + 8 * p); }
    { LAS float* prm = (LAS float*)(lb + RP_PRM);
      if (F.tid < 64) { const int c = 64 * h + F.tid; prm[F.tid] = A->in[I_W0][l * GW + c]; prm[64 + F.tid] = A->in[I_A0][l * GW + c]; prm[128 + F.tid] = A->in[I_KK][l * GW + c]; prm[192 + F.tid] = A->in[I_KA][l * GW + c];
          prm[256 + F.tid] = A->in[I_RK][l * GW + c]; prm[320 + F.tid] = mu[c]; prm[384 + F.tid] = mu[512 + c]; prm[448 + F.tid] = mu[1024 + c]; }
      if (F.tid >= 128 && F.tid < 128 + 320) ((LAS float*)(lb + RP_MUL))[F.tid - 128] = mu[1536 + F.tid - 128]; }
    __syncthreads();
    const LAS float* prm = (const LAS float*)(lb + RP_PRM); const LAS float* mul = (const LAS float*)(lb + RP_MUL);
#pragma unroll 1
    for (int j = 0; j < 4; ++j) {
        const int tg = ((F.blk - blk0) >> 3) + 32 * (F.wave + 8 * j), t = tg * 16 + fr; const bool hp = (t & (SEQ - 1)) != 0;
        const bf16* pc = P + (size_t)t * NINP + RW_OFF; const bf16* pp = pc - NINP;
        v4u la[10], lp[10]; v2u xa[3][4], xb[3][4];
#pragma unroll
        for (int s2 = 0; s2 < 10; ++s2) { const int c = 1536 + 32 * s2 + 8 * fq; la[s2] = *(const GAS v4u*)(pc + c); lp[s2] = (v4u){0u, 0u, 0u, 0u}; if (hp) lp[s2] = *(const GAS v4u*)(pp + c); }
#pragma unroll
        for (int q = 0; q < 3; ++q)
#pragma unroll
            for (int nt = 0; nt < 4; ++nt) { const int c = 512 * q + 64 * h + 16 * nt + 4 * fq; xa[q][nt] = *(const GAS v2u*)(pc + c); xb[q][nt] = (v2u){0u, 0u}; if (hp) xb[q][nt] = *(const GAS v2u*)(pp + c); }
        bf16x8 fx[10];
#pragma unroll
        for (int s2 = 0; s2 < 10; ++s2) { const f32x4 m0 = *(const LAS f32x4*)(mul + 32 * s2 + 8 * fq), m1 = *(const LAS f32x4*)(mul + 32 * s2 + 8 * fq + 4);
            const v4u a = la[s2], b = lp[s2];
            float v[8] = {bf_lo(a.x), bf_hi(a.x), bf_lo(a.y), bf_hi(a.y), bf_lo(a.z), bf_hi(a.z), bf_lo(a.w), bf_hi(a.w)};
            const float bv[8] = {bf_lo(b.x), bf_hi(b.x), bf_lo(b.y), bf_hi(b.y), bf_lo(b.z), bf_hi(b.z), bf_lo(b.w), bf_hi(b.w)};
            const float mv[8] = {m0.x, m0.y, m0.z, m0.w, m1.x, m1.y, m1.z, m1.w};
#pragma unroll
            for (int i = 0; i < 8; ++i) { v[i] = v[i] + (bv[i] - v[i]) * mv[i]; if (s2 < 3) v[i] = tanhf_(v[i]); else if (s2 >= 6) v[i] = sigmoidf_(v[i]); }
            v4u o; o.x = cvt_pk_bf16(v[0], v[1]); o.y = cvt_pk_bf16(v[2], v[3]); o.z = cvt_pk_bf16(v[4], v[5]); o.w = cvt_pk_bf16(v[6], v[7]); fx[s2] = as_frag(o); }
        f32x4 r4[4], k4[4], v4[4];
#pragma unroll
        for (int nt = 0; nt < 4; ++nt) {
#define RP_LERP(dst_, q_) do { const f32x4 m_ = *(const LAS f32x4*)(prm + 320 + 64 * (q_) + 16 * nt + 4 * fq); const v2u a_ = xa[q_][nt], b_ = xb[q_][nt]; \
            dst_ = (f32x4){bf_lo(a_.x) + (bf_lo(b_.x) - bf_lo(a_.x)) * m_.x, bf_hi(a_.x) + (bf_hi(b_.x) - bf_hi(a_.x)) * m_.y, bf_lo(a_.y) + (bf_lo(b_.y) - bf_lo(a_.y)) * m_.z, bf_hi(a_.y) + (bf_hi(b_.y) - bf_hi(a_.y)) * m_.w}; } while (0)
            RP_LERP(r4[nt], 0); RP_LERP(k4[nt], 1); RP_LERP(v4[nt], 2);
#undef RP_LERP
        }
        float ss = 0.f;
#pragma unroll
        for (int nt = 0; nt < 4; ++nt) { const f32x4 kkw = *(const LAS f32x4*)(prm + 128 + 16 * nt + 4 * fq);
#pragma unroll
            for (int i = 0; i < 4; ++i) { const float kq = k4[nt][i] * kkw[i]; ss += kq * kq; } }
        ss += __shfl_xor(ss, 16); ss += __shfl_xor(ss, 32);
        const float inv = rcpf_(fmaxf(sqrtf(ss), 1e-12f));
        float br = 0.f, kr = 0.f, rkr = 0.f;
#pragma unroll
        for (int nt = 0; nt < 4; ++nt) { const int row = 16 * nt + fr;
            f32x4 aw = {0.f, 0.f, 0.f, 0.f}, ac = aw, ag = aw;
#pragma unroll
            for (int s2 = 0; s2 < 3; ++s2) { aw = MFMA16(as_frag(*(const LAS v4u*)(lb + RP_L0 + row * 208 + 64 * s2 + 16 * fq)), fx[s2], aw); ac = MFMA16(as_frag(*(const LAS v4u*)(lb + RP_L1 + row * 208 + 64 * s2 + 16 * fq)), fx[3 + s2], ac); }
#pragma unroll
            for (int s2 = 0; s2 < 4; ++s2) ag = MFMA16(as_frag(*(const LAS v4u*)(lb + RP_L2 + row * 272 + 64 * s2 + 16 * fq)), fx[6 + s2], ag);
            const int cl = 16 * nt + 4 * fq, c = 64 * h + cl;
            const f32x4 w0 = *(const LAS f32x4*)(prm + cl), a0 = *(const LAS f32x4*)(prm + 64 + cl), kkw = *(const LAS f32x4*)(prm + 128 + cl), kaw = *(const LAS f32x4*)(prm + 192 + cl), rkw = *(const LAS f32x4*)(prm + 256 + cl);
            f32x4 o_wr, o_kp, o_de, o_v, o_g, o_al, o_be;
#pragma unroll
            for (int i = 0; i < 4; ++i) {
                const float x = -(w0[i] + aw[i]);
                const float sp = (x > 20.f) ? x : __logf(1.f + __expf(x));
                const float wv = -sp - 0.5f, de = __expf(-__expf(wv));
                const float a = sigmoidf_(a0[i] + ac[i]);
                const float kn = k4[nt][i] * kkw[i] * inv, be = kn * a;
                const float kpv = k4[nt][i] * (1.f + (a - 1.f) * kaw[i]);
                o_al[i] = -kn; o_be[i] = be; o_de[i] = de; o_wr[i] = de * r4[nt][i]; o_kp[i] = kpv; o_v[i] = v4[nt][i]; o_g[i] = ag[i];
                br += be * r4[nt][i]; kr += kpv * r4[nt][i]; rkr += r4[nt][i] * kpv * rkw[i]; }
            const size_t o = (size_t)t * GW + c;
            *(GAS f32x4*)(RW + 1 * RWB + o) = o_de;
#define RW_ST16(k_, v_) *(GAS v2u*)((bf16*)(RW + (k_) * RWB) + o) = (v2u){cvt_pk_safe((v_)[0], (v_)[1]), cvt_pk_safe((v_)[2], (v_)[3])}
            RW_ST16(0, o_al); RW_ST16(2, o_wr); RW_ST16(3, o_kp); RW_ST16(4, o_be); RW_ST16(5, o_v); RW_ST16(6, o_g); }
#undef RW_ST16
        br += __shfl_xor(br, 16); br += __shfl_xor(br, 32); kr += __shfl_xor(kr, 16); kr += __shfl_xor(kr, 32); rkr += __shfl_xor(rkr, 16); rkr += __shfl_xor(rkr, 32);
        if (fq == 0) SC[(size_t)t * 8 + h] = (f32x4){br, kr, rkr, 0.f};
    }
    __syncthreads();
}

template <bool FINAL>
DI void s5_pass(KArgs A, const Frame& F, int l, int gw, int NGW) {
    const bf16* P = (const bf16*)(A->ws + WS_P); const unsigned char* sc = A->ws + ws_s5c(l);
    f32x2* E = (f32x2*)(A->ws + WS_S5E); const f32x2* X0 = (const f32x2*)(A->ws + WS_S5X); bf16* YS = (bf16*)(A->ws + WS_YS);
    const int lane = F.lane, fr = lane & 15, fq = lane >> 4;
    constexpr int XP = 272;
    LAS unsigned char* xs = F.lds + RING_OFF + F.wave * (32 * XP);
    for (int item = gw; item < BATCH * 32 * 128; item += NGW) {
        const int b = item >> 12, g = (item >> 7) & 31, ch = item & 127, t0 = b * SEQ + 64 * ch;
        const f32x4 lam = ((const f32x4*)(sc + S5C_LAM))[g * 64 + lane];
        float bre[16], bim[16];
        { const f32x4* bp = (const f32x4*)((const float*)(sc + S5C_BB) + (size_t)(g * 64 + lane) * 32);
#pragma unroll
          for (int q = 0; q < 4; ++q) { const f32x4 a = bp[q], c = bp[4 + q]; bre[4 * q] = a.x; bre[4 * q + 1] = a.y; bre[4 * q + 2] = a.z; bre[4 * q + 3] = a.w; bim[4 * q] = c.x; bim[4 * q + 1] = c.y; bim[4 * q + 2] = c.z; bim[4 * q + 3] = c.w; } }
        const bf16* up = P + (size_t)(t0 + lane) * NINP + S5_OFF + 16 * g;
        const v4u u0 = *(const GAS v4u*)up, u1 = *(const GAS v4u*)(up + 8);
        const unsigned uw[8] = {u0.x, u0.y, u0.z, u0.w, u1.x, u1.y, u1.z, u1.w};
        float xr = 0.f, xi = 0.f;
        if (FINAL) { const f32x2 x0 = X0[(size_t)item * 64 + lane]; xr = x0.x; xi = x0.y; }
        bf16x8 cf[4];
        if (FINAL) {
#pragma unroll
            for (int s = 0; s < 4; ++s) cf[s] = as_frag(*(const GAS v4u*)((const bf16*)(sc + S5C_CP) + (size_t)(g * 16 + fr) * 128 + 32 * s + 8 * fq)); }
#pragma unroll 1
        for (int half = 0; half < 2; ++half) {
#pragma unroll 4
            for (int tt = 0; tt < 32; ++tt) { const int tl = half * 32 + tt;
                float br_ = 0.f, bi_ = 0.f;
#pragma unroll
                for (int k = 0; k < 8; ++k) { const unsigned uu = (unsigned)__builtin_amdgcn_readlane((int)uw[k], tl);
                    const float ua = bf_lo(uu), ub = bf_hi(uu);
                    br_ += bre[2 * k] * ua + bre[2 * k + 1] * ub; bi_ += bim[2 * k] * ua + bim[2 * k + 1] * ub; }
                const float nr = lam.x * xr - lam.y * xi + br_, ni = lam.x * xi + lam.y * xr + bi_; xr = nr; xi = ni;
                if (FINAL) *(LAS unsigned*)(xs + tt * XP + 4 * lane) = cvt_pk_bf16(xr, xi); }
            if (FINAL) {
                LDS_WAIT();
#pragma unroll
                for (int mt = 0; mt < 2; ++mt) { f32x4 acc = {0.f, 0.f, 0.f, 0.f};
#pragma unroll
                    for (int s = 0; s < 4; ++s) acc = MFMA16(cf[s], as_frag(*(const LAS v4u*)(xs + (16 * mt + fr) * XP + 64 * s + 16 * fq)), acc);
                    const int t = t0 + half * 32 + 16 * mt + fr, c = 16 * g + 4 * fq;
                    const v2u uq = *(const GAS v2u*)(P + (size_t)t * NINP + S5_OFF + c); const f32x4 dk = *(const GAS f32x4*)(A->in[I_S5D] + l * GW + c);
                    const float y0 = gelu_tanh(acc[0] + dk.x * bf_lo(uq.x)), y1 = gelu_tanh(acc[1] + dk.y * bf_hi(uq.x)), y2 = gelu_tanh(acc[2] + dk.z * bf_lo(uq.y)), y3 = gelu_tanh(acc[3] + dk.w * bf_hi(uq.y));
                    v2u o; o.x = cvt_pk_bf16(y0, y1); o.y = cvt_pk_bf16(y2, y3); *(GAS v2u*)(YS + (size_t)t * GW + c) = o; }
                LDS_WAIT();
            }
        }
        if (!FINAL) E[(size_t)item * 64 + lane] = (f32x2){xr, xi};
    }
}
typedef short bf16x4 __attribute__((ext_vector_type(4)));
DI void s5_pass1_mfma(KArgs A, const Frame& F, int l) {
    const bf16* P = (const bf16*)(A->ws + WS_P); f32x2* E = (f32x2*)(A->ws + WS_S5E);
    const f32x2* pw = (const f32x2*)(A->ws + WS_MISC + MI_S5POW); const v2u* bfp = (const v2u*)(A->ws + WS_MISC + MI_S5BBF);
    const int lane = F.lane, fr = lane & 15, fq = lane >> 4, gwv = F.blk * NWAVES + F.wave;
    if (gwv >= 2048) return;
    const int b = gwv >> 10, g = (gwv >> 5) & 31, cq = gwv & 31;
    const int t0 = b * SEQ + 256 * cq;
    bf16x4 uf[16];
#pragma unroll
    for (int tl = 0; tl < 16; ++tl) uf[tl] = __builtin_bit_cast(bf16x4, *(const GAS v2u*)(P + (size_t)(t0 + 16 * tl + fr) * NINP + S5_OFF + 16 * g + 4 * fq));
#pragma unroll 1
    for (int nt = 0; nt < 4; ++nt) {
        const f32x2* pp = pw + (size_t)(g * 64 + 16 * nt + fr) * 17;
        f32x2 w[4];
#pragma unroll
        for (int i = 0; i < 4; ++i) w[i] = pp[15 - 4 * fq - i];
        const f32x2 L16 = pp[16];
        bf16x4 bf[2][2];
#pragma unroll
        for (int ri = 0; ri < 2; ++ri)
#pragma unroll
            for (int hl = 0; hl < 2; ++hl) bf[ri][hl] = __builtin_bit_cast(bf16x4, bfp[((size_t)((g * 4 + nt) * 2 + ri) * 2 + hl) * 64 + lane]);
#pragma unroll
        for (int k = 0; k < 4; ++k) { float ar_ = 0.f, ai_ = 0.f;
#pragma unroll
            for (int tl = 0; tl < 4; ++tl) { f32x4 dr = {0.f, 0.f, 0.f, 0.f}, di = dr;
                dr = __builtin_amdgcn_mfma_f32_16x16x16bf16_1k(uf[4 * k + tl], bf[0][0], dr, 0, 0, 0); dr = __builtin_amdgcn_mfma_f32_16x16x16bf16_1k(uf[4 * k + tl], bf[0][1], dr, 0, 0, 0);
                di = __builtin_amdgcn_mfma_f32_16x16x16bf16_1k(uf[4 * k + tl], bf[1][0], di, 0, 0, 0); di = __builtin_amdgcn_mfma_f32_16x16x16bf16_1k(uf[4 * k + tl], bf[1][1], di, 0, 0, 0);
                float sr = ar_ * L16.x - ai_ * L16.y, si = ar_ * L16.y + ai_ * L16.x;
#pragma unroll
                for (int i = 0; i < 4; ++i) { sr += w[i].x * dr[i] - w[i].y * di[i]; si += w[i].x * di[i] + w[i].y * dr[i]; }
                ar_ = sr; ai_ = si; }
            ar_ += __shfl_xor(ar_, 16); ar_ += __shfl_xor(ar_, 32); ai_ += __shfl_xor(ai_, 16); ai_ += __shfl_xor(ai_, 32);
            const size_t item = ((size_t)(b * 32 + g) << 7) + 4 * cq + k;
            if (fq == 0) E[item * 64 + 16 * nt + fr] = (f32x2){ar_, ai_}; } }
}
DI void s5_carry(KArgs A, const Frame& F, int l, int blk0) {
    const int i = (F.blk - blk0) * NT + F.tid; if (i < 0 || i >= BATCH * 32 * 64) return;
    const int bg = i >> 6, p = i & 63, g = bg & 31;
    const f32x4 lam = ((const f32x4*)(A->ws + ws_s5c(l) + S5C_LAM))[g * 64 + p];
    const f32x2* E = (const f32x2*)(A->ws + WS_S5E) + (size_t)bg * 128 * 64 + p; f32x2* X0 = (f32x2*)(A->ws + WS_S5X) + (size_t)bg * 128 * 64 + p;
    float xr = 0.f, xi = 0.f;
#pragma unroll 1
    for (int c0 = 0; c0 < 128; c0 += 32) { f32x2 e[32];
#pragma unroll
        for (int k = 0; k < 32; ++k) e[k] = E[(size_t)(c0 + k) * 64];
#pragma unroll
        for (int k = 0; k < 32; ++k) { X0[(size_t)(c0 + k) * 64] = (f32x2){xr, xi}; const float nr = lam.z * xr - lam.w * xi + e[k].x, ni = lam.z * xi + lam.w * xr + e[k].y; xr = nr; xi = ni; } }
}

constexpr int SCH = 32;
constexpr int SB_VEC = 5 * SCH * 64 * 4, SB_V = SCH * 16 * 4, SB_SC = SCH * 8, SB_BYTES = SB_VEC + SB_V + SB_SC;
DI void rwkv_scan(KArgs A, const Frame& F, int blk_) {
    const int bh = blk_ >> 2, q = blk_ & 3, b = bh >> 3, h = bh & 7;
    const float* RW = (const float*)(A->ws + WS_RW); const f32x4* SC = (const f32x4*)(A->ws + WS_RWSC); float* Yo = (float*)(A->ws + WS_RW) + 7 * RWB;
    const int lane = F.lane, w = F.wave;
    const bool loader = (w >= 4); const int lt = F.tid - 256;
    const int rho = lane >> 4, kq = lane & 15;
    f32x2 sa = {0.f, 0.f}, sb = {0.f, 0.f};
    constexpr int NCH = SEQ / SCH;
#define SCAN_LOAD(c_) do { const size_t tb_ = (size_t)b * SEQ + (size_t)(c_) * SCH; \
        _Pragma("unroll") for (int i = 0; i < 4; ++i) { const int idx = lt + 256 * i, ai = idx >> 8, arr = ai + (ai > 0), rem = idx & 255, row = rem >> 3, c8 = rem & 7; \
            rvh[i] = *(const GAS v4u*)((const bf16*)(RW + (size_t)arr * RWB) + (tb_ + row) * GW + 64 * h + 8 * c8); } \
        _Pragma("unroll") for (int i = 0; i < 2; ++i) { const int idx = lt + 256 * i, row = idx >> 4, c4 = idx & 15; rvd[i] = *(const GAS f32x4*)(RW + 1 * RWB + (tb_ + row) * GW + 64 * h + 4 * c4); } \
        if (lt < 64) { const int row = lt >> 1, c8 = lt & 1; rvv = *(const GAS v4u*)((const bf16*)(RW + 5 * RWB) + (tb_ + row) * GW + 64 * h + 16 * q + 8 * c8); } \
        else if (lt >= 128 && lt < 128 + SCH) { rsc = SC[(tb_ + (lt - 128)) * 8 + h]; } } while (0)
#define SCAN_UNPK(d_, u_) do { *(LAS f32x4*)(d_) = (f32x4){bf_lo((u_).x), bf_hi((u_).x), bf_lo((u_).y), bf_hi((u_).y)}; *(LAS f32x4*)((d_) + 16) = (f32x4){bf_lo((u_).z), bf_hi((u_).z), bf_lo((u_).w), bf_hi((u_).w)}; } while (0)
#define SCAN_STORE(buf_) do { LAS unsigned char* base_ = F.lds + RING_OFF + (buf_) * SB_BYTES; \
        _Pragma("unroll") for (int i = 0; i < 4; ++i) { const int idx = lt + 256 * i, ai = idx >> 8, arr = ai + (ai > 0), rem = idx & 255, row = rem >> 3, c8 = rem & 7; \
            SCAN_UNPK(base_ + ((arr * SCH + row) * 64 + 8 * c8) * 4, rvh[i]); } \
        _Pragma("unroll") for (int i = 0; i < 2; ++i) { const int idx = lt + 256 * i; *(LAS f32x4*)(base_ + (1 * SCH * 64) * 4 + idx * 16) = rvd[i]; } \
        if (lt < 64) { SCAN_UNPK(base_ + SB_VEC + lt * 32, rvv); } \
        else if (lt >= 128 && lt < 128 + SCH) *(LAS f32x2*)(base_ + SB_VEC + SB_V + (lt - 128) * 8) = (f32x2){rsc.x, rsc.y}; } while (0)
#define SCAN_LD(P_, t_) do { const LAS unsigned char* p_ = base + (t_) * 256 + 16 * kq; \
        P_##al = *(const LAS f32x4*)(p_); P_##de = *(const LAS f32x4*)(p_ + 1 * SCH * 256); P_##wr = *(const LAS f32x4*)(p_ + 2 * SCH * 256); \
        P_##kp = *(const LAS f32x4*)(p_ + 3 * SCH * 256); P_##be = *(const LAS f32x4*)(p_ + 4 * SCH * 256); \
        P_##vt = *(const LAS float*)(base + SB_VEC + ((t_) * 16 + 4 * w + rho) * 4); P_##sc = *(const LAS f32x2*)(base + SB_VEC + SB_V + (t_) * 8); } while (0)
#define SCAN_STEP(P_, t_) do { \
        f32x2 pa2 = sa * (f32x2){P_##al.x, P_##al.y} + sb * (f32x2){P_##al.z, P_##al.w}, py2 = sa * (f32x2){P_##wr.x, P_##wr.y} + sb * (f32x2){P_##wr.z, P_##wr.w}; \
        float pa = allsum16(pa2.x + pa2.y), py = allsum16(py2.x + py2.y); \
        sa = sa * (f32x2){P_##de.x, P_##de.y} + (f32x2){P_##kp.x, P_##kp.y} * P_##vt + (f32x2){P_##be.x, P_##be.y} * pa; \
        sb = sb * (f32x2){P_##de.z, P_##de.w} + (f32x2){P_##kp.z, P_##kp.w} * P_##vt + (f32x2){P_##be.z, P_##be.w} * pa; \
        const float y_ = py + pa * P_##sc.x + P_##vt * P_##sc.y; ysel = (kq == ((t_) & 15)) ? y_ : ysel; } while (0)
    if (loader) { v4u rvh[4], rvv = {0u, 0u, 0u, 0u}; f32x4 rvd[2], rsc = {0.f, 0.f, 0.f, 0.f}; SCAN_LOAD(0); SCAN_STORE(0); }
    __syncthreads();
#pragma unroll 1
    for (int c = 0; c < NCH; ++c) {
        if (loader) {
            if (c + 1 < NCH) { v4u rvh[4], rvv = {0u, 0u, 0u, 0u}; f32x4 rvd[2], rsc = {0.f, 0.f, 0.f, 0.f}; SCAN_LOAD(c + 1); SCAN_STORE((c + 1) & 1); }
        } else {
            const LAS unsigned char* base = F.lds + RING_OFF + (c & 1) * SB_BYTES;
            const size_t tb = (size_t)b * SEQ + (size_t)c * SCH;
            float* yp = Yo + (tb + kq) * GW + 64 * h + 16 * q + 4 * w + rho;
            f32x4 A_al, A_de, A_wr, A_kp, A_be, B_al, B_de, B_wr, B_kp, B_be; float A_vt, B_vt; f32x2 A_sc, B_sc; float ysel = 0.f;
            SCAN_LD(A_, 0);
#pragma unroll
            for (int t = 0; t < SCH; t += 2) {
                SCAN_LD(B_, t + 1); __builtin_amdgcn_sched_barrier(0);
                SCAN_STEP(A_, t); __builtin_amdgcn_sched_barrier(0);
                if (t + 2 < SCH) SCAN_LD(A_, t + 2);
                __builtin_amdgcn_sched_barrier(0);
                SCAN_STEP(B_, t + 1); __builtin_amdgcn_sched_barrier(0);
                if ((t & 15) == 14) yp[(size_t)(t - 14) * GW] = ysel;
            }
        }
        __syncthreads();
    }
#undef SCAN_LD
#undef SCAN_STEP
}
#define CKEN 7
constexpr int S2WG = 32;
#define CK_SEL_MASK 0
#define CK_SEL_VAL 0
#ifndef CHUNK_Y_TO_Z
#define CHUNK_Y_TO_Z 0
#endif
constexpr int CK_BT = 0, CK_KT = 8192, CK_RT = 16384, CK_VT = 24576  , CK_WT = 32768  , CK_U0T = 40960  , CK_S0 = 49152  ,
              CK_MTH = 57344, CK_MTL = 65536  , CK_GT = 73728  ,
              CK_BTT = 90112  , CK_KTT = 98304  , CK_WTT = 106496  , CK_PC = 114688  , CK_STRIDE = 114944;
DI unsigned short bfbits(float x) { return (unsigned short)(cvt_pk_safe(x, 0.f) & 0xffffu); }
DI v4u ld16(const unsigned char* p) { return *(const GAS v4u*)p; }
DI v2u ld8(const unsigned char* p) { return *(const GAS v2u*)p; }
DI float ldfc(const float* p) { return *p; }
#define CK_SYNC() do { asm volatile("s_waitcnt vmcnt(0)" ::: "memory"); __builtin_amdgcn_fence(__ATOMIC_ACQUIRE, "agent"); asm volatile("s_waitcnt vmcnt(0)" ::: "memory"); } while (0)

DI void rwkv_chunk_stage1(KArgs A, const Frame& F, int item, LAS float* xs) {
    const int b = item >> 10, h = (item >> 7) & 7, c = item & 127, lane = F.lane, fr = lane & 15, fq = lane >> 4;
    const size_t t0 = (size_t)b * SEQ + 64 * c;
    const float* RW = (const float*)(A->ws + WS_RW);
    unsigned char* ck = A->ws + WS_CK + (size_t)item * CK_STRIDE;
    float* atf = (float*)(A->ws + WS_RW) + (size_t)(item >> 10) * 2 * RWB + RWB / 2 + (size_t)(item & 1023) * 4096;
    const float* dec = RW + 1 * RWB + t0 * GW + 64 * h + lane;
    const bf16* pal = (const bf16*)(RW + 0 * RWB) + t0 * GW + 64 * h + lane; const bf16* pwr = (const bf16*)(RW + 2 * RWB) + t0 * GW + 64 * h + lane;
    const bf16* pkp = (const bf16*)(RW + 3 * RWB) + t0 * GW + 64 * h + lane; const bf16* pbe = (const bf16*)(RW + 4 * RWB) + t0 * GW + 64 * h + lane;
    const bf16* pvv = (const bf16*)(RW + 5 * RWB) + t0 * GW + 64 * h + lane;
    unsigned btp[4], ktp[4];
    float P = 1.f;
    {
        unsigned short* oAT = (unsigned short*)(ck + CK_S0) + lane; unsigned short* oBT = (unsigned short*)(ck + CK_BT) + lane; unsigned short* oKT = (unsigned short*)(ck + CK_KT) + lane; unsigned short* oRT = (unsigned short*)(ck + CK_RT) + lane;
        float pb = 0.f, pk = 0.f;
#pragma unroll
        for (int t = 0; t < 64; ++t) {
            const float d = dec[(size_t)t * GW], al = bf1(pal[(size_t)t * GW]), wr = bf1(pwr[(size_t)t * GW]), kp = bf1(pkp[(size_t)t * GW]), be = bf1(pbe[(size_t)t * GW]);
            const float Pm = P; P *= d; const float Pi = 1.f / P;
            const float at = al * Pm, bt = be * Pi, kt = kp * Pi, rt = wr * Pm;
            atf[t * 64 + lane] = at;
            oAT[t * 64] = bfbits(at); oBT[t * 64] = bfbits(bt); oKT[t * 64] = bfbits(kt); oRT[t * 64] = bfbits(rt);
            if (t & 1) { btp[(t >> 1) & 3] = cvt_pk_safe(pb, bt); ktp[(t >> 1) & 3] = cvt_pk_safe(pk, kt);
                if ((t & 7) == 7) { *(GAS v4u*)(ck + CK_BTT + lane * 128 + 16 * (t >> 3)) = (v4u){btp[0], btp[1], btp[2], btp[3]}; *(GAS v4u*)(ck + CK_KTT + lane * 128 + 16 * (t >> 3)) = (v4u){ktp[0], ktp[1], ktp[2], ktp[3]}; } }
            else { pb = bt; pk = kt; }
            if ((t & 15) == 15) __builtin_amdgcn_sched_barrier(0);
        }
        *(GAS float*)((float*)(ck + CK_PC) + lane) = P;
    }
    __builtin_amdgcn_sched_barrier(0);
    {
#pragma unroll
        for (int q = 0; q < 8; ++q) { unsigned w[4];
#pragma unroll
            for (int e = 0; e < 4; ++e) w[e] = (unsigned)pvv[(size_t)(8 * q + 2 * e) * GW] | ((unsigned)pvv[(size_t)(8 * q + 2 * e + 1) * GW] << 16);
            *(GAS v4u*)(ck + CK_VT + lane * 128 + 16 * q) = (v4u){w[0], w[1], w[2], w[3]}; }
    }
    CK_SYNC();
#pragma unroll 1
    for (int tt = 0; tt < 4; ++tt) {
        const bf16x8 fa0 = as_frag(ld16(ck + CK_S0 + (16 * tt + fr) * 128 + 16 * fq)), fa1 = as_frag(ld16(ck + CK_S0 + (16 * tt + fr) * 128 + 64 + 16 * fq));
        f32x4 aak[4];
#pragma unroll
        for (int tj = 0; tj < 4; ++tj) { aak[tj] = (f32x4){0.f, 0.f, 0.f, 0.f};
            if (tj <= tt) {
                const unsigned char* rb = ck + CK_BT + (16 * tj + fr) * 128 + 16 * fq; const unsigned char* rk = ck + CK_KT + (16 * tj + fr) * 128 + 16 * fq;
                f32x4 dab = {0.f, 0.f, 0.f, 0.f}, dak = dab;
                dab = MFMA16(as_frag(ld16(rb)), fa0, dab); dab = MFMA16(as_frag(ld16(rb + 64)), fa1, dab);
                dak = MFMA16(as_frag(ld16(rk)), fa0, dak); dak = MFMA16(as_frag(ld16(rk + 64)), fa1, dak);
                if (tj == tt) {
#pragma unroll
                    for (int i = 0; i < 4; ++i) { const bool keep = (4 * fq + i) < fr; dab[i] = keep ? dab[i] : 0.f; dak[i] = keep ? dak[i] : 0.f; } }
                *(LAS f32x4*)(xs + (16 * tt + fr) * 64 + 16 * tj + 4 * fq) = dab;
                aak[tj] = dak; } }
        f32x4 ru[4] = {{0.f, 0.f, 0.f, 0.f}, {0.f, 0.f, 0.f, 0.f}, {0.f, 0.f, 0.f, 0.f}, {0.f, 0.f, 0.f, 0.f}};
#pragma unroll
        for (int s = 0; s < 2; ++s) { if (2 * s <= tt) {
            v4u pf; pf.x = cvt_pk_safe(aak[2 * s][0], aak[2 * s][1]); pf.y = cvt_pk_safe(aak[2 * s][2], aak[2 * s][3]); pf.z = cvt_pk_safe(aak[2 * s + 1][0], aak[2 * s + 1][1]); pf.w = cvt_pk_safe(aak[2 * s + 1][2], aak[2 * s + 1][3]);
#pragma unroll
            for (int tv = 0; tv < 4; ++tv) { const unsigned char* rv = ck + CK_VT + (16 * tv + fr) * 128 + 64 * s + 8 * fq; const v2u va = ld8(rv), vb = ld8(rv + 32);
                ru[tv] = MFMA16(as_frag((v4u){va.x, va.y, vb.x, vb.y}), as_frag(pf), ru[tv]); } } }
#pragma unroll
        for (int tv = 0; tv < 4; ++tv) *(GAS f32x4*)(ck + CK_MTH + ((16 * tt + fr) * 64 + 16 * tv + 4 * fq) * 4) = ru[tv];
    }
    CK_SYNC(); LDS_WAIT();
#define CK_SOLVE(x_) do { _Pragma("unroll") for (int t = 1; t < 64; ++t) { float acc_ = x_[t]; \
            _Pragma("unroll") for (int jb = 0; jb < t; jb += 4) { const f32x4 a4 = *(const LAS f32x4*)(xs + t * 64 + jb); \
                acc_ += a4.x * x_[jb]; if (jb + 1 < t) acc_ += a4.y * x_[jb + 1]; if (jb + 2 < t) acc_ += a4.z * x_[jb + 2]; if (jb + 3 < t) acc_ += a4.w * x_[jb + 3]; } \
            x_[t] = acc_; } } while (0)
    {
        float xw[64];
#pragma unroll
        for (int t = 0; t < 64; ++t) xw[t] = ldfc(atf + t * 64 + lane);
        CK_SOLVE(xw);
        unsigned short* oWT = (unsigned short*)(ck + CK_WT) + lane;
#pragma unroll
        for (int t = 0; t < 64; ++t) oWT[t * 64] = bfbits(xw[t]);
#pragma unroll
        for (int q = 0; q < 8; ++q) *(GAS v4u*)(ck + CK_WTT + lane * 128 + 16 * q) = (v4u){cvt_pk_safe(xw[8 * q], xw[8 * q + 1]), cvt_pk_safe(xw[8 * q + 2], xw[8 * q + 3]), cvt_pk_safe(xw[8 * q + 4], xw[8 * q + 5]), cvt_pk_safe(xw[8 * q + 6], xw[8 * q + 7])};
    }
    __builtin_amdgcn_sched_barrier(0);
    {
        float xu[64]; const float* ru = (const float*)(ck + CK_MTH) + lane;
#pragma unroll
        for (int t = 0; t < 64; ++t) xu[t] = ldfc(ru + t * 64);
        CK_SOLVE(xu);
#pragma unroll
        for (int q = 0; q < 8; ++q) *(GAS v4u*)(ck + CK_U0T + lane * 128 + 16 * q) = (v4u){cvt_pk_safe(xu[8 * q], xu[8 * q + 1]), cvt_pk_safe(xu[8 * q + 2], xu[8 * q + 3]), cvt_pk_safe(xu[8 * q + 4], xu[8 * q + 5]), cvt_pk_safe(xu[8 * q + 6], xu[8 * q + 7])};
    }
#undef CK_SOLVE
    CK_SYNC();
    const float* pc = (const float*)(ck + CK_PC);
#pragma unroll 1
    for (int t2 = 0; t2 < 4; ++t2) {
        const bf16x8 fb0 = as_frag(ld16(ck + CK_BTT + (16 * t2 + fr) * 128 + 16 * fq)), fb1 = as_frag(ld16(ck + CK_BTT + (16 * t2 + fr) * 128 + 64 + 16 * fq));
        const float pck = ldfc(pc + 16 * t2 + fr);
        unsigned hw[4][2];
#pragma unroll
        for (int t1 = 0; t1 < 4; ++t1) { const unsigned char* rw = ck + CK_WTT + (16 * t1 + fr) * 128 + 16 * fq;
            f32x4 d = {0.f, 0.f, 0.f, 0.f}; d = MFMA16(as_frag(ld16(rw)), fb0, d); d = MFMA16(as_frag(ld16(rw + 64)), fb1, d);
            float m[4];
#pragma unroll
            for (int i = 0; i < 4; ++i) { m[i] = (d[i] + ((t1 == t2 && 4 * fq + i == fr) ? 1.f : 0.f)) * pck; }
            hw[t1][0] = cvt_pk_safe(m[0], m[1]); hw[t1][1] = cvt_pk_safe(m[2], m[3]); }
#pragma unroll
        for (int sx = 0; sx < 2; ++sx) *(GAS v4u*)(ck + CK_MTH + ((t2 * 2 + sx) * 64 + lane) * 16) = (v4u){hw[2 * sx][0], hw[2 * sx][1], hw[2 * sx + 1][0], hw[2 * sx + 1][1]}; }
#pragma unroll 1
    for (int tv = 0; tv < 4; ++tv) {
        const unsigned char* ru = ck + CK_U0T + (16 * tv + fr) * 128 + 16 * fq; const unsigned char* rv = ck + CK_VT + (16 * tv + fr) * 128 + 16 * fq;
        const bf16x8 fu0 = as_frag(ld16(ru)), fu1 = as_frag(ld16(ru + 64)), fv0 = as_frag(ld16(rv)), fv1 = as_frag(ld16(rv + 64));
#pragma unroll
        for (int t2 = 0; t2 < 4; ++t2) { const unsigned char* rb = ck + CK_BTT + (16 * t2 + fr) * 128 + 16 * fq; const unsigned char* rk = ck + CK_KTT + (16 * t2 + fr) * 128 + 16 * fq;
            f32x4 d = {0.f, 0.f, 0.f, 0.f};
            d = MFMA16(as_frag(ld16(rb)), fu0, d); d = MFMA16(as_frag(ld16(rb + 64)), fu1, d); d = MFMA16(as_frag(ld16(rk)), fv0, d); d = MFMA16(as_frag(ld16(rk + 64)), fv1, d);
            const f32x4 pr = *(const GAS f32x4*)(pc + 16 * t2 + 4 * fq);
            *(GAS f32x4*)(ck + CK_GT + ((tv * 4 + t2) * 64 + lane) * 16) = d * pr; } }
}
DI void rwkv_chunk_stage2(KArgs A, const Frame& F, int bh, int vt) {
    const int lane = F.lane, fr = lane & 15, fq = lane >> 4;
    f32x4 acc[4] = {{0.f, 0.f, 0.f, 0.f}, {0.f, 0.f, 0.f, 0.f}, {0.f, 0.f, 0.f, 0.f}, {0.f, 0.f, 0.f, 0.f}};
    unsigned char* ck0 = A->ws + WS_CK + (size_t)(bh * 128) * CK_STRIDE;
    const unsigned voff = (unsigned)lane * 16u;
#define S2_GLD(d_, sb_, imm_) asm volatile("global_load_dwordx4 %0, %1, %2 offset:" #imm_ : "=&v"(d_) : "v"(voff), "s"(sb_) : "memory")
#define S2_LOAD(P_, c_) do { const unsigned char* ck_ = ck0 + (size_t)(c_) * CK_STRIDE; const unsigned char* sg = ck_ + CK_GT + vt * 4096; const unsigned char* sm0 = ck_ + CK_MTH; const unsigned char* sm1 = ck_ + CK_MTH + 4096; \
        S2_GLD(P_##g[0], sg, 0); S2_GLD(P_##g[1], sg, 1024); S2_GLD(P_##g[2], sg, 2048); S2_GLD(P_##g[3], sg, 3072); \
        S2_GLD(P_##m[0][0], sm0, 0); S2_GLD(P_##m[0][1], sm0, 1024); S2_GLD(P_##m[1][0], sm0, 2048); S2_GLD(P_##m[1][1], sm0, 3072); \
        S2_GLD(P_##m[2][0], sm1, 0); S2_GLD(P_##m[2][1], sm1, 1024); S2_GLD(P_##m[3][0], sm1, 2048); S2_GLD(P_##m[3][1], sm1, 3072); } while (0)
#define S2_WAIT(P_, N_) do { asm volatile("s_waitcnt vmcnt(" #N_ ")" : "+v"(P_##g[0]), "+v"(P_##g[1]), "+v"(P_##g[2]), "+v"(P_##g[3]), "+v"(P_##m[0][0]), "+v"(P_##m[0][1]), "+v"(P_##m[1][0]), "+v"(P_##m[1][1]), \
        "+v"(P_##m[2][0]), "+v"(P_##m[2][1]), "+v"(P_##m[3][0]), "+v"(P_##m[3][1]) :: "memory"); } while (0)
#define S2_STEP(P_, c_) do { unsigned char* ck_ = ck0 + (size_t)(c_) * CK_STRIDE; v4u sh[2]; \
        _Pragma("unroll") for (int s = 0; s < 2; ++s) { \
            const unsigned a0 = cvt_pk_safe(acc[2 * s][0], acc[2 * s][1]), a1 = cvt_pk_safe(acc[2 * s][2], acc[2 * s][3]), b0 = cvt_pk_safe(acc[2 * s + 1][0], acc[2 * s + 1][1]), b1 = cvt_pk_safe(acc[2 * s + 1][2], acc[2 * s + 1][3]); \
            sh[s] = (v4u){a0, a1, b0, b1}; \
            *(GAS v2u*)(ck_ + CK_S0 + (16 * vt + fr) * 128 + (32 * s + 4 * fq) * 2) = (v2u){a0, a1}; \
            *(GAS v2u*)(ck_ + CK_S0 + (16 * vt + fr) * 128 + (32 * s + 16 + 4 * fq) * 2) = (v2u){b0, b1}; } \
        _Pragma("unroll") for (int t2 = 0; t2 < 4; ++t2) { f32x4 d = P_##g[t2]; \
            d = MFMA16(as_frag(P_##m[t2][0]), as_frag(sh[0]), d); d = MFMA16(as_frag(P_##m[t2][1]), as_frag(sh[1]), d); acc[t2] = d; } } while (0)
    f32x4 Ag[4], Bg[4], Cg[4]; v4u Am[4][2], Bm[4][2], Cm[4][2];
    S2_LOAD(A, 0); S2_LOAD(B, 1); S2_LOAD(C, 2);
    S2_WAIT(A, 24); S2_STEP(A, 0); S2_LOAD(A, 3);
    S2_WAIT(B, 28); S2_STEP(B, 1); S2_LOAD(B, 4);
    S2_WAIT(C, 32); S2_STEP(C, 2); S2_LOAD(C, 5);
#pragma unroll 1
    for (int c = 3; c < 126; c += 3) {
        S2_WAIT(A, 32); S2_STEP(A, c); S2_LOAD(A, c + 3);
        S2_WAIT(B, 32); S2_STEP(B, c + 1); if (c + 4 < 128) S2_LOAD(B, c + 4);
        S2_WAIT(C, 32); S2_STEP(C, c + 2); if (c + 5 < 128) S2_LOAD(C, c + 5);
    }
    S2_WAIT(A, 0); S2_STEP(A, 126); S2_WAIT(B, 0); S2_STEP(B, 127);
#undef S2_GLD
#undef S2_LOAD
#undef S2_WAIT
#undef S2_STEP
}
DI void rwkv_chunk_stage3(KArgs A, const Frame& F, int item, int l) {
    const int b = item >> 10, h = (item >> 7) & 7, c = item & 127, lane = F.lane, fr = lane & 15, fq = lane >> 4;
    const size_t t0 = (size_t)b * SEQ + 64 * c;
    const unsigned char* ck = A->ws + WS_CK + (size_t)item * CK_STRIDE;
    const f32x4* SC = (const f32x4*)(A->ws + WS_RWSC); const bf16* Gt = (const bf16*)((const float*)(A->ws + WS_RW) + 6 * RWB) + t0 * GW + 64 * h; bf16* Yc = (bf16*)(A->ws + WS_YCAT) + t0 * D + 512 + 64 * h;
    float gng[4], gnb[4];
#pragma unroll
    for (int tv = 0; tv < 4; ++tv) { gng[tv] = A->in[I_GNG][l * GW + 64 * h + 16 * tv + fr]; gnb[tv] = A->in[I_GNB][l * GW + 64 * h + 16 * tv + fr]; }
    bf16x8 s0f[4][2], uf[4][2];
#pragma unroll
    for (int tv = 0; tv < 4; ++tv) { const unsigned char* rs = ck + CK_S0 + (16 * tv + fr) * 128 + 16 * fq; s0f[tv][0] = as_frag(ld16(rs)); s0f[tv][1] = as_frag(ld16(rs + 64)); }
#pragma unroll
    for (int tv = 0; tv < 4; ++tv) { f32x4 u[4];
#pragma unroll
        for (int tt = 0; tt < 4; ++tt) { const unsigned char* rw = ck + CK_WT + (16 * tt + fr) * 128 + 16 * fq;
            f32x4 d = {0.f, 0.f, 0.f, 0.f}; d = MFMA16(as_frag(ld16(rw)), s0f[tv][0], d); d = MFMA16(as_frag(ld16(rw + 64)), s0f[tv][1], d);
            const v2u u0 = ld8(ck + CK_U0T + (16 * tv + fr) * 128 + (16 * tt + 4 * fq) * 2);
            u[tt] = d + (f32x4){bf_lo(u0.x), bf_hi(u0.x), bf_lo(u0.y), bf_hi(u0.y)}; }
#pragma unroll
        for (int s = 0; s < 2; ++s) uf[tv][s] = as_frag((v4u){cvt_pk_safe(u[2 * s][0], u[2 * s][1]), cvt_pk_safe(u[2 * s][2], u[2 * s][3]), cvt_pk_safe(u[2 * s + 1][0], u[2 * s + 1][1]), cvt_pk_safe(u[2 * s + 1][2], u[2 * s + 1][3])}); }
#pragma unroll 1
    for (int tt = 0; tt < 4; ++tt) {
        const unsigned char* rr = ck + CK_RT + (16 * tt + fr) * 128 + 16 * fq; const bf16x8 fr0 = as_frag(ld16(rr)), fr1 = as_frag(ld16(rr + 64));
        float rk4[4]; unsigned short gq[4][4]; v2u vq[4];
#pragma unroll
        for (int i = 0; i < 4; ++i) rk4[i] = SC[(t0 + 16 * tt + 4 * fq + i) * 8 + h].z;
#pragma unroll
        for (int tv = 0; tv < 4; ++tv) { vq[tv] = ld8(ck + CK_VT + (16 * tv + fr) * 128 + (16 * tt + 4 * fq) * 2);
#pragma unroll
            for (int i = 0; i < 4; ++i) gq[tv][i] = Gt[(size_t)(16 * tt + 4 * fq + i) * GW + 16 * tv + fr]; }
        f32x4 arb[4], ark[4];
#pragma unroll
        for (int tj = 0; tj < 4; ++tj) { arb[tj] = (f32x4){0.f, 0.f, 0.f, 0.f}; ark[tj] = arb[tj];
            if (tj <= tt) { const unsigned char* rb = ck + CK_BT + (16 * tj + fr) * 128 + 16 * fq; const unsigned char* rk = ck + CK_KT + (16 * tj + fr) * 128 + 16 * fq;
                f32x4 db = {0.f, 0.f, 0.f, 0.f}, dk = db;
                db = MFMA16(as_frag(ld16(rb)), fr0, db); db = MFMA16(as_frag(ld16(rb + 64)), fr1, db); dk = MFMA16(as_frag(ld16(rk)), fr0, dk); dk = MFMA16(as_frag(ld16(rk + 64)), fr1, dk);
                if (tj == tt) {
#pragma unroll
                    for (int i = 0; i < 4; ++i) { const bool keep = (4 * fq + i) <= fr; db[i] = keep ? db[i] : 0.f; dk[i] = keep ? dk[i] : 0.f; } }
                arb[tj] = db; ark[tj] = dk; } }
        f32x4 y[4] = {{0.f, 0.f, 0.f, 0.f}, {0.f, 0.f, 0.f, 0.f}, {0.f, 0.f, 0.f, 0.f}, {0.f, 0.f, 0.f, 0.f}};
#pragma unroll
        for (int s = 0; s < 2; ++s) { if (2 * s <= tt) {
            const bf16x8 fb = as_frag((v4u){cvt_pk_safe(arb[2 * s][0], arb[2 * s][1]), cvt_pk_safe(arb[2 * s][2], arb[2 * s][3]), cvt_pk_safe(arb[2 * s + 1][0], arb[2 * s + 1][1]), cvt_pk_safe(arb[2 * s + 1][2], arb[2 * s + 1][3])});
            const bf16x8 fk = as_frag((v4u){cvt_pk_safe(ark[2 * s][0], ark[2 * s][1]), cvt_pk_safe(ark[2 * s][2], ark[2 * s][3]), cvt_pk_safe(ark[2 * s + 1][0], ark[2 * s + 1][1]), cvt_pk_safe(ark[2 * s + 1][2], ark[2 * s + 1][3])});
#pragma unroll
            for (int tv = 0; tv < 4; ++tv) { const unsigned char* rv = ck + CK_VT + (16 * tv + fr) * 128 + 64 * s + 8 * fq; const v2u va = ld8(rv), vb = ld8(rv + 32);
                y[tv] = MFMA16(fb, uf[tv][s], y[tv]); y[tv] = MFMA16(fk, as_frag((v4u){va.x, va.y, vb.x, vb.y}), y[tv]); } } }
#pragma unroll
        for (int tv = 0; tv < 4; ++tv) { y[tv] = MFMA16(fr0, s0f[tv][0], y[tv]); y[tv] = MFMA16(fr1, s0f[tv][1], y[tv]); }
#pragma unroll
        for (int i = 0; i < 4; ++i) {
            const float mean = allsum16((y[0][i] + y[1][i]) + (y[2][i] + y[3][i])) * (1.f / 64.f);
            const float d0 = y[0][i] - mean, d1 = y[1][i] - mean, d2 = y[2][i] - mean, d3 = y[3][i] - mean;
            const float rstd = 1.f / sqrtf(allsum16((d0 * d0 + d1 * d1) + (d2 * d2 + d3 * d3)) * (1.f / 64.f) + GN_EPS);
            const float dd[4] = {d0, d1, d2, d3};
#pragma unroll
            for (int tv = 0; tv < 4; ++tv) { const float vv = (i == 0) ? bf_lo(vq[tv].x) : (i == 1) ? bf_hi(vq[tv].x) : (i == 2) ? bf_lo(vq[tv].y) : bf_hi(vq[tv].y);
                const float r = (dd[tv] * rstd * gng[tv] + gnb[tv] + vv * rk4[i]) * bf1(gq[tv][i]);
                Yc[(size_t)(16 * tt + 4 * fq + i) * D + 16 * tv + fr] = bfbits(r); } }
    }
}

DI void rwkv_post_part(KArgs A, const Frame& F, int l, int blk0, int nblk) {
    const float* RW = (const float*)(A->ws + WS_RW); const f32x4* SC = (const f32x4*)(A->ws + WS_RWSC); bf16* Y = (bf16*)(A->ws + WS_YCAT);
    const int gw = (F.blk - blk0) * NWAVES + F.wave, NGW = nblk * NWAVES, c = 8 * F.lane, h = F.lane >> 3;
    const f32x4 g0 = *(const GAS f32x4*)(A->in[I_GNG] + l * GW + c), g1 = *(const GAS f32x4*)(A->in[I_GNG] + l * GW + c + 4), b0 = *(const GAS f32x4*)(A->in[I_GNB] + l * GW + c), b1 = *(const GAS f32x4*)(A->in[I_GNB] + l * GW + c + 4);
    for (int t = gw; t < T; t += NGW) { const size_t o = (size_t)t * GW + c;
        const float* ysrc = (CK_SEL_MASK && ((((t & (SEQ - 1)) >> 6) & CK_SEL_MASK) == CK_SEL_VAL)) ? (const float*)(A->ws + WS_Z) : RW + 7 * RWB;
        const f32x4 y0 = *(const GAS f32x4*)(ysrc + o), y1 = *(const GAS f32x4*)(ysrc + o + 4);
        const v4u vv8 = *(const GAS v4u*)((const bf16*)(RW + 5 * RWB) + o), gg8 = *(const GAS v4u*)((const bf16*)(RW + 6 * RWB) + o);
        const f32x4 v0 = {bf_lo(vv8.x), bf_hi(vv8.x), bf_lo(vv8.y), bf_hi(vv8.y)}, v1 = {bf_lo(vv8.z), bf_hi(vv8.z), bf_lo(vv8.w), bf_hi(vv8.w)},
                    q0 = {bf_lo(gg8.x), bf_hi(gg8.x), bf_lo(gg8.y), bf_hi(gg8.y)}, q1 = {bf_lo(gg8.z), bf_hi(gg8.z), bf_lo(gg8.w), bf_hi(gg8.w)};
        const float rkr = SC[(size_t)t * 8 + h].z;
        float s = (y0.x + y0.y) + (y0.z + y0.w) + (y1.x + y1.y) + (y1.z + y1.w);
        s += __shfl_xor(s, 1); s += __shfl_xor(s, 2); s += __shfl_xor(s, 4);
        const float mean = s * (1.f / 64.f); const f32x4 d0 = y0 - mean, d1 = y1 - mean;
        float s2 = (d0.x * d0.x + d0.y * d0.y) + (d0.z * d0.z + d0.w * d0.w) + (d1.x * d1.x + d1.y * d1.y) + (d1.z * d1.z + d1.w * d1.w);
        s2 += __shfl_xor(s2, 1); s2 += __shfl_xor(s2, 2); s2 += __shfl_xor(s2, 4);
        const float rstd = 1.f / sqrtf(s2 * (1.f / 64.f) + GN_EPS);
        const f32x4 r0 = (d0 * rstd * g0 + b0 + v0 * rkr) * q0, r1 = (d1 * rstd * g1 + b1 + v1 * rkr) * q1;
        v4u ov; ov.x = cvt_pk_bf16(r0.x, r0.y); ov.y = cvt_pk_bf16(r0.z, r0.w); ov.z = cvt_pk_bf16(r1.x, r1.y); ov.w = cvt_pk_bf16(r1.z, r1.w);
        *(GAS v4u*)(Y + (size_t)t * D + 512 + c) = ov; }
}

DI void phase_ln2(KArgs A, const Frame& F, int l) {
    if (l + 1 < DEPTH) mod_finalize(A, F, l + 1);
    LAS float* ms = (LAS float*)(F.lds + RING_OFF);
    stage_mod(A, ms + 4096, l, 3, 0.f, F.tid); stage_mod(A, ms, l, 4, 1.f, F.tid);
    for (int i = F.tid; i < D; i += NT) { ms[8192 + i] = A->in[I_LNG][(size_t)(l * 2 + 0) * D + i]; ms[8192 + D + i] = A->in[I_LNB][(size_t)(l * 2 + 0) * D + i]; }
    __syncthreads();
    const int gw = F.blk * NWAVES + F.wave, NGW = F.G * NWAVES;
    float* Z = (float*)(A->ws + WS_Z); bf16* H = (bf16*)(A->ws + WS_H);
    for (int row0 = gw; row0 < T; row0 += 2 * NGW) { f32x4 v[2][8];
#pragma unroll
        for (int r = 0; r < 2; ++r) { const GAS f32x4* zr = (const GAS f32x4*)(Z + (size_t)(row0 + r * NGW) * D) + F.lane;
#pragma unroll
            for (int j = 0; j < 8; ++j) v[r][j] = zr[64 * j]; }
#pragma unroll
        for (int r = 0; r < 2; ++r) { const int row = row0 + r * NGW, b = row >> 13;
            float mean, rstd; row_stats(v[r], mean, rstd);
            if (F.lane == 0) ((f32x2*)(A->ws + WS_MISC + MI_STATS))[row] = (f32x2){mean, rstd};
#pragma unroll
            for (int j = 0; j < 8; ++j) { const int c = 4 * (F.lane + 64 * j); v[r][j] = (v[r][j] - mean) * rstd * *(const LAS f32x4*)(ms + 8192 + c) + *(const LAS f32x4*)(ms + 8192 + D + c); }
            ada_store(v[r], ms + b * 2048, ms + 4096 + b * 2048, H + (size_t)row * D, nullptr, F.lane); } }
    __syncthreads();
}
DI void phase_router(KArgs A, const Frame& F, int l) {
    LAS int* cnt = (LAS int*)(F.lds + RING_OFF);
    LAS float* lg = (LAS float*)(F.lds + RING_OFF + 1024);
    if (F.tid < 32) cnt[F.tid] = 0;
    __syncthreads();
    const bf16* H = (const bf16*)(A->ws + WS_H); const bf16* HL = (const bf16*)(A->ws + WS_HLO);
    const bf16* Wh = (const bf16*)(A->ws + WS_ROUT); const bf16* Wl = Wh + 48 * 2048;
    const int lane = F.lane, fr = lane & 15, fq = lane >> 4;
    for (int grp = F.blk * 4 + F.wave; F.wave < 4 && grp < T / 16; grp += F.G * 4) {
        const int t0 = grp * 16;
        f32x4 acc[3] = {{0.f, 0.f, 0.f, 0.f}, {0.f, 0.f, 0.f, 0.f}, {0.f, 0.f, 0.f, 0.f}};
        const bf16* hp = H + (size_t)(t0 + fr) * D + 8 * fq;
#pragma unroll 2
        for (int s = 0; s < 64; ++s) { const bf16x8 xh = as_frag(*(const GAS v4u*)(hp + 32 * s));
#pragma unroll
            for (int nt = 0; nt < 3; ++nt) { const size_t wo = (size_t)(16 * nt + fr) * D + 32 * s + 8 * fq;
                const bf16x8 wh = as_frag(*(const GAS v4u*)(Wh + wo)), wl = as_frag(*(const GAS v4u*)(Wl + wo));
                acc[nt] = MFMA16(wh, xh, acc[nt]); acc[nt] = MFMA16(wl, xh, acc[nt]); } }
        LAS float* my = lg + F.wave * (16 * 48);
#pragma unroll
        for (int nt = 0; nt < 3; ++nt)
#pragma unroll
            for (int i = 0; i < 4; ++i) my[fr * 48 + 16 * nt + 4 * fq + i] = acc[nt][i];
        LDS_WAIT();
        if (lane < 16) { const int t = t0 + lane; const LAS float* q = my + lane * 48;
            float gl[4]; int gi = 0; float gm = -3.4e38f;
#pragma unroll
            for (int j = 0; j < 4; ++j) { gl[j] = q[j] + A->in[I_RGB][l * 4 + j]; if (gl[j] > gm) { gm = gl[j]; gi = j; } }
            float gs = 0.f;
#pragma unroll
            for (int j = 0; j < 4; ++j) gs += __expf(gl[j] - gm);
            const float gval = 1.f / gs;
            float e1 = -3.4e38f, e2 = -3.4e38f; int i1 = 0, i2 = 0;
            for (int j = 0; j < 8; ++j) { const float v = q[4 + 8 * gi + j] + A->in[I_REB][l * 32 + 8 * gi + j];
                if (v > e1) { e2 = e1; i2 = i1; e1 = v; i1 = j; } else if (v > e2) { e2 = v; i2 = j; } }
            const float w2 = gval / (1.f + __expf(e1 - e2)), w1 = gval - w2;
            const int id1 = 8 * gi + i1, id2 = 8 * gi + i2;
            ((i32x2*)(A->ws + WS_MISC + MI_ROUTE_E))[t] = (i32x2){id1, id2};
            ((f32x2*)(A->ws + WS_MISC + MI_ROUTE_W))[t] = (f32x2){w1, w2};
            __hip_atomic_fetch_add(&cnt[id1], 1, __ATOMIC_RELAXED, __HIP_MEMORY_SCOPE_WORKGROUP); __hip_atomic_fetch_add(&cnt[id2], 1, __ATOMIC_RELAXED, __HIP_MEMORY_SCOPE_WORKGROUP); }
        LDS_WAIT();
    }
    __syncthreads();
    if (F.tid < 32) ((int*)(A->ws + WS_MISC + MI_COUNTS))[F.blk * 32 + F.tid] = cnt[F.tid];
    __syncthreads();
}
DI void phase_dispatch(KArgs A, const Frame& F) {
    LAS int* tot = (LAS int*)(F.lds + RING_OFF);
    LAS int* pre = tot + 32; LAS int* pst = tot + 64; LAS int* part = tot + 96; LAS int* ids = part + 16 * 64; LAS int* dst = ids + 128;
    const int* counts = (const int*)(A->ws + WS_MISC + MI_COUNTS);
    { const int e = F.tid & 31, pt = F.tid >> 5; int s = 0, sp = 0;
      for (int k = 0; k < 16; ++k) { const int bb = pt * 16 + k; if (bb < F.G) { const int c = counts[bb * 32 + e]; s += c; if (bb < F.blk) sp += c; } }
      part[pt * 64 + e] = s; part[pt * 64 + 32 + e] = sp; }
    __syncthreads();
    if (F.tid < 32) { int s = 0, sp = 0; for (int k = 0; k < 16; ++k) { s += part[k * 64 + F.tid]; sp += part[k * 64 + 32 + F.tid]; } tot[F.tid] = s; pre[F.tid] = sp; }
    if (F.tid >= 64 && F.tid < 64 + 64) { const int tk = F.tid - 64; const i32x2 e = ((const i32x2*)(A->ws + WS_MISC + MI_ROUTE_E))[F.blk * 64 + tk]; ids[2 * tk] = e.x; ids[2 * tk + 1] = e.y; }
    __syncthreads();
    if (F.tid == 0) { int s = 0; for (int e = 0; e < 32; ++e) { pst[e] = s; s += (tot[e] + 255) & ~255; }
        if (F.blk == 0) { int* te = (int*)(A->ws + WS_MISC + MI_TILEE); int tl = 0; for (int e = 0; e < 32; ++e) { const int n = (tot[e] + 255) >> 8; for (int k = 0; k < n; ++k) te[tl++] = e; } te[MAXTILES] = tl; } }
    __syncthreads();
    if (F.tid < 32) { int run = pst[F.tid] + pre[F.tid]; for (int a = 0; a < 128; ++a) if (ids[a] == F.tid) dst[a] = run++; }
    __syncthreads();
    if (F.tid < 64) { const int t = F.blk * 64 + F.tid; ((i32x2*)(A->ws + WS_MISC + MI_DEST))[t] = (i32x2){dst[2 * F.tid], dst[2 * F.tid + 1]};
        const f32x2 w = ((const f32x2*)(A->ws + WS_MISC + MI_ROUTE_W))[t]; float* rw = (float*)(A->ws + WS_MISC + MI_ROWW); rw[dst[2 * F.tid]] = w.x; rw[dst[2 * F.tid + 1]] = w.y; }
    const bf16* H = (const bf16*)(A->ws + WS_H); bf16* XB = (bf16*)(A->ws + WS_XB);
    for (int a = (F.tid >> 8); a < 128; a += 2) { const int t = F.blk * 64 + (a >> 1), c = (F.tid & 255) * 8;
        *(GAS v4u*)(XB + (size_t)dst[a] * D + c) = *(const GAS v4u*)(H + (size_t)t * D + c); }
    __syncthreads();
}
DI void phase_ln3(KArgs A, const Frame& F, int l, float* xout) {
    LAS float* ms = (LAS float*)(F.lds + RING_OFF);
    const bool next = (l + 1 < DEPTH);
    stage_mod(A, ms, l, 5, 1.f, F.tid);
    if (next) { stage_mod(A, ms + 4096, l + 1, 1, 1.f, F.tid); stage_mod(A, ms + 8192, l + 1, 0, 0.f, F.tid); }
    for (int i = F.tid; i < D; i += NT) { ms[12288 + i] = A->in[I_LNG][(size_t)(l * 2 + 1) * D + i]; ms[12288 + D + i] = A->in[I_LNB][(size_t)(l * 2 + 1) * D + i];
        ms[16384 + i] = A->in[I_LNG][(size_t)(l * 2 + 0) * D + i]; ms[16384 + D + i] = A->in[I_LNB][(size_t)(l * 2 + 0) * D + i]; }
    __syncthreads();
    const int gw = F.blk * NWAVES + F.wave, NGW = F.G * NWAVES;
    const f32x2* stats = (const f32x2*)(A->ws + WS_MISC + MI_STATS);
    const float* Z = (const float*)(A->ws + WS_Z); const bf16* YR = (const bf16*)(A->ws + WS_YR); bf16* H = (bf16*)(A->ws + WS_H);
    const i32x2* dest = (const i32x2*)(A->ws + WS_MISC + MI_DEST);
    for (int row0 = gw; row0 < T; row0 += 2 * NGW) { f32x4 v[2][8];
        const i32x2 d0 = dest[row0], d1 = dest[row0 + NGW];
#pragma unroll
        for (int r = 0; r < 2; ++r) { const GAS f32x4* zr = (const GAS f32x4*)(Z + (size_t)(row0 + r * NGW) * D) + F.lane;
#pragma unroll
            for (int j = 0; j < 8; ++j) v[r][j] = zr[64 * j]; }
#pragma unroll
        for (int r = 0; r < 2; ++r) { const int row = row0 + r * NGW, b = row >> 13; const i32x2 d = r ? d1 : d0; const f32x2 st = stats[row];
            const GAS v2u* y0 = (const GAS v2u*)(YR + (size_t)d.x * D) + F.lane; const GAS v2u* y1 = (const GAS v2u*)(YR + (size_t)d.y * D) + F.lane;
            v2u ya[8], yb[8];
#pragma unroll
            for (int j = 0; j < 8; ++j) { ya[j] = y0[64 * j]; yb[j] = y1[64 * j]; }
            __builtin_amdgcn_sched_barrier(0);
#pragma unroll
            for (int j = 0; j < 8; ++j) { const int c = 4 * (F.lane + 64 * j); const v2u a = ya[j], q = yb[j]; const f32x4 gt = *(const LAS f32x4*)(ms + b * 2048 + c);
                const f32x4 ym = {bf_lo(a.x) + bf_lo(q.x), bf_hi(a.x) + bf_hi(q.x), bf_lo(a.y) + bf_lo(q.y), bf_hi(a.y) + bf_hi(q.y)};
                const f32x4 x1 = (v[r][j] - st.x) * st.y * *(const LAS f32x4*)(ms + 16384 + c) + *(const LAS f32x4*)(ms + 16384 + D + c);
                v[r][j] = x1 * ALPHA + gt * ym; }
            float mean, rstd; row_stats(v[r], mean, rstd);
            GAS f32x4* xo = (GAS f32x4*)(xout + (size_t)row * D) + F.lane;
#pragma unroll
            for (int j = 0; j < 8; ++j) { const int c = 4 * (F.lane + 64 * j); v[r][j] = (v[r][j] - mean) * rstd * *(const LAS f32x4*)(ms + 12288 + c) + *(const LAS f32x4*)(ms + 12288 + D + c); xo[64 * j] = v[r][j]; }
            if (next) ada_store(v[r], ms + 4096 + b * 2048, ms + 8192 + b * 2048, H + (size_t)row * D, nullptr, F.lane);
            __builtin_amdgcn_sched_barrier(0); } }
    __syncthreads();
}

constexpr int NPH = 15;
#ifdef ONLY_PHASE
#define IN(k) ((((k) % NPH) == ONLY_PHASE) && lo <= (k) && (k) < hi)
#else
#define IN(k) (lo <= (k) && (k) < hi)
#endif
#ifndef REPMASK
#define REPMASK 0
#endif
#ifndef BARREP
#define BARREP 1
#endif
#define REP4A 1
#define REP4B 1
#define REP_S2 1
#define REP_PREP 1
#define REP_S5A 1
#define REP_S5C 1
#define REP_CONV 1
#define REP_ATT 1
#define REP_ST1 1
#define NREP(k) (1 + ((REPMASK >> (k)) & 1))
#define SEAM(k) do { if (IN(k) && IN((k) + 1)) { for (int br_ = 0; br_ < BARREP; ++br_) xcd_barrier(bar); } } while (0)
template <int l> DI void run_layer(KArgs A0, LAS unsigned char* lds, const XcdBarrier& bar, const int lo, const int hi, const int wv) {
    KArgs A = A0; Frame F;
    {
        constexpr int p0 = l * NPH;

        for (int rep_ = 0; rep_ < NREP(0); ++rep_) { A = launder(A0); F = mkframe(lds, wv); if (IN(p0 + 0) && l == 0) phase_wprep_a(A, F, l, F.blk * NWAVES + F.wave, F.G * NWAVES);
        if (NREP(0) > 1) __syncthreads(); } SEAM(p0 + 0);
        for (int rep_ = 0; rep_ < NREP(1); ++rep_) { A = launder(A0); F = mkframe(lds, wv); if (IN(p0 + 1) && l == 0) phase_ln_in(A, F, l);
        if (NREP(1) > 1) __syncthreads(); } SEAM(p0 + 1);
        for (int rep_ = 0; rep_ < NREP(2); ++rep_) { A = launder(A0); F = mkframe(lds, wv); if (IN(p0 + 2)) { pg8::Gemm g{(const bf16*)(A->ws + WS_H), (const bf16*)(A->ws + ws_win(l)), D}; pg8::StaticOrder S; S.init(T, NINP, F.G, F.blk);
            EpiP E{(bf16*)(A->ws + WS_P), NINP}; pg8::gemm_phase<EpiP, pg8::StaticOrder, true, true>(F.lds + RING_OFF, g, S, E, F.wave); }
        if (NREP(2) > 1) __syncthreads(); } SEAM(p0 + 2);
        for (int rep_ = 0; rep_ < NREP(3); ++rep_) { A = launder(A0); F = mkframe(lds, wv); if (IN(p0 + 3)) { for (int q_ = 0; q_ < REP_S5A; ++q_) s5_pass1_mfma(A, F, l); for (int q_ = 0; q_ < REP_PREP; ++q_) rwkv_prep_part(A, F, l, 0, F.G); }
        if (NREP(3) > 1) __syncthreads(); } SEAM(p0 + 3);
        for (int rep_ = 0; rep_ < NREP(4); ++rep_) { A = launder(A0); F = mkframe(lds, wv); if (IN(p0 + 4)) {
            if (F.blk < 8) s5_carry(A, F, l, 0);
            for (int q_ = 0; q_ < REP_ATT; ++q_) attn_part(A, F, l, 0, F.G, 0, 256);
            __syncthreads();
            { const int item = F.blk * NWAVES + F.wave; for (int q_ = 0; q_ < REP_ST1; ++q_) if (CKEN & 1) if (item < 2048) rwkv_chunk_stage1(A, F, item, (LAS float*)(F.lds + RING_OFF + F.wave * 16384)); } }
        if (NREP(4) > 1) __syncthreads(); } SEAM(p0 + 4);
        for (int rep_ = 0; rep_ < NREP(5); ++rep_) { A = launder(A0); F = mkframe(lds, wv); if (IN(p0 + 5)) {
            if (F.blk < S2WG) { for (int r2_ = 0; r2_ < REP_S2; ++r2_) if (F.wave < 2) rwkv_chunk_stage2(A, F, F.blk >> 1, 2 * (F.blk & 1) + F.wave); }
            else if (CHUNK_Y_TO_Z && F.blk < 72) rwkv_scan(A, F, F.blk - 8);
            else { constexpr int B0 = S2WG; const int nb = F.G - B0;
                if (F.wave < 4) { const int cw = (F.blk - B0) * 4 + F.wave, NCW = nb * 4;
                    for (int q_ = 0; q_ < REP_S5C; ++q_) s5_pass<true>(A, F, l, cw, NCW); for (int q_ = 0; q_ < REP_CONV; ++q_) conv_part(A, F, l, cw, NCW);
                    if (l + 1 < DEPTH) phase_wprep_a(A, F, l + 1, cw, NCW, 2); }
                else { const int mw = (F.blk - B0) * 4 + F.wave - 4, NMW = nb * 4;
                    for (int r4_ = 0; r4_ < REP4B; ++r4_) phase_wprep_b(A, F, l, mw, NMW);
                    if (l + 1 < DEPTH) phase_wprep_a(A, F, l + 1, mw, NMW, 1); } } }
        if (NREP(5) > 1) __syncthreads(); } SEAM(p0 + 5);
        for (int rep_ = 0; rep_ < NREP(6); ++rep_) { A = launder(A0); F = mkframe(lds, wv); if (IN(p0 + 6)) {
            const int item = F.blk * NWAVES + F.wave; if (item < 2048) rwkv_chunk_stage3(A, F, item, l); }
        if (NREP(6) > 1) __syncthreads(); } SEAM(p0 + 6);
        for (int rep_ = 0; rep_ < NREP(7); ++rep_) { A = launder(A0); F = mkframe(lds, wv); if (IN(p0 + 7)) {
            constexpr int GLUWG = 128;
            if (F.blk < GLUWG) { pg8::Gemm g{(const bf16*)(A->ws + WS_YS), (const bf16*)(A->ws + WS_GLU), 512}; pg8::StaticOrder S; S.init(T, 512, GLUWG, F.blk);
                EpiGlu E{(const bf16*)(A->ws + WS_YS), (bf16*)(A->ws + WS_YCAT), A->in[I_GLUB] + l * GW}; pg8::gemm_phase<EpiGlu, pg8::StaticOrder, true, true>(F.lds + RING_OFF, g, S, E, F.wave); } }
        if (NREP(7) > 1) __syncthreads(); } SEAM(p0 + 7);
        for (int rep_ = 0; rep_ < NREP(8); ++rep_) { A = launder(A0); F = mkframe(lds, wv); if (IN(p0 + 8)) { LAS float* g1p = (LAS float*)(F.lds + XTRA_OFF); stage_mod(A, g1p, l, 2, 1.f, F.tid); __syncthreads();
            pg8::Gemm g{(const bf16*)(A->ws + WS_YCAT), (const bf16*)(A->ws + WS_WOUT), D}; pg8::StaticOrder S; S.init(T, D, F.G, F.blk);
            const float* xin = (l == 0) ? A->in[I_X] : (const float*)A->out; EpiZ E{xin, (float*)(A->ws + WS_Z), g1p}; pg8::gemm_phase<EpiZ, pg8::StaticOrder, true, true>(F.lds + RING_OFF, g, S, E, F.wave); }
        if (NREP(8) > 1) __syncthreads(); } SEAM(p0 + 8);
        for (int rep_ = 0; rep_ < NREP(9); ++rep_) { A = launder(A0); F = mkframe(lds, wv); if (IN(p0 + 9)) phase_ln2(A, F, l);
        if (NREP(9) > 1) __syncthreads(); } SEAM(p0 + 9);
        for (int rep_ = 0; rep_ < NREP(10); ++rep_) { A = launder(A0); F = mkframe(lds, wv); if (IN(p0 + 10)) phase_router(A, F, l);
        if (NREP(10) > 1) __syncthreads(); } SEAM(p0 + 10);
        for (int rep_ = 0; rep_ < NREP(11); ++rep_) { A = launder(A0); F = mkframe(lds, wv); if (IN(p0 + 11)) phase_dispatch(A, F);
        if (NREP(11) > 1) __syncthreads(); } SEAM(p0 + 11);
        for (int rep_ = 0; rep_ < NREP(12); ++rep_) { A = launder(A0); F = mkframe(lds, wv); if (IN(p0 + 12)) { const int* te = (const int*)(A->ws + WS_MISC + MI_TILEE); pg8::Gemm g{(const bf16*)(A->ws + WS_XB), (const bf16*)(A->ws + WS_W13), D};
            pg8::GroupedOrder S{te[MAXTILES], 4, F.G, F.blk, te}; EpiMoeA E{(bf16*)(A->ws + WS_HMID)}; pg8::gemm_phase<EpiMoeA, pg8::GroupedOrder, true, true>(F.lds + RING_OFF, g, S, E, F.wave); }
        if (NREP(12) > 1) __syncthreads(); } SEAM(p0 + 12);
        for (int rep_ = 0; rep_ < NREP(13); ++rep_) { A = launder(A0); F = mkframe(lds, wv); if (IN(p0 + 13)) { const int* te = (const int*)(A->ws + WS_MISC + MI_TILEE); pg8::Gemm g{(const bf16*)(A->ws + WS_HMID), (const bf16*)(A->ws + WS_W2), DEXP};
            pg8::GroupedOrder S{te[MAXTILES], 8, F.G, F.blk, te}; EpiMoeB E{(bf16*)(A->ws + WS_YR), (const float*)(A->ws + WS_MISC + MI_ROWW)}; pg8::gemm_phase<EpiMoeB, pg8::GroupedOrder, true, true>(F.lds + RING_OFF, g, S, E, F.wave); }
        if (NREP(13) > 1) __syncthreads(); } SEAM(p0 + 13);
        for (int rep_ = 0; rep_ < NREP(14); ++rep_) { A = launder(A0); F = mkframe(lds, wv); if (IN(p0 + 14)) phase_ln3(A, F, l, A->out);
        if (NREP(14) > 1) __syncthreads(); } SEAM(p0 + 14);
    }
}
__global__ void __launch_bounds__(NT, 2) hybrid_fwd(Args Aval) {
    KArgs A0 = (KArgs)__builtin_amdgcn_kernarg_segment_ptr(); KArgs A = A0;
    extern __shared__ __attribute__((aligned(16))) unsigned char lds[];
    Frame F;
    F.lds = (LAS unsigned char*)lds;
    F.tid = threadIdx.x; F.lane = F.tid & 63; F.wave = __builtin_amdgcn_readfirstlane(F.tid >> 6);
    F.G = gridDim.x; F.blk = blockIdx.x;
    volatile LAS unsigned* MISC = (volatile LAS unsigned*)(F.lds + MISC_OFF);
    for (int u = F.tid; u < 1024 / 4; u += NT) ((LAS unsigned*)(F.lds + LDSCTL_OFF))[u] = 0u;
    __syncthreads();
    XcdBarrier bar = xcd_barrier_post((unsigned*)(A->ws + WS_CTL) + CW_BAR, MISC + 8);
    const int lo = A->ph_lo, hi = A->ph_hi;
    const int wv = F.wave;
    run_layer<0>(A0, (LAS unsigned char*)lds, bar, lo, hi, wv);
    run_layer<1>(A0, (LAS unsigned char*)lds, bar, lo, hi, wv);
}

#ifndef N_LAUNCH_MODE
#define N_LAUNCH_MODE 1
#endif
extern "C" void kernel_launch(void* const* d_in, const int* in_sizes, int n_in, void* d_out, int out_size, void* d_ws, size_t ws_size, hipStream_t stream) {
    static int grid = 0;
    if (grid == 0) {
        if (n_in != 39 || out_size != T * D || ws_size < WS_END) { fprintf(stderr, "kernel_launch: unexpected shapes (n_in %d, out %d, ws %zu)\n", n_in, out_size, ws_size); grid = -1; return; }
        int dev = 0, cus = 0, per_cu = 0;
        if (hipGetDevice(&dev) != hipSuccess || hipDeviceGetAttribute(&cus, hipDeviceAttributeMultiprocessorCount, dev) != hipSuccess) { grid = -1; return; }
        if (hipFuncSetAttribute((const void*)hybrid_fwd, hipFuncAttributeMaxDynamicSharedMemorySize, LDS_BYTES) != hipSuccess) { fprintf(stderr, "kernel_launch: hipFuncSetAttribute failed\n"); grid = -1; return; }
        if (hipOccupancyMaxActiveBlocksPerMultiprocessor(&per_cu, (const void*)hybrid_fwd, NT, LDS_BYTES) != hipSuccess || per_cu < 1) fprintf(stderr, "kernel_launch: occupancy query says %d\n", per_cu);
        (void)hipGetLastError();
        grid = cus;
        if (grid != 256) { fprintf(stderr, "kernel_launch: %d CUs; this kernel is built for 256\n", grid); grid = -1; return; }
    }
    if (grid < 0) return;
    Args a{};
    for (int i = 0; i < 39; ++i) a.in[i] = (const float*)d_in[i];
    a.out = (float*)d_out; a.ws = (unsigned char*)d_ws;
#if N_LAUNCH_MODE == 1
    (void)hipMemsetAsync((char*)d_ws + WS_CTL, 0, CTL_ZERO_BYTES, stream);
    a.ph_lo = 0; a.ph_hi = DEPTH * NPH;
    hipLaunchKernelGGL(hybrid_fwd, dim3(grid), dim3(NT), LDS_BYTES, stream, a);
#else
    for (int ph = 0; ph < DEPTH * NPH; ++ph) {
        if (ph == 1 * NPH + 1) continue;
        (void)hipMemsetAsync((char*)d_ws + WS_CTL, 0, CTL_ZERO_BYTES, stream);
        a.ph_lo = ph; a.ph_hi = ph + 1;
        hipLaunchKernelGGL(hybrid_fwd, dim3(grid), dim3(NT), LDS_BYTES, stream, a);
    }
#endif
}
```

```cpp
#include <hip/hip_runtime.h>
#include <cstdio>
#include <cstdint>
namespace pg8 {
#define PG8_LAS __attribute__((address_space(3)))
typedef unsigned short bf16_t;
typedef short bf16x8 __attribute__((ext_vector_type(8)));
typedef float f32x4 __attribute__((ext_vector_type(4)));
typedef unsigned u32x4 __attribute__((ext_vector_type(4)));
constexpr int BM = 256, BK = 64, HALF = 128, HTB = HALF * BK * 2  , STAGE_BYTES = 8 * HTB, NXCD = 8, WGM = 8;

__host__ __device__ __forceinline__ int lds_byte(int r, int c) { const int st = (r >> 4) * 2 + (c >> 5), rr = r & 15, cc = c & 31, ob = rr * 64 + cc * 2; return st * 1024 + (ob ^ (((ob >> 9) & 1) << 5)); }
__host__ __device__ __forceinline__ void stage_rc(int b, int& R, int& C) { const int st = b / 1024, sb = b % 1024, swz = sb ^ (((sb >> 9) & 1) << 5); R = (st >> 1) * 16 + swz / 64; C = (st & 1) * 32 + (swz % 64) / 2; }
__host__ __device__ __forceinline__ int perm32(int rho) { const int n = rho >> 4, i = rho & 15; return 8 * (i >> 2) + 4 * n + (i & 3); }


struct Unit { int pm, pn, po; };
struct Gemm { const bf16_t* A; const bf16_t* Bt; int K; };

struct StaticOrder {
    int nM, nN, nwg, G, c;
    __device__ void init(int M, int N, int G_, int c_) { nM = M / BM; nN = N / BM; nwg = nM * nN; G = G_; c = c_; }
    __device__ bool next(int i, Unit& u) const {
        const long L = (long)i * G + c; if (L >= nwg) return false;
        int wgid = (int)L; { const int q = nwg / NXCD, r = nwg % NXCD, xcd = wgid % NXCD, off = wgid / NXCD; wgid = (xcd < r ? xcd * (q + 1) : r * (q + 1) + (xcd - r) * q) + off; }
        const int nig = WGM * nN, gid = wgid / nig, fm = gid * WGM, gsz = (nM - fm) < WGM ? (nM - fm) : WGM;
        u.pm = fm + ((wgid % nig) % gsz); u.pn = (wgid % nig) / gsz; u.po = u.pn; return true;
    }
    __device__ __forceinline__ void a_ready(const Unit&) const {}
    __device__ __forceinline__ void done(const Unit&) const {}
};
struct GroupedOrder {
    int ntiles, npn, G, c; const int* tile_e;
    __device__ bool next(int i, Unit& u) const {
        const int idx = c >> 3, pn = idx % npn, rpx = (G >> 3) / npn, t = (i * 8 + (c & 7)) * rpx + idx / npn; if (t >= ntiles) return false;
        u.pm = t; u.po = pn; u.pn = tile_e[t] * npn + pn; return true;
    }
    __device__ __forceinline__ void a_ready(const Unit&) const {}
    __device__ __forceinline__ void done(const Unit&) const {}
};
__device__ __forceinline__ unsigned cvt_pk_bf16(float lo, float hi) { unsigned r; asm volatile("s_nop 0\n\tv_cvt_pk_bf16_f32 %0, %1, %2" : "=v"(r) : "v"(lo), "v"(hi)); return r; }
template <class Epi, class Sched, bool ALIGN_EPI = false, bool SP2 = false>
__device__ __forceinline__ void gemm_phase(PG8_LAS unsigned char* lds, const Gemm g, const Sched& S, const Epi& E, int wv) {
    int tid_ = (wv << 6) | (int)__builtin_amdgcn_mbcnt_hi(~0u, __builtin_amdgcn_mbcnt_lo(~0u, 0u)); asm volatile("" : "+v"(tid_));
    const int tid = tid_, wid = __builtin_amdgcn_readfirstlane(tid >> 6), lane = tid & 63, wr = wid >> 2, wc = wid & 3, fr = lane & 15, fq = lane >> 4;
    const int K = g.K, nt = K / BK;
    unsigned voffA[2], voffB[2];
#pragma unroll
    for (int i = 0; i < 2; ++i) { int R, C; stage_rc(tid * 16 + i * 8192, R, C); const int Rb = Epi::PERM ? ((R & ~31) + perm32(R & 31)) : R;
        voffA[i] = (unsigned)(R * K + C) * 2u; voffB[i] = (unsigned)(Rb * K + C) * 2u; }
    const size_t kstep = (size_t)(BK * 2);
    const size_t hstep = (size_t)HALF * K * 2;
    const size_t tstep = 2 * hstep;
    const unsigned ldsw = (unsigned)wid * 1024u;
    const int aoff = lds_byte(wr * 64 + fr, fq * 8), boff = lds_byte(wc * 32 + fr, fq * 8);
#define PG8_SA(b, h) (((b) * 2 + (h)) * HTB)
#define PG8_SB(b, h) ((4 + (b) * 2 + (h)) * HTB)
#define PG8_STAGE(bufoff, gbase, voff) do { _Pragma("unroll") for (int _i = 0; _i < 2; ++_i) \
        __builtin_amdgcn_global_load_lds((const unsigned*)((const char*)(gbase) + (voff)[_i]), (PG8_LAS unsigned*)(lds + (bufoff) + ldsw + _i * 8192), 16, 0, 0); } while (0)
#define PG8_LDA(dst, b, h) do { _Pragma("unroll") for (int m = 0; m < 4; ++m) _Pragma("unroll") for (int k = 0; k < 2; ++k) dst[m][k] = *(const PG8_LAS bf16x8*)(lds + PG8_SA(b, h) + aoff + m * 2048 + k * 1024); } while (0)
#define PG8_LDB(dst, b, h) do { _Pragma("unroll") for (int n = 0; n < 2; ++n) _Pragma("unroll") for (int k = 0; k < 2; ++k) dst[n][k] = *(const PG8_LAS bf16x8*)(lds + PG8_SB(b, h) + boff + n * 2048 + k * 1024); } while (0)
#define PG8_MMA(ai, bj, At, Bt) do { __builtin_amdgcn_s_setprio(1); _Pragma("unroll") for (int m = 0; m < 4; ++m) _Pragma("unroll") for (int n = 0; n < 2; ++n) _Pragma("unroll") for (int k = 0; k < 2; ++k) \
        acc[ai][bj][m][n] = __builtin_amdgcn_mfma_f32_16x16x32_bf16(Bt[n][k], At[m][k], acc[ai][bj][m][n], 0, 0, 0); __builtin_amdgcn_s_setprio(0); } while (0)
#define PG8_WAIT_V(n) asm volatile("s_waitcnt vmcnt(" #n ")" ::: "memory")
#define PG8_WAIT_L(n) asm volatile("s_waitcnt lgkmcnt(" #n ")" ::: "memory")
#define PG8_BAR __builtin_amdgcn_s_barrier()
#define PG8_SCHED __builtin_amdgcn_sched_barrier(0)
    Unit cur, nxt; int ui = 0;
    if (!S.next(0, cur)) return;
    f32x4 acc[2][2][4][2];
#pragma unroll
    for (int a = 0; a < 2; ++a)
#pragma unroll
        for (int b = 0; b < 2; ++b)
#pragma unroll
            for (int m = 0; m < 4; ++m)
#pragma unroll
                for (int n = 0; n < 2; ++n) acc[a][b][m][n] = (f32x4){0.f, 0.f, 0.f, 0.f};
    bf16x8 At[4][2], B0[2][2], B1[2][2];
    const char* cA = (const char*)g.A + (size_t)cur.pm * tstep; const char* cB = (const char*)g.Bt + (size_t)cur.pn * tstep;
    S.a_ready(cur);
    if constexpr (SP2) {
        PG8_STAGE(PG8_SB(0, 0), cB, voffB); PG8_STAGE(PG8_SB(0, 1), cB + hstep, voffB); PG8_STAGE(PG8_SA(0, 0), cA, voffA); PG8_STAGE(PG8_SA(0, 1), cA + hstep, voffA);
        if (wr == 1) PG8_BAR;
        PG8_WAIT_V(2); PG8_BAR;
        PG8_STAGE(PG8_SB(1, 0), cB + kstep, voffB); PG8_STAGE(PG8_SA(1, 0), cA + kstep, voffA); PG8_STAGE(PG8_SB(1, 1), cB + hstep + kstep, voffB);
        PG8_WAIT_V(6); PG8_BAR;
    } else {
        PG8_STAGE(PG8_SB(0, 0), cB, voffB); PG8_STAGE(PG8_SA(0, 0), cA, voffA); PG8_STAGE(PG8_SB(0, 1), cB + hstep, voffB); PG8_STAGE(PG8_SA(0, 1), cA + hstep, voffA);
        if (wr == 1) PG8_BAR;
        PG8_WAIT_V(4); PG8_BAR;
        PG8_STAGE(PG8_SB(1, 0), cB + kstep, voffB); PG8_STAGE(PG8_SA(1, 0), cA + kstep, voffA); PG8_STAGE(PG8_SB(1, 1), cB + hstep + kstep, voffB);
        PG8_WAIT_V(6); PG8_BAR;
    }
    for (;;) {
        const bool has_next = S.next(ui + 1, nxt);
        const char* nA = has_next ? (const char*)g.A + (size_t)nxt.pm * tstep : cA; const char* nB = has_next ? (const char*)g.Bt + (size_t)nxt.pn * tstep : cB;
        asm volatile(".p2align 8");
        for (int t = 0; t < nt; t += 2) {
            const bool last = (t == nt - 2);
            const char* a1 = cA + (size_t)(t + 1) * kstep;
            const char* a2 = last ? nA : cA + (size_t)(t + 2) * kstep; const char* b2 = last ? nB : cB + (size_t)(t + 2) * kstep;
            const char* a3 = a2 + kstep; const char* b3 = b2 + kstep;
            if (last && has_next) S.a_ready(nxt);
            if constexpr (SP2) {
            PG8_LDB(B0, 0, 0); PG8_LDB(B1, 0, 1); PG8_SCHED; PG8_LDA(At, 0, 0); PG8_STAGE(PG8_SA(1, 1), a1 + hstep, voffA);
            PG8_WAIT_V(8); PG8_WAIT_L(0); PG8_BAR; PG8_MMA(0, 0, At, B0); PG8_MMA(0, 1, At, B1); PG8_BAR; PG8_SCHED;
            PG8_LDA(At, 0, 1); PG8_STAGE(PG8_SB(0, 0), b2, voffB); PG8_STAGE(PG8_SB(0, 1), b2 + hstep, voffB); PG8_STAGE(PG8_SA(0, 0), a2, voffA);
            PG8_WAIT_V(8); PG8_WAIT_L(0); PG8_BAR; PG8_MMA(1, 0, At, B0); PG8_MMA(1, 1, At, B1); PG8_BAR; PG8_SCHED;
            PG8_LDB(B0, 1, 0); PG8_LDB(B1, 1, 1); PG8_SCHED; PG8_LDA(At, 1, 0); PG8_STAGE(PG8_SA(0, 1), a2 + hstep, voffA);
            PG8_WAIT_V(8); PG8_WAIT_L(0); PG8_BAR; PG8_MMA(0, 0, At, B0); PG8_MMA(0, 1, At, B1); PG8_BAR; PG8_SCHED;
            PG8_LDA(At, 1, 1); PG8_STAGE(PG8_SB(1, 0), b3, voffB); PG8_STAGE(PG8_SB(1, 1), b3 + hstep, voffB); PG8_STAGE(PG8_SA(1, 0), a3, voffA);
            PG8_WAIT_V(8); PG8_WAIT_L(0); PG8_BAR; PG8_MMA(1, 0, At, B0); PG8_MMA(1, 1, At, B1); PG8_BAR; PG8_SCHED;
            } else {
            PG8_LDB(B0, 0, 0); PG8_SCHED; PG8_LDA(At, 0, 0); PG8_STAGE(PG8_SA(1, 1), a1 + hstep, voffA);
            PG8_WAIT_L(8); PG8_BAR; PG8_WAIT_L(0); PG8_MMA(0, 0, At, B0); PG8_BAR; PG8_SCHED;
            PG8_LDB(B1, 0, 1); PG8_STAGE(PG8_SB(0, 0), b2, voffB);
            PG8_BAR; PG8_WAIT_L(0); PG8_MMA(0, 1, At, B1); PG8_BAR;
            PG8_LDA(At, 0, 1); PG8_STAGE(PG8_SA(0, 0), a2, voffA);
            PG8_BAR; PG8_WAIT_L(0); PG8_MMA(1, 0, At, B0); PG8_BAR; PG8_SCHED;
            PG8_STAGE(PG8_SB(0, 1), b2 + hstep, voffB);
            PG8_WAIT_V(6); PG8_BAR; PG8_MMA(1, 1, At, B1); PG8_BAR;
            PG8_LDB(B0, 1, 0); PG8_SCHED; PG8_LDA(At, 1, 0); PG8_STAGE(PG8_SA(0, 1), a2 + hstep, voffA);
            PG8_WAIT_L(8); PG8_BAR; PG8_WAIT_L(0); PG8_MMA(0, 0, At, B0); PG8_BAR; PG8_SCHED;
            PG8_LDB(B1, 1, 1); PG8_STAGE(PG8_SB(1, 0), b3, voffB);
            PG8_BAR; PG8_WAIT_L(0); PG8_MMA(0, 1, At, B1); PG8_BAR;
            PG8_LDA(At, 1, 1); PG8_STAGE(PG8_SA(1, 0), a3, voffA);
            PG8_BAR; PG8_WAIT_L(0); PG8_MMA(1, 0, At, B0); PG8_BAR; PG8_SCHED;
            PG8_STAGE(PG8_SB(1, 1), b3 + hstep, voffB);
            PG8_WAIT_V(6); PG8_BAR; PG8_MMA(1, 1, At, B1); PG8_BAR;
            }
        }
        if constexpr (ALIGN_EPI) { if (wr == 0) PG8_BAR; }
        if constexpr (!Epi::AFTER_DRAIN) { E(acc, cur, wr, wc, fr, fq); S.done(cur); }
        if (!has_next) break;
#pragma unroll
        for (int a = 0; a < 2; ++a)
#pragma unroll
            for (int b = 0; b < 2; ++b)
#pragma unroll
                for (int m = 0; m < 4; ++m)
#pragma unroll
                    for (int n = 0; n < 2; ++n) acc[a][b][m][n] = (f32x4){0.f, 0.f, 0.f, 0.f};
        cur = nxt; cA = nA; cB = nB; ++ui;
        if constexpr (ALIGN_EPI) { if (wr == 1) PG8_BAR; }
    }
    PG8_WAIT_V(0);
    if constexpr (!ALIGN_EPI) { if (wr == 0) PG8_BAR; }
    PG8_BAR;
    if constexpr (Epi::AFTER_DRAIN) { E.fused(acc, cur, wr, wc, fr, fq, lds, wid, lane); S.done(cur); }
#undef PG8_SA
#undef PG8_SB
#undef PG8_STAGE
#undef PG8_LDA
#undef PG8_LDB
#undef PG8_MMA
#undef PG8_WAIT_V
#undef PG8_WAIT_L
#undef PG8_BAR
#undef PG8_SCHED
}
}

constexpr int D = 2048, BATCH = 2, SEQ = 8192, T = BATCH * SEQ, DEPTH = 2, GW = 512;
constexpr int RW_OFF = 3 * GW, RW_COLS = 3 * GW + 96 + 96 + 128, ATT_OFF = RW_OFF + RW_COLS, S5_OFF = ATT_OFF + 512 + 256, NIN = S5_OFF + GW, NINP = 4864;
static_assert(NIN == 4672 && ATT_OFF == 3392 && S5_OFF == 4160, "column layout");
constexpr int NEXP = 32, DEXP = 512, MAXTILES = 160, MAXROWS = MAXTILES * 256;
constexpr float ALPHA = 1.41421356237f, LN_EPS = 1e-5f, GN_EPS = 64e-5f;
constexpr int NWAVES = 8, NT = 512;
constexpr int KS_MOD = 8;

constexpr size_t MiB = 1u << 20;
constexpr size_t WS_CTL = 0, CTL_ZERO_BYTES = 1 * MiB;
constexpr size_t WS_MODP = 1 * MiB;
constexpr size_t WS_MODF = 4 * MiB;
constexpr size_t WS_WIN = 5 * MiB;
constexpr size_t WS_WOUT = 24 * MiB;
constexpr size_t WS_GLU = 32 * MiB;
constexpr size_t WS_LORA = WS_GLU + MiB / 2;
constexpr size_t WS_ROUT = 33 * MiB;
constexpr size_t WS_S5C = WS_ROUT + MiB / 2;
constexpr size_t WS_MISC = 34 * MiB;
constexpr size_t WS_W13 = 36 * MiB;
constexpr size_t WS_W2 = 164 * MiB;
constexpr size_t WS_H = 228 * MiB;
constexpr size_t WS_Z = 292 * MiB;
constexpr size_t WS_P = 420 * MiB;
constexpr size_t WS_YCAT = 572 * MiB;
constexpr size_t WS_RW = 636 * MiB;
constexpr size_t WS_RWSC = 892 * MiB;
constexpr size_t WS_YS = 894 * MiB;
constexpr size_t WS_S5E = 910 * MiB;
constexpr size_t WS_S5X = 914 * MiB;
constexpr size_t WS_WIN2 = 918 * MiB;
constexpr size_t WS_LORA2 = 937 * MiB, WS_S5C2 = 938 * MiB;
constexpr size_t WS_CK = 939 * MiB;
constexpr size_t WS_END = 1164 * MiB;
constexpr size_t WS_XB = WS_P;
constexpr size_t WS_YR = WS_P;
constexpr size_t WS_HLO = WS_RW;
constexpr size_t WS_HMID = WS_RW + 64 * MiB;
static_assert(WS_P + (size_t)MAXROWS * 2048 * 2 <= WS_RW, "XB overlay");
constexpr size_t MI_COUNTS = 0;
constexpr size_t MI_TILEE = 64 * 1024;
constexpr size_t MI_ROUTE_E = 128 * 1024;
constexpr size_t MI_ROUTE_W = 256 * 1024;
constexpr size_t MI_DEST = 384 * 1024;
constexpr size_t MI_ROWW = 512 * 1024;
constexpr size_t MI_S5POW = 1280 * 1024;
constexpr size_t MI_S5BBF = MI_S5POW + 320 * 1024;
constexpr size_t MI_STATS = 1024 * 1024;
constexpr size_t S5C_LAM = 0;
constexpr size_t S5C_BB = 32 * 1024;
constexpr size_t S5C_CP = 32 * 1024 + 256 * 1024;
static_assert(S5C_CP + 32 * 16 * 128 * 2 <= MiB / 2, "S5C");
__device__ __forceinline__ constexpr size_t ws_win(int l) { return (l & 1) ? WS_WIN2 : WS_WIN; }
__device__ __forceinline__ constexpr size_t ws_lora(int l) { return (l & 1) ? WS_LORA2 : WS_LORA; }
__device__ __forceinline__ constexpr size_t ws_s5c(int l) { return (l & 1) ? WS_S5C2 : WS_S5C; }
constexpr int CW_BAR = 4096;

constexpr int RING_OFF = 0, RING_BYTES = 131072;
constexpr int XTRA_OFF = RING_BYTES;
constexpr int LDSCTL_OFF = XTRA_OFF + 16384, MISC_OFF = LDSCTL_OFF + 320;
constexpr int LDS_BYTES = LDSCTL_OFF + 1024;
static_assert(LDS_BYTES <= 163840, "LDS");

#define GAS __attribute__((address_space(1)))
#define LAS __attribute__((address_space(3)))
#define DI __device__ __forceinline__
typedef unsigned short bf16;
typedef unsigned v4u __attribute__((ext_vector_type(4)));
typedef unsigned v2u __attribute__((ext_vector_type(2)));
typedef float f32x4 __attribute__((ext_vector_type(4)));
typedef float f32x2 __attribute__((ext_vector_type(2)));
typedef int i32x2 __attribute__((ext_vector_type(2)));
typedef short bf16x8 __attribute__((ext_vector_type(8)));
typedef GAS unsigned gu32;
#define RLX_AGENT __ATOMIC_RELAXED, __HIP_MEMORY_SCOPE_AGENT
#define LDS_WAIT() asm volatile("s_waitcnt lgkmcnt(0)" ::: "memory")
#define VM_WAIT() asm volatile("s_waitcnt vmcnt(0)" ::: "memory")
using pg8::cvt_pk_bf16;
typedef __bf16 bf2_t __attribute__((ext_vector_type(2)));
DI unsigned cvt_pk_safe(float lo, float hi) { const bf2_t r = __builtin_convertvector((f32x2){lo, hi}, bf2_t); return __builtin_bit_cast(unsigned, r); }
DI float bf_lo(unsigned u) { return __builtin_bit_cast(float, u << 16); }
DI float bf_hi(unsigned u) { return __builtin_bit_cast(float, u & 0xffff0000u); }
DI float bf1(bf16 b) { return __builtin_bit_cast(float, (unsigned)b << 16); }
DI float rcpf_(float x) { return __builtin_amdgcn_rcpf(x); }
DI float sigmoidf_(float x) { return rcpf_(1.f + __expf(-x)); }
DI float siluf_(float x) { return x * rcpf_(1.f + __expf(-x)); }
DI float tanhf_(float x) { const float e = __expf(-2.f * fabsf(x)); const float t = (1.f - e) * rcpf_(1.f + e); return x < 0.f ? -t : t; }
DI float gelu_tanh(float x) { const float u = 0.7978845608028654f * (x + 0.044715f * x * x * x); return 0.5f * x * (1.f + tanhf_(u)); }
template <int CTRL> DI float dppf(float x) { return __builtin_bit_cast(float, __builtin_amdgcn_update_dpp(0, __builtin_bit_cast(int, x), CTRL, 0xF, 0xF, true)); }
DI float allsum16(float x) { x += dppf<0xB1>(x); x += dppf<0x4E>(x); x += dppf<0x141>(x); x += dppf<0x140>(x); return x; }
DI float rdlane(float x, int l) { return __builtin_bit_cast(float, __builtin_amdgcn_readlane(__builtin_bit_cast(int, x), l)); }
DI float wave_sum(float v) { v = allsum16(v); return (rdlane(v, 0) + rdlane(v, 16)) + (rdlane(v, 32) + rdlane(v, 48)); }
DI bf16x8 as_frag(v4u v) { return __builtin_bit_cast(bf16x8, v); }
#define MFMA16(a, b, c) __builtin_amdgcn_mfma_f32_16x16x32_bf16((a), (b), (c), 0, 0, 0)

#define XB_TMO      128
#define XB_XCNT(j)  (256  + 64 * (j))
#define XB_XSUB(j)  (1280 + 64 * (j))
#define XB_XGEN(j)  (2304 + 64 * (j))
#define XB_TOP      3328
#define XB_TOPGEN   3392
#define XCD_BAR_WORDS 3456
#define XB_SPIN_CAP (1u << 18)
__device__ __forceinline__ unsigned xb_ld(unsigned* p)              { return __hip_atomic_load(p, __ATOMIC_RELAXED, __HIP_MEMORY_SCOPE_AGENT); }
__device__ __forceinline__ unsigned xb_add(unsigned* p, unsigned v) { return __hip_atomic_fetch_add(p, v, __ATOMIC_RELAXED, __HIP_MEMORY_SCOPE_AGENT); }
__device__ __forceinline__ unsigned xb_xcc_id() { return (unsigned)__builtin_amdgcn_s_getreg((3 << 11) | 20) & 0xFu; }
#define XB_SPIN(cond, bar) do { unsigned _sp = 0; while (cond) { __builtin_amdgcn_s_sleep(1); \
    if ((++_sp & 255u) == 0u) { if (xb_ld(&(bar)[XB_TMO])) break; if (_sp > XB_SPIN_CAP) { atomicAdd(&(bar)[XB_TMO], 1u); break; } } } } while (0)
struct XcdBarrier { unsigned* bar; unsigned x; volatile LAS unsigned* st; int wv; };
__device__ __forceinline__ XcdBarrier xcd_barrier_post(unsigned* bar, volatile LAS unsigned* st) {
    XcdBarrier b; b.bar = bar; b.x = xb_xcc_id(); b.st = st; b.wv = __builtin_amdgcn_readfirstlane((int)threadIdx.x >> 6);
    if (threadIdx.x == 0) (void)xb_add(&bar[XB_XCNT(b.x)], 1u);
    return b;
}
__device__ __forceinline__ void xcd_barrier_complete(unsigned* bar, unsigned x, unsigned& nloc, unsigned& nx) {
    const unsigned G = gridDim.x * gridDim.y * gridDim.z;
    unsigned sum, cnt, mine, sp = 0u;
    for (;;) {
        sum = 0u; cnt = 0u; mine = 0u;
#pragma unroll
        for (unsigned j = 0; j < 16; ++j) { const unsigned c = xb_ld(&bar[XB_XCNT(j)]); sum += c; cnt += (c > 0u) ? 1u : 0u; mine = (j == x) ? c : mine; }
        if (sum == G) break;
        __builtin_amdgcn_s_sleep(1);
        if ((++sp & 255u) == 0u) { if (xb_ld(&bar[XB_TMO])) break; if (sp > XB_SPIN_CAP) { atomicAdd(&bar[XB_TMO], 1u); break; } }
    }
    nloc = mine > 0u ? mine : 1u; nx = cnt > 0u ? cnt : 1u;
}
__device__ __forceinline__ void xcd_barrier(const XcdBarrier& b) {
    asm volatile("s_waitcnt vmcnt(0)" ::: "memory");
    __syncthreads();
    if (b.wv == 0 && __builtin_amdgcn_mbcnt_hi(~0u, __builtin_amdgcn_mbcnt_lo(~0u, 0u)) == 0u) {
        unsigned* bar = b.bar;
        __builtin_amdgcn_s_waitcnt(0);
        unsigned nloc = b.st[0], nx = b.st[1];
        if (nloc == 0u) { xcd_barrier_complete(bar, b.x, nloc, nx); b.st[0] = nloc; b.st[1] = nx; }
        const unsigned old = xb_add(&bar[XB_XSUB(b.x)], 1u);
        const unsigned gen = old / nloc;
        if (old + 1u == (gen + 1u) * nloc) {
            __builtin_amdgcn_fence(__ATOMIC_RELEASE, "agent");
            asm volatile("s_waitcnt vmcnt(0)" ::: "memory");
            const unsigned og = xb_add(&bar[XB_TOP], 1u);
            const unsigned tg = og / nx;
            if (og + 1u == (tg + 1u) * nx) xb_add(&bar[XB_TOPGEN], 1u);
            else XB_SPIN(xb_ld(&bar[XB_TOPGEN]) == tg, bar);
            __builtin_amdgcn_fence(__ATOMIC_ACQUIRE, "agent");
            xb_add(&bar[XB_XGEN(b.x)], 1u);
            asm volatile("s_waitcnt vmcnt(0)" ::: "memory");
        } else {
            XB_SPIN(xb_ld(&bar[XB_XGEN(b.x)]) == gen, bar);
            __builtin_amdgcn_fence(__ATOMIC_ACQUIRE, "agent");
            asm volatile("s_waitcnt vmcnt(0)" ::: "memory");
        }
    }
    __syncthreads();
}

struct Frame {
    LAS unsigned char* lds;
    int tid, lane, wave, G, blk;
};
struct Args { const float* in[39]; float* out; unsigned char* ws; int ph_lo, ph_hi; };
typedef const __attribute__((address_space(4))) Args* KArgs;
DI KArgs launder(KArgs p) { asm volatile("" : "+s"(p)); return p; }
enum { I_X = 0, I_C, I_WADA, I_BADA, I_LNG, I_LNB, I_WIN, I_WOUT, I_CONVW, I_MU, I_W0, I_W2, I_A0, I_A2, I_G2, I_KK, I_KA, I_RK, I_GNG, I_GNB,
       I_SINKS, I_RELB, I_LRE, I_LIM, I_LOGDT, I_BRE, I_BIM, I_CRE, I_CIM, I_S5D, I_GLUW, I_GLUB, I_RGW, I_RGB, I_REW, I_REB, I_MW1, I_MW3, I_MW2 };

DI Frame mkframe(LAS unsigned char* lds, int wv) {
    Frame F; int w_ = wv; asm volatile("" : "+s"(w_)); int t = (w_ << 6) | (int)__builtin_amdgcn_mbcnt_hi(~0u, __builtin_amdgcn_mbcnt_lo(~0u, 0u)); asm volatile("" : "+v"(t)); int g = gridDim.x, b = blockIdx.x; asm volatile("" : "+s"(g), "+s"(b));
    F.lds = lds; F.tid = t; F.lane = t & 63; F.wave = __builtin_amdgcn_readfirstlane(t >> 6); F.G = g; F.blk = b; return F;
}
DI float mod_val(KArgs A, int l, int b, int col) {
    const float* mp = (const float*)(A->ws + WS_MODP) + ((size_t)(l * KS_MOD) * 2 + b) * 12288 + col;
    float s = A->in[I_BADA][l * 12288 + col];
#pragma unroll
    for (int ks = 0; ks < KS_MOD; ++ks) s += mp[(size_t)ks * 2 * 12288];
    return s;
}
template <bool PARTIAL = false>
DI void stage_mod(KArgs A, LAS float* dst, int l, int which, float add, int tid) {
    const float* mf = (const float*)(A->ws + WS_MODF) + (size_t)l * 2 * 12288 + which * 2048;
    for (int i = tid; i < 2 * 2048; i += NT) { const int b = i >> 11, c = i & 2047; dst[i] = add + (PARTIAL ? mod_val(A, l, b, which * 2048 + c) : mf[b * 12288 + c]); }
}
DI void mod_finalize(KArgs A, const Frame& F, int l) {
    float* mf = (float*)(A->ws + WS_MODF) + (size_t)l * 2 * 12288;
    for (int i = F.blk * NT + F.tid; i < 2 * 12288; i += F.G * NT) { const int b = i / 12288, c = i % 12288; mf[i] = mod_val(A, l, b, c); }
}
constexpr int TSCR = 64 * 65 * 4;
DI void transpose_item(const float* W, int K, int N, bf16* WT, int k0, int n0, int drow0, LAS float* scr, int lane) {
    f32x4 r[16]; const int rs = lane >> 4, cj = 4 * (lane & 15);
#pragma unroll
    for (int i = 0; i < 16; ++i) r[i] = *(const GAS f32x4*)(W + (size_t)(k0 + 4 * i + rs) * N + n0 + cj);
#pragma unroll
    for (int i = 0; i < 16; ++i) { LAS float* d = scr + (4 * i + rs) * 65 + cj; d[0] = r[i].x; d[1] = r[i].y; d[2] = r[i].z; d[3] = r[i].w; }
    LDS_WAIT(); asm volatile("" ::: "memory");
    const int c = lane & 7;
#pragma unroll
    for (int j = 0; j < 8; ++j) { const int n = (lane >> 3) + 8 * j; const LAS float* q = scr + (8 * c) * 65 + n;
        v4u o; o.x = cvt_pk_bf16(q[0 * 65], q[1 * 65]); o.y = cvt_pk_bf16(q[2 * 65], q[3 * 65]); o.z = cvt_pk_bf16(q[4 * 65], q[5 * 65]); o.w = cvt_pk_bf16(q[6 * 65], q[7 * 65]);
        *(GAS v4u*)(WT + (size_t)(drow0 + n) * K + k0 + 8 * c) = o; }
    LDS_WAIT(); asm volatile("" ::: "memory");
}
DI void phase_wprep_a(KArgs A, const Frame& F, int l, int wid, int nw, int parts = 3) {
    LAS float* scr = (LAS float*)(F.lds + RING_OFF + F.wave * TSCR);
    const int gw = wid, NGW = nw;
    if (parts & 1) { const float* W = A->in[I_WIN] + (size_t)l * D * NIN; bf16* WT = (bf16*)(A->ws + ws_win(l));
      constexpr int NB = NIN / 64, ITEMS = (D / 64) * NB;
      for (int it = gw; it < ITEMS; it += NGW) { const int kb = it / NB, nb = it % NB; transpose_item(W, D, NIN, WT, 64 * kb, 64 * nb, 64 * nb, scr, F.lane); }
      for (int i = gw * 64 + F.lane; i < (NINP - NIN) * D / 8; i += NGW * 64) *(GAS v4u*)(WT + (size_t)NIN * D + (size_t)i * 8) = (v4u){0u, 0u, 0u, 0u};
    }
    if (!(parts & 2)) return;
    const int gt = wid * 64 + F.lane, NGT = nw * 64;
    { bf16* L0 = (bf16*)(A->ws + ws_lora(l)); bf16* L1 = L0 + 512 * 96; bf16* L2 = L1 + 512 * 96;
      const float* w2 = A->in[I_W2] + (size_t)l * 96 * 512; const float* a2 = A->in[I_A2] + (size_t)l * 96 * 512; const float* g2 = A->in[I_G2] + (size_t)l * 128 * 512;
      for (int i = gt; i < 512 * 96; i += NGT) { const int n = i / 96, k = i % 96; L0[i] = (bf16)(cvt_pk_bf16(w2[k * 512 + n], 0.f) & 0xffffu); L1[i] = (bf16)(cvt_pk_bf16(a2[k * 512 + n], 0.f) & 0xffffu); }
      for (int i = gt; i < 512 * 128; i += NGT) { const int n = i / 128, k = i % 128; L2[i] = (bf16)(cvt_pk_bf16(g2[k * 512 + n], 0.f) & 0xffffu); }
    }
    { unsigned char* sc = A->ws + ws_s5c(l);
      for (int i = gt; i < 32 * 64; i += NGT) { const int g = i >> 6;
          const float lr = A->in[I_LRE][l * 2048 + i], li = A->in[I_LIM][l * 2048 + i], dt = expf(A->in[I_LOGDT][l * 32 + g]);
          const float mag = expf(lr * dt), ar = mag * cosf(li * dt), ai = mag * sinf(li * dt);
          float pr = ar, pi = ai;
#pragma unroll
          for (int s = 0; s < 6; ++s) { const float nr = pr * pr - pi * pi, ni = 2.f * pr * pi; pr = nr; pi = ni; }
          ((f32x4*)(sc + S5C_LAM))[i] = (f32x4){ar, ai, pr, pi};
          const float den = lr * lr + li * li, zr = ((ar - 1.f) * lr + ai * li) / den, zi = (ai * lr - (ar - 1.f) * li) / den;
          float* bb = (float*)(sc + S5C_BB) + (size_t)i * 32;
          const float* br = A->in[I_BRE] + ((size_t)l * 2048 + i) * 16; const float* bi = A->in[I_BIM] + ((size_t)l * 2048 + i) * 16;
          float bbv[32];
#pragma unroll
          for (int c = 0; c < 16; ++c) { bbv[c] = zr * br[c] - zi * bi[c]; bbv[16 + c] = zr * bi[c] + zi * br[c]; bb[c] = bbv[c]; bb[16 + c] = bbv[16 + c]; }
          { f32x2* pw = (f32x2*)(A->ws + WS_MISC + MI_S5POW) + (size_t)i * 17; float qr = 1.f, qi = 0.f;
#pragma unroll 1
            for (int e = 0; e <= 16; ++e) { pw[e] = (f32x2){qr, qi}; const float nr = qr * ar - qi * ai, ni = qr * ai + qi * ar; qr = nr; qi = ni; } }
          { v2u* bfp = (v2u*)(A->ws + WS_MISC + MI_S5BBF); const int p = i & 63, nt = p >> 4, frl = p & 15;
#pragma unroll
            for (int ri = 0; ri < 2; ++ri)
#pragma unroll
                for (int q4 = 0; q4 < 4; ++q4) { const float* v = bbv + 16 * ri + 4 * q4;
                    const unsigned h0 = cvt_pk_bf16(v[0], v[1]), h1 = cvt_pk_bf16(v[2], v[3]);
                    const unsigned l0 = cvt_pk_bf16(v[0] - bf_lo(h0), v[1] - bf_hi(h0)), l1 = cvt_pk_bf16(v[2] - bf_lo(h1), v[3] - bf_hi(h1));
                    const size_t ix = ((size_t)((g * 4 + nt) * 2 + ri) * 2) * 64 + q4 * 16 + frl;
                    bfp[ix] = (v2u){h0, h1}; bfp[ix + 64] = (v2u){l0, l1}; } } }
      bf16* cp = (bf16*)(sc + S5C_CP);
      for (int i = gt; i < 32 * 16 * 128; i += NGT) { const int k = i & 127, gc = i >> 7, p = k >> 1;
          const float v = (k & 1) ? -A->in[I_CIM][((size_t)l * 512 + gc) * 64 + p] : A->in[I_CRE][((size_t)l * 512 + gc) * 64 + p];
          cp[i] = (bf16)(cvt_pk_bf16(v, 0.f) & 0xffffu); }
    }
    {
        constexpr int NCG = 12288 / 256, ITEMS = NCG * KS_MOD, ROWS = D / KS_MOD;
        for (int it = gw; it < ITEMS; it += NGW) {
            const int ll = l, r = it, cg = r / KS_MOD, ks = r % KS_MOD, col = cg * 256 + 4 * F.lane;
            const float* wp = A->in[I_WADA] + ((size_t)ll * D + ks * ROWS) * 12288 + col; const float* cv = A->in[I_C] + ks * ROWS;
            f32x4 a0 = {0.f, 0.f, 0.f, 0.f}, a1 = {0.f, 0.f, 0.f, 0.f};
#pragma unroll 8
            for (int k = 0; k < ROWS; ++k) { const f32x4 w = *(const GAS f32x4*)(wp + (size_t)k * 12288); const float s0 = siluf_(cv[k]), s1 = siluf_(cv[D + k]); a0 += w * s0; a1 += w * s1; }
            float* mp = (float*)(A->ws + WS_MODP) + ((size_t)(ll * KS_MOD + ks) * 2) * 12288 + col;
            *(GAS f32x4*)mp = a0; *(GAS f32x4*)(mp + 12288) = a1;
        }
    }
}
DI void phase_wprep_b(KArgs A, const Frame& F, int l, int gw, int NGW) {
    LAS float* scr = (LAS float*)(F.lds + RING_OFF + F.wave * TSCR);
    constexpr int IT_O = (D / 64) * (D / 64), IT_G = (512 / 64) * (512 / 64), IT_13 = (D / 64) * (DEXP / 64), IT_2 = (DEXP / 64) * (D / 64);
    constexpr int TOTAL = IT_O + IT_G + NEXP * (2 * IT_13 + IT_2);
    for (int it = gw; it < TOTAL; it += NGW) {
        int r = it;
        if (r < IT_O) { const int nbk = D / 64, kb = r / nbk, nb = r % nbk; transpose_item(A->in[I_WOUT] + (size_t)l * D * D, D, D, (bf16*)(A->ws + WS_WOUT), 64 * kb, 64 * nb, 64 * nb, scr, F.lane); continue; } r -= IT_O;
        if (r < IT_G) { const int nbk = 512 / 64, kb = r / nbk, nb = r % nbk; transpose_item(A->in[I_GLUW] + (size_t)l * 512 * 512, 512, 512, (bf16*)(A->ws + WS_GLU), 64 * kb, 64 * nb, 64 * nb, scr, F.lane); continue; } r -= IT_G;
        const int e = r / (2 * IT_13 + IT_2); r %= (2 * IT_13 + IT_2);
        if (r < 2 * IT_13) { const int which = r / IT_13, rr = r % IT_13, nbk = DEXP / 64, kb = rr / nbk, nb = rr % nbk, n0 = 64 * nb;
            const float* W = A->in[which ? I_MW3 : I_MW1] + ((size_t)l * NEXP + e) * D * DEXP;
            const int drow0 = e * 1024 + (n0 >> 7) * 256 + which * 128 + (n0 & 127);
            transpose_item(W, D, DEXP, (bf16*)(A->ws + WS_W13), 64 * kb, n0, drow0, scr, F.lane); continue; }
        r -= 2 * IT_13;
        { const int nbk = D / 64, kb = r / nbk, nb = r % nbk; const float* W = A->in[I_MW2] + ((size_t)l * NEXP + e) * DEXP * D;
          transpose_item(W, DEXP, D, (bf16*)(A->ws + WS_W2), 64 * kb, 64 * nb, e * 2048 + 64 * nb, scr, F.lane); }
    }
    { bf16* hi = (bf16*)(A->ws + WS_ROUT); bf16* lo = hi + 48 * 2048;
      for (int i = gw * 64 + F.lane; i < 48 * 2048; i += NGW * 64) { const int j = i >> 11, k = i & 2047;
          float w = 0.f; if (j < 4) w = A->in[I_RGW][((size_t)l * D + k) * 4 + j]; else if (j < 36) w = A->in[I_REW][((size_t)l * D + k) * 32 + (j - 4)];
          const unsigned h = cvt_pk_bf16(w, 0.f) & 0xffffu; const float wl = w - bf_lo(h);
          hi[i] = (bf16)h; lo[i] = (bf16)(cvt_pk_bf16(wl, 0.f) & 0xffffu); } }
}

DI void row_stats(const f32x4 (&v)[8], float& mean, float& rstd) {
    float s = 0.f;
#pragma unroll
    for (int j = 0; j < 8; ++j) s += (v[j].x + v[j].y) + (v[j].z + v[j].w);
    mean = wave_sum(s) * (1.f / D); float s2 = 0.f;
#pragma unroll
    for (int j = 0; j < 8; ++j) { const f32x4 d = v[j] - mean; s2 += (d.x * d.x + d.y * d.y) + (d.z * d.z + d.w * d.w); }
    rstd = 1.f / sqrtf(wave_sum(s2) * (1.f / D) + LN_EPS);
}
DI void ada_store(const f32x4 (&v)[8], const LAS float* sc1p, const LAS float* sh, bf16* hrow, bf16* lorow, int lane) {
    float mean, rstd; row_stats(v, mean, rstd);
#pragma unroll
    for (int j = 0; j < 8; ++j) { const int c = 4 * (lane + 64 * j);
        const f32x4 a = *(const LAS f32x4*)(sc1p + c), b = *(const LAS f32x4*)(sh + c);
        const f32x4 h = (v[j] - mean) * rstd * a + b;
        v2u o; o.x = cvt_pk_bf16(h.x, h.y); o.y = cvt_pk_bf16(h.z, h.w);
        *(GAS v2u*)(hrow + c) = o;
        if (lorow) { v2u q; q.x = cvt_pk_bf16(h.x - bf_lo(o.x), h.y - bf_hi(o.x)); q.y = cvt_pk_bf16(h.z - bf_lo(o.y), h.w - bf_hi(o.y)); *(GAS v2u*)(lorow + c) = q; } }
}
DI void phase_ln_in(KArgs A, const Frame& F, int l) {
    LAS float* ms = (LAS float*)(F.lds + RING_OFF);
    stage_mod<true>(A, ms + 4096, l, 0, 0.f, F.tid); stage_mod<true>(A, ms, l, 1, 1.f, F.tid);
    mod_finalize(A, F, l);
    __syncthreads();
    const int gw = F.blk * NWAVES + F.wave, NGW = F.G * NWAVES;
    const float* x = A->in[I_X]; bf16* H = (bf16*)(A->ws + WS_H);
    for (int row0 = gw; row0 < T; row0 += 2 * NGW) { f32x4 v[2][8];
#pragma unroll
        for (int r = 0; r < 2; ++r) { const GAS f32x4* xr = (const GAS f32x4*)(x + (size_t)(row0 + r * NGW) * D) + F.lane;
#pragma unroll
            for (int j = 0; j < 8; ++j) v[r][j] = xr[64 * j]; }
#pragma unroll
        for (int r = 0; r < 2; ++r) { const int row = row0 + r * NGW, b = row >> 13; ada_store(v[r], ms + b * 2048, ms + 4096 + b * 2048, H + (size_t)row * D, nullptr, F.lane); } }
    __syncthreads();
}

struct EpiP {
    static constexpr bool PERM = true, AFTER_DRAIN = false;
    bf16* O; int ldc;
    DI void operator()(const f32x4 (&acc)[2][2][4][2], const pg8::Unit& u, int wr, int wc, int fr, int fq) const {
        const int row0 = u.pm * 256 + wr * 64 + fr, col0 = u.po * 256 + wc * 32 + 8 * fq;
#pragma unroll
        for (int ai = 0; ai < 2; ++ai)
#pragma unroll
            for (int m = 0; m < 4; ++m) { bf16* rowp = O + (size_t)(row0 + ai * 128 + m * 16) * ldc + col0;
#pragma unroll
                for (int bj = 0; bj < 2; ++bj) { const f32x4 v0 = acc[ai][bj][m][0], v1 = acc[ai][bj][m][1];
                    v4u w; w.x = cvt_pk_bf16(v0[0], v0[1]); w.y = cvt_pk_bf16(v0[2], v0[3]); w.z = cvt_pk_bf16(v1[0], v1[1]); w.w = cvt_pk_bf16(v1[2], v1[3]);
                    *(GAS v4u*)(rowp + bj * 128) = w; } }
    }
};
struct EpiGlu {
    static constexpr bool PERM = true, AFTER_DRAIN = false;
    const bf16* YS; bf16* O; const float* bias;
    DI void operator()(const f32x4 (&acc)[2][2][4][2], const pg8::Unit& u, int wr, int wc, int fr, int fq) const {
        const int row0 = u.pm * 256 + wr * 64 + fr, col0 = u.po * 256 + wc * 32 + 8 * fq;
#pragma unroll
        for (int ai = 0; ai < 2; ++ai)
#pragma unroll
            for (int m = 0; m < 4; ++m) { const int row = row0 + ai * 128 + m * 16;
#pragma unroll
                for (int bj = 0; bj < 2; ++bj) { const int col = col0 + bj * 128;
                    const v4u y = *(const GAS v4u*)(YS + (size_t)row * 512 + col);
                    const f32x4 b0 = *(const GAS f32x4*)(bias + col), b1 = *(const GAS f32x4*)(bias + col + 4);
                    const f32x4 v0 = acc[ai][bj][m][0] + b0, v1 = acc[ai][bj][m][1] + b1;
                    v4u w;
                    w.x = cvt_pk_bf16(bf_lo(y.x) * sigmoidf_(v0[0]), bf_hi(y.x) * sigmoidf_(v0[1]));
                    w.y = cvt_pk_bf16(bf_lo(y.y) * sigmoidf_(v0[2]), bf_hi(y.y) * sigmoidf_(v0[3]));
                    w.z = cvt_pk_bf16(bf_lo(y.z) * sigmoidf_(v1[0]), bf_hi(y.z) * sigmoidf_(v1[1]));
                    w.w = cvt_pk_bf16(bf_lo(y.w) * sigmoidf_(v1[2]), bf_hi(y.w) * sigmoidf_(v1[3]));
                    *(GAS v4u*)(O + (size_t)row * D + 1536 + col) = w; } }
    }
};
struct EpiZ {
    static constexpr bool PERM = false, AFTER_DRAIN = false;
    const float* X; float* Z; const LAS float* g1p;
    DI void operator()(const f32x4 (&acc)[2][2][4][2], const pg8::Unit& u, int wr, int wc, int fr, int fq) const {
        const int row0 = u.pm * 256 + wr * 64 + fr, col0 = u.po * 256 + wc * 32 + 4 * fq; const int b = (u.pm * 256) >> 13;
        f32x4 gv[2][2];
#pragma unroll
        for (int bj = 0; bj < 2; ++bj)
#pragma unroll
            for (int n = 0; n < 2; ++n) gv[bj][n] = *(const LAS f32x4*)(g1p + b * 2048 + col0 + bj * 128 + n * 16);
#pragma unroll
        for (int ai = 0; ai < 2; ++ai)
#pragma unroll
            for (int m = 0; m < 4; ++m) { const size_t ro = (size_t)(row0 + ai * 128 + m * 16) * D + col0;
#pragma unroll
                for (int bj = 0; bj < 2; ++bj)
#pragma unroll
                    for (int n = 0; n < 2; ++n) { const f32x4 xv = *(const GAS f32x4*)(X + ro + bj * 128 + n * 16);
                        *(GAS f32x4*)(Z + ro + bj * 128 + n * 16) = xv * ALPHA + gv[bj][n] * acc[ai][bj][m][n]; } }
    }
};
struct EpiMoeA {
    static constexpr bool PERM = true, AFTER_DRAIN = false;
    bf16* O;
    DI void operator()(const f32x4 (&acc)[2][2][4][2], const pg8::Unit& u, int wr, int wc, int fr, int fq) const {
        const int row0 = u.pm * 256 + wr * 64 + fr, col0 = u.po * 128 + wc * 32 + 8 * fq;
#pragma unroll
        for (int ai = 0; ai < 2; ++ai)
#pragma unroll
            for (int m = 0; m < 4; ++m) { const f32x4 a0 = acc[ai][0][m][0], a1 = acc[ai][0][m][1], b0 = acc[ai][1][m][0], b1 = acc[ai][1][m][1];
                v4u w; w.x = cvt_pk_bf16(siluf_(a0[0]) * b0[0], siluf_(a0[1]) * b0[1]); w.y = cvt_pk_bf16(siluf_(a0[2]) * b0[2], siluf_(a0[3]) * b0[3]);
                w.z = cvt_pk_bf16(siluf_(a1[0]) * b1[0], siluf_(a1[1]) * b1[1]); w.w = cvt_pk_bf16(siluf_(a1[2]) * b1[2], siluf_(a1[3]) * b1[3]);
                *(GAS v4u*)(O + (size_t)(row0 + ai * 128 + m * 16) * DEXP + col0) = w; }
    }
};
struct EpiMoeB {
    static constexpr bool PERM = true, AFTER_DRAIN = false;
    bf16* O; const float* roww;
    DI void operator()(const f32x4 (&acc)[2][2][4][2], const pg8::Unit& u, int wr, int wc, int fr, int fq) const {
        const int row0 = u.pm * 256 + wr * 64 + fr, col0 = u.po * 256 + wc * 32 + 8 * fq;
#pragma unroll
        for (int ai = 0; ai < 2; ++ai)
#pragma unroll
            for (int m = 0; m < 4; ++m) { const int row = row0 + ai * 128 + m * 16; const float s = roww[row]; bf16* rowp = O + (size_t)row * D + col0;
#pragma unroll
                for (int bj = 0; bj < 2; ++bj) { const f32x4 v0 = acc[ai][bj][m][0] * s, v1 = acc[ai][bj][m][1] * s;
                    v4u w; w.x = cvt_pk_bf16(v0[0], v0[1]); w.y = cvt_pk_bf16(v0[2], v0[3]); w.z = cvt_pk_bf16(v1[0], v1[1]); w.w = cvt_pk_bf16(v1[2], v1[3]);
                    *(GAS v4u*)(rowp + bj * 128) = w; } }
    }
};

DI void conv_part(KArgs A, const Frame& F, int l, int gw, int NGW) {
    const bf16* P = (const bf16*)(A->ws + WS_P); bf16* Y = (bf16*)(A->ws + WS_YCAT); const float* cw = A->in[I_CONVW] + (size_t)l * 3 * GW;
    for (int i = gw * 64 + F.lane; i < T * 64; i += NGW * 64) { const int t = i >> 6, c = (i & 63) * 8, ts = t & (SEQ - 1);
        const bf16* pr = P + (size_t)t * NINP + c;
        const v4u bg = *(const GAS v4u*)pr, c0 = *(const GAS v4u*)(pr + 512), h0 = *(const GAS v4u*)(pr + 1024);
        v4u c1 = {0u, 0u, 0u, 0u}, h1 = c1, c2 = c1, h2 = c1;
        if (ts >= 1) { c1 = *(const GAS v4u*)(pr - NINP + 512); h1 = *(const GAS v4u*)(pr - NINP + 1024); }
        if (ts >= 2) { c2 = *(const GAS v4u*)(pr - 2 * NINP + 512); h2 = *(const GAS v4u*)(pr - 2 * NINP + 1024); }
        const unsigned bgv[4] = {bg.x, bg.y, bg.z, bg.w}, c0v[4] = {c0.x, c0.y, c0.z, c0.w}, h0v[4] = {h0.x, h0.y, h0.z, h0.w}, c1v[4] = {c1.x, c1.y, c1.z, c1.w},
                       h1v[4] = {h1.x, h1.y, h1.z, h1.w}, c2v[4] = {c2.x, c2.y, c2.z, c2.w}, h2v[4] = {h2.x, h2.y, h2.z, h2.w};
        unsigned o[4];
#pragma unroll
        for (int k = 0; k < 4; ++k) {
            const float w0a = cw[c + 2 * k], w1a = cw[GW + c + 2 * k], w2a = cw[2 * GW + c + 2 * k], w0b = cw[c + 2 * k + 1], w1b = cw[GW + c + 2 * k + 1], w2b = cw[2 * GW + c + 2 * k + 1];
            const float ya = bf_lo(bgv[k]) * (w0a * bf_lo(c2v[k]) * bf_lo(h2v[k]) + w1a * bf_lo(c1v[k]) * bf_lo(h1v[k]) + w2a * bf_lo(c0v[k]) * bf_lo(h0v[k]));
            const float yb = bf_hi(bgv[k]) * (w0b * bf_hi(c2v[k]) * bf_hi(h2v[k]) + w1b * bf_hi(c1v[k]) * bf_hi(h1v[k]) + w2b * bf_hi(c0v[k]) * bf_hi(h0v[k]));
            o[k] = cvt_pk_bf16(ya, yb); }
        *(GAS v4u*)(Y + (size_t)t * D + c) = (v4u){o[0], o[1], o[2], o[3]}; }
}

constexpr int AK_PITCH = 144, AV_PITCH = 528;
constexpr int ATT_K_OFF = 0, ATT_V_OFF = 256 * AK_PITCH, ATT_B_OFF = ATT_V_OFF + 64 * AV_PITCH;
DI void attn_part(KArgs A, const Frame& F, int l, int blk0, int nblk, int item0, int item1) {
    const bf16* P = (const bf16*)(A->ws + WS_P); bf16* Y = (bf16*)(A->ws + WS_YCAT);
    LAS unsigned char* Ks = F.lds + RING_OFF + ATT_K_OFF; LAS unsigned char* Vs = F.lds + RING_OFF + ATT_V_OFF; LAS float* Bs = (LAS float*)(F.lds + RING_OFF + ATT_B_OFF);
    const int lane = F.lane, fr = lane & 15, fq = lane >> 4, w = F.wave;
    for (int item = item0 + (F.blk - blk0); item < item1; item += nblk) {
        const int b = item >> 7, g = (item >> 6) & 1, n = item & 63;
        const int tok0 = b * SEQ + 128 * (n - 1);
        float relb_v; { const int r = F.tid >> 7, rel = F.tid & 127;
          int bucket = rel; if (rel >= 16) { bucket = 16 + (int)(logf((float)rel * (1.f / 16.f)) / logf(8.f) * 16.f); bucket = bucket < 31 ? bucket : 31; }
          relb_v = A->in[I_RELB][bucket * 8 + 4 * g + r]; }
        const f32x4 sink4 = *(const GAS f32x4*)(A->in[I_SINKS] + l * 8 + 4 * g);
        for (int id = F.tid; id < 2048; id += NT) { const int key = id & 255, part = id >> 8; const bool ok = (n > 0) || (key >= 128);
            v4u kv = {0u, 0u, 0u, 0u}, vv = {0u, 0u, 0u, 0u};
            if (ok) { const bf16* src = P + (size_t)(tok0 + key) * NINP + ATT_OFF + 512 + 64 * g + 8 * part; kv = *(const GAS v4u*)src; vv = *(const GAS v4u*)(src + 128); }
            *(LAS v4u*)(Ks + key * AK_PITCH + 16 * part) = kv;
            LAS bf16* vd = (LAS bf16*)(Vs + (8 * part) * AV_PITCH) + key;
            vd[0 * (AV_PITCH / 2)] = (bf16)(vv.x & 0xffffu); vd[1 * (AV_PITCH / 2)] = (bf16)(vv.x >> 16); vd[2 * (AV_PITCH / 2)] = (bf16)(vv.y & 0xffffu); vd[3 * (AV_PITCH / 2)] = (bf16)(vv.y >> 16);
            vd[4 * (AV_PITCH / 2)] = (bf16)(vv.z & 0xffffu); vd[5 * (AV_PITCH / 2)] = (bf16)(vv.z >> 16); vd[6 * (AV_PITCH / 2)] = (bf16)(vv.w & 0xffffu); vd[7 * (AV_PITCH / 2)] = (bf16)(vv.w >> 16); }
        Bs[(F.tid >> 7) * 128 + (F.tid & 127)] = relb_v;
        __syncthreads();
        const int qi = 16 * w + fr, qtok = b * SEQ + 128 * n + qi;
        const bf16* qp0 = P + (size_t)qtok * NINP + ATT_OFF + 64 * (4 * g) + 8 * fq;
        v4u qn0 = *(const GAS v4u*)qp0, qn1 = *(const GAS v4u*)(qp0 + 32);
#pragma unroll 1
        for (int r = 0; r < 4; ++r) { const int h = 4 * g + r;
            const bf16x8 q0 = as_frag(qn0), q1 = as_frag(qn1);
            if (r < 3) { qn0 = *(const GAS v4u*)(qp0 + 64 * (r + 1)); qn1 = *(const GAS v4u*)(qp0 + 64 * (r + 1) + 32); }
            const float sink = (r == 0) ? sink4.x : (r == 1) ? sink4.y : (r == 2) ? sink4.z : sink4.w;
            f32x4 s[9]; float mx = sink;
#pragma unroll
            for (int kt = 0; kt < 9; ++kt) { const int nt = w + kt;
                const LAS unsigned char* kp = Ks + (16 * nt + fr) * AK_PITCH + 16 * fq;
                f32x4 acc = {0.f, 0.f, 0.f, 0.f};
                acc = MFMA16(as_frag(*(const LAS v4u*)kp), q0, acc); acc = MFMA16(as_frag(*(const LAS v4u*)(kp + 64)), q1, acc);
#pragma unroll
                for (int i = 0; i < 4; ++i) { const int j = 16 * nt + 4 * fq + i, rel = qi + 128 - j; const bool ok = (rel >= 0) && (rel < 128) && ((n > 0) || (j >= 128));
                    const float sc = ok ? acc[i] * 0.125f + Bs[r * 128 + (rel & 127)] : -1e30f; acc[i] = sc; mx = fmaxf(mx, sc); }
                s[kt] = acc; }
            mx = fmaxf(mx, __shfl_xor(mx, 16)); mx = fmaxf(mx, __shfl_xor(mx, 32));
            float den = 0.f;
#pragma unroll
            for (int kt = 0; kt < 9; ++kt)
#pragma unroll
                for (int i = 0; i < 4; ++i) { const float p = s[kt][i] > -1e29f ? __expf(s[kt][i] - mx) : 0.f; s[kt][i] = p; den += p; }
            den += __shfl_xor(den, 16); den += __shfl_xor(den, 32); den += __expf(sink - mx);
            const float inv = 1.f / den;
            f32x4 o[4];
#pragma unroll
            for (int dt = 0; dt < 4; ++dt) o[dt] = (f32x4){0.f, 0.f, 0.f, 0.f};
#pragma unroll
            for (int sp = 0; sp < 5; ++sp) { const int k0 = 2 * sp, k1 = 2 * sp + 1;
                v4u pf; pf.x = cvt_pk_bf16(s[k0][0], s[k0][1]); pf.y = cvt_pk_bf16(s[k0][2], s[k0][3]);
                if (k1 < 9) { pf.z = cvt_pk_bf16(s[k1 < 9 ? k1 : 8][0], s[k1 < 9 ? k1 : 8][1]); pf.w = cvt_pk_bf16(s[k1 < 9 ? k1 : 8][2], s[k1 < 9 ? k1 : 8][3]); } else { pf.z = 0u; pf.w = 0u; }
                int t0 = w + k0, t1 = w + k1; t1 = t1 < 16 ? t1 : 15;
#pragma unroll
                for (int dt = 0; dt < 4; ++dt) { const LAS unsigned char* vp = Vs + (16 * dt + fr) * AV_PITCH + 8 * fq;
                    const v2u va = *(const LAS v2u*)(vp + 32 * t0), vb = *(const LAS v2u*)(vp + 32 * t1);
                    o[dt] = MFMA16(as_frag((v4u){va.x, va.y, vb.x, vb.y}), as_frag(pf), o[dt]); } }
            bf16* op = Y + (size_t)qtok * D + 1024 + 64 * h + 4 * fq;
#pragma unroll
            for (int dt = 0; dt < 4; ++dt) { v2u ov; ov.x = cvt_pk_bf16(o[dt][0] * inv, o[dt][1] * inv); ov.y = cvt_pk_bf16(o[dt][2] * inv, o[dt][3] * inv); *(GAS v2u*)(op + 16 * dt) = ov; }
        }
        __syncthreads();
    }
}

DI void lerp8(const bf16* cur, const bf16* prv, bool has_prev, const float* mu, float (&o)[8]) {
    const v4u a = *(const GAS v4u*)cur; v4u b = {0u, 0u, 0u, 0u}; if (has_prev) b = *(const GAS v4u*)prv;
    const f32x4 m0 = *(const GAS f32x4*)mu, m1 = *(const GAS f32x4*)(mu + 4);
    const float av[8] = {bf_lo(a.x), bf_hi(a.x), bf_lo(a.y), bf_hi(a.y), bf_lo(a.z), bf_hi(a.z), bf_lo(a.w), bf_hi(a.w)};
    const float bv[8] = {bf_lo(b.x), bf_hi(b.x), bf_lo(b.y), bf_hi(b.y), bf_lo(b.z), bf_hi(b.z), bf_lo(b.w), bf_hi(b.w)};
    const float mv[8] = {m0.x, m0.y, m0.z, m0.w, m1.x, m1.y, m1.z, m1.w};
#pragma unroll
    for (int i = 0; i < 8; ++i) o[i] = av[i] + (bv[i] - av[i]) * mv[i];
}
DI void lerp4(const bf16* cur, const bf16* prv, bool has_prev, const float* mu, float (&o)[4]) {
    const v2u a = *(const GAS v2u*)cur; v2u b = {0u, 0u}; if (has_prev) b = *(const GAS v2u*)prv;
    const f32x4 m0 = *(const GAS f32x4*)mu;
    o[0] = bf_lo(a.x) + (bf_lo(b.x) - bf_lo(a.x)) * m0.x; o[1] = bf_hi(a.x) + (bf_hi(b.x) - bf_hi(a.x)) * m0.y;
    o[2] = bf_lo(a.y) + (bf_lo(b.y) - bf_lo(a.y)) * m0.z; o[3] = bf_hi(a.y) + (bf_hi(b.y) - bf_hi(a.y)) * m0.w;
}
constexpr size_t RWB = (size_t)T * GW;
constexpr int RP_L0 = 0, RP_L1 = 64 * 208, RP_L2 = 2 * 64 * 208, RP_PRM = RP_L2 + 64 * 272, RP_MUL = RP_PRM + 2048, RP_END = RP_MUL + 1280;
DI void rwkv_prep_part(KArgs A, const Frame& F, int l, int blk0, int nblk) {
    const bf16* P = (const bf16*)(A->ws + WS_P); float* RW = (float*)(A->ws + WS_RW); f32x4* SC = (f32x4*)(A->ws + WS_RWSC);
    const bf16* L0 = (const bf16*)(A->ws + ws_lora(l)); const bf16* L1 = L0 + 512 * 96; const bf16* L2 = L1 + 512 * 96;
    const float* mu = A->in[I_MU] + (size_t)l * RW_COLS;
    const int lane = F.lane, fr = lane & 15, fq = lane >> 4, h = (F.blk - blk0) & 7;
    LAS unsigned char* lb = F.lds + RING_OFF;
    for (int i = F.tid; i < 64 * 12; i += NT) { const int r = i / 12, p = i % 12;
        *(LAS v4u*)(lb + RP_L0 + r * 208 + 16 * p) = *(const GAS v4u*)(L0 + (size_t)(64 * h + r) * 96 + 8 * p); *(LAS v4u*)(lb + RP_L1 + r * 208 + 16 * p) = *(const GAS v4u*)(L1 + (size_t)(64 * h + r) * 96 + 8 * p); }
    for (int i = F.tid; i < 64 * 16; i += NT) { const int r = i >> 4, p = i & 15; *(LAS v4u*)(lb + RP_L2 + r * 272 + 16 * p) = *(const GAS v4u*)(L2 + (size_t)(64 * h + r) * 128 + 8 * p); }
    { LAS float* prm = (LAS float*)(lb + RP_PRM);
      if (F.tid < 64) { const int c = 64 * h + F.tid; prm[F.tid] = A->in[I_W0][l * GW + c]; prm[64 + F.tid] = A->in[I_A0][l * GW + c]; prm[128 + F.tid] = A->in[I_KK][l * GW + c]; prm[192 + F.tid] = A->in[I_KA][l * GW + c];
          prm[256 + F.tid] = A->in[I_RK][l * GW + c]; prm[320 + F.tid] = mu[c]; prm[384 + F.tid] = mu[512 + c]; prm[448 + F.tid] = mu[1024 + c]; }
      if (F.tid >= 128 && F.tid < 128 + 320) ((LAS float*)(lb + RP_MUL))[F.tid - 128] = mu[1536 + F.tid - 128]; }
    __syncthreads();
    const LAS float* prm = (const LAS float*)(lb + RP_PRM); const LAS float* mul = (const LAS float*)(lb + RP_MUL);
#pragma unroll 1
    for (int j = 0; j < 4; ++j) {
        const int tg = ((F.blk - blk0) >> 3) + 32 * (F.wave + 8 * j), t = tg * 16 + fr; const bool hp = (t & (SEQ - 1)) != 0;
        const bf16* pc = P + (size_t)t * NINP + RW_OFF; const bf16* pp = pc - NINP;
        v4u la[10], lp[10]; v2u xa[3][4], xb[3][4];
#pragma unroll
        for (int s2 = 0; s2 < 10; ++s2) { const int c = 1536 + 32 * s2 + 8 * fq; la[s2] = *(const GAS v4u*)(pc + c); lp[s2] = (v4u){0u, 0u, 0u, 0u}; if (hp) lp[s2] = *(const GAS v4u*)(pp + c); }
#pragma unroll
        for (int q = 0; q < 3; ++q)
#pragma unroll
            for (int nt = 0; nt < 4; ++nt) { const int c = 512 * q + 64 * h + 16 * nt + 4 * fq; xa[q][nt] = *(const GAS v2u*)(pc + c); xb[q][nt] = (v2u){0u, 0u}; if (hp) xb[q][nt] = *(const GAS v2u*)(pp + c); }
        bf16x8 fx[10];
#pragma unroll
        for (int s2 = 0; s2 < 10; ++s2) { const f32x4 m0 = *(const LAS f32x4*)(mul + 32 * s2 + 8 * fq), m1 = *(const LAS f32x4*)(mul + 32 * s2 + 8 * fq + 4);
            const v4u a = la[s2], b = lp[s2];
            float v[8] = {bf_lo(a.x), bf_hi(a.x), bf_lo(a.y), bf_hi(a.y), bf_lo(a.z), bf_hi(a.z), bf_lo(a.w), bf_hi(a.w)};
            const float bv[8] = {bf_lo(b.x), bf_hi(b.x), bf_lo(b.y), bf_hi(b.y), bf_lo(b.z), bf_hi(b.z), bf_lo(b.w), bf_hi(b.w)};
            const float mv[8] = {m0.x, m0.y, m0.z, m0.w, m1.x, m1.y, m1.z, m1.w};
#pragma unroll
            for (int i = 0; i < 8; ++i) { v[i] = v[i] + (bv[i] - v[i]) * mv[i]; if (s2 < 3) v[i] = tanhf_(v[i]); else if (s2 >= 6) v[i] = sigmoidf_(v[i]); }
            v4u o; o.x = cvt_pk_bf16(v[0], v[1]); o.y = cvt_pk_bf16(v[2], v[3]); o.z = cvt_pk_bf16(v[4], v[5]); o.w = cvt_pk_bf16(v[6], v[7]); fx[s2] = as_frag(o); }
        f32x4 r4[4], k4[4], v4[4];
#pragma unroll
        for (int nt = 0; nt < 4; ++nt) {
#define RP_LERP(dst_, q_) do { const f32x4 m_ = *(const LAS f32x4*)(prm + 320 + 64 * (q_) + 16 * nt + 4 * fq); const v2u a_ = xa[q_][nt], b_ = xb[q_][nt]; \
            dst_ = (f32x4){bf_lo(a_.x) + (bf_lo(b_.x) - bf_lo(a_.x)) * m_.x, bf_hi(a_.x) + (bf_hi(b_.x) - bf_hi(a_.x)) * m_.y, bf_lo(a_.y) + (bf_lo(b_.y) - bf_lo(a_.y)) * m_.z, bf_hi(a_.y) + (bf_hi(b_.y) - bf_hi(a_.y)) * m_.w}; } while (0)
            RP_LERP(r4[nt], 0); RP_LERP(k4[nt], 1); RP_LERP(v4[nt], 2);
#undef RP_LERP
        }
        float ss = 0.f;
#pragma unroll
        for (int nt = 0; nt < 4; ++nt) { const f32x4 kkw = *(const LAS f32x4*)(prm + 128 + 16 * nt + 4 * fq);
#pragma unroll
            for (int i = 0; i < 4; ++i) { const float kq = k4[nt][i] * kkw[i]; ss += kq * kq; } }
        ss += __shfl_xor(ss, 16); ss += __shfl_xor(ss, 32);
        const float inv = rcpf_(fmaxf(sqrtf(ss), 1e-12f));
        float br = 0.f, kr = 0.f, rkr = 0.f;
#pragma unroll
        for (int nt = 0; nt < 4; ++nt) { const int row = 16 * nt + fr;
            f32x4 aw = {0.f, 0.f, 0.f, 0.f}, ac = aw, ag = aw;
#pragma unroll
            for (int s2 = 0; s2 < 3; ++s2) { aw = MFMA16(as_frag(*(const LAS v4u*)(lb + RP_L0 + row * 208 + 64 * s2 + 16 * fq)), fx[s2], aw); ac = MFMA16(as_frag(*(const LAS v4u*)(lb + RP_L1 + row * 208 + 64 * s2 + 16 * fq)), fx[3 + s2], ac); }
#pragma unroll
            for (int s2 = 0; s2 < 4; ++s2) ag = MFMA16(as_frag(*(const LAS v4u*)(lb + RP_L2 + row * 272 + 64 * s2 + 16 * fq)), fx[6 + s2], ag);
            const int cl = 16 * nt + 4 * fq, c = 64 * h + cl;
            const f32x4 w0 = *(const LAS f32x4*)(prm + cl), a0 = *(const LAS f32x4*)(prm + 64 + cl), kkw = *(const LAS f32x4*)(prm + 128 + cl), kaw = *(const LAS f32x4*)(prm + 192 + cl), rkw = *(const LAS f32x4*)(prm + 256 + cl);
            f32x4 o_wr, o_kp, o_de, o_v, o_g, o_al, o_be;
#pragma unroll
            for (int i = 0; i < 4; ++i) {
                const float x = -(w0[i] + aw[i]);
                const float sp = (x > 20.f) ? x : __logf(1.f + __expf(x));
                const float wv = -sp - 0.5f, de = __expf(-__expf(wv));
                const float a = sigmoidf_(a0[i] + ac[i]);
                const float kn = k4[nt][i] * kkw[i] * inv, be = kn * a;
                const float kpv = k4[nt][i] * (1.f + (a - 1.f) * kaw[i]);
                o_al[i] = -kn; o_be[i] = be; o_de[i] = de; o_wr[i] = de * r4[nt][i]; o_kp[i] = kpv; o_v[i] = v4[nt][i]; o_g[i] = ag[i];
                br += be * r4[nt][i]; kr += kpv * r4[nt][i]; rkr += r4[nt][i] * kpv * rkw[i]; }
            const size_t o = (size_t)t * GW + c;
            *(GAS f32x4*)(RW + 1 * RWB + o) = o_de;
#define RW_ST16(k_, v_) *(GAS v2u*)((bf16*)(RW + (k_) * RWB) + o) = (v2u){cvt_pk_safe((v_)[0], (v_)[1]), cvt_pk_safe((v_)[2], (v_)[3])}
            RW_ST16(0, o_al); RW_ST16(2, o_wr); RW_ST16(3, o_kp); RW_ST16(4, o_be); RW_ST16(5, o_v); RW_ST16(6, o_g); }
#undef RW_ST16
        br += __shfl_xor(br, 16); br += __shfl_xor(br, 32); kr += __shfl_xor(kr, 16); kr += __shfl_xor(kr, 32); rkr += __shfl_xor(rkr, 16); rkr += __shfl_xor(rkr, 32);
        if (fq == 0) SC[(size_t)t * 8 + h] = (f32x4){br, kr, rkr, 0.f};
    }
    __syncthreads();
}

template <bool FINAL>
DI void s5_pass(KArgs A, const Frame& F, int l, int gw, int NGW) {
    const bf16* P = (const bf16*)(A->ws + WS_P); const unsigned char* sc = A->ws + ws_s5c(l);
    f32x2* E = (f32x2*)(A->ws + WS_S5E); const f32x2* X0 = (const f32x2*)(A->ws + WS_S5X); bf16* YS = (bf16*)(A->ws + WS_YS);
    const int lane = F.lane, fr = lane & 15, fq = lane >> 4;
    constexpr int XP = 272;
    LAS unsigned char* xs = F.lds + RING_OFF + F.wave * (32 * XP);
    for (int item = gw; item < BATCH * 32 * 128; item += NGW) {
        const int b = item >> 12, g = (item >> 7) & 31, ch = item & 127, t0 = b * SEQ + 64 * ch;
        const f32x4 lam = ((const f32x4*)(sc + S5C_LAM))[g * 64 + lane];
        float bre[16], bim[16];
        { const f32x4* bp = (const f32x4*)((const float*)(sc + S5C_BB) + (size_t)(g * 64 + lane) * 32);
#pragma unroll
          for (int q = 0; q < 4; ++q) { const f32x4 a = bp[q], c = bp[4 + q]; bre[4 * q] = a.x; bre[4 * q + 1] = a.y; bre[4 * q + 2] = a.z; bre[4 * q + 3] = a.w; bim[4 * q] = c.x; bim[4 * q + 1] = c.y; bim[4 * q + 2] = c.z; bim[4 * q + 3] = c.w; } }
        const bf16* up = P + (size_t)(t0 + lane) * NINP + S5_OFF + 16 * g;
        const v4u u0 = *(const GAS v4u*)up, u1 = *(const GAS v4u*)(up + 8);
        const unsigned uw[8] = {u0.x, u0.y, u0.z, u0.w, u1.x, u1.y, u1.z, u1.w};
        float xr = 0.f, xi = 0.f;
        if (FINAL) { const f32x2 x0 = X0[(size_t)item * 64 + lane]; xr = x0.x; xi = x0.y; }
        bf16x8 cf[4];
        if (FINAL) {
#pragma unroll
            for (int s = 0; s < 4; ++s) cf[s] = as_frag(*(const GAS v4u*)((const bf16*)(sc + S5C_CP) + (size_t)(g * 16 + fr) * 128 + 32 * s + 8 * fq)); }
#pragma unroll 1
        for (int half = 0; half < 2; ++half) {
#pragma unroll 4
            for (int tt = 0; tt < 32; ++tt) { const int tl = half * 32 + tt;
                float br_ = 0.f, bi_ = 0.f;
#pragma unroll
                for (int k = 0; k < 8; ++k) { const unsigned uu = (unsigned)__builtin_amdgcn_readlane((int)uw[k], tl);
                    const float ua = bf_lo(uu), ub = bf_hi(uu);
                    br_ += bre[2 * k] * ua + bre[2 * k + 1] * ub; bi_ += bim[2 * k] * ua + bim[2 * k + 1] * ub; }
                const float nr = lam.x * xr - lam.y * xi + br_, ni = lam.x * xi + lam.y * xr + bi_; xr = nr; xi = ni;
                if (FINAL) *(LAS unsigned*)(xs + tt * XP + 4 * lane) = cvt_pk_bf16(xr, xi); }
            if (FINAL) {
                LDS_WAIT();
#pragma unroll
                for (int mt = 0; mt < 2; ++mt) { f32x4 acc = {0.f, 0.f, 0.f, 0.f};
#pragma unroll
                    for (int s = 0; s < 4; ++s) acc = MFMA16(cf[s], as_frag(*(const LAS v4u*)(xs + (16 * mt + fr) * XP + 64 * s + 16 * fq)), acc);
                    const int t = t0 + half * 32 + 16 * mt + fr, c = 16 * g + 4 * fq;
                    const v2u uq = *(const GAS v2u*)(P + (size_t)t * NINP + S5_OFF + c); const f32x4 dk = *(const GAS f32x4*)(A->in[I_S5D] + l * GW + c);
                    const float y0 = gelu_tanh(acc[0] + dk.x * bf_lo(uq.x)), y1 = gelu_tanh(acc[1] + dk.y * bf_hi(uq.x)), y2 = gelu_tanh(acc[2] + dk.z * bf_lo(uq.y)), y3 = gelu_tanh(acc[3] + dk.w * bf_hi(uq.y));
                    v2u o; o.x = cvt_pk_bf16(y0, y1); o.y = cvt_pk_bf16(y2, y3); *(GAS v2u*)(YS + (size_t)t * GW + c) = o; }
                LDS_WAIT();
            }
        }
        if (!FINAL) E[(size_t)item * 64 + lane] = (f32x2){xr, xi};
    }
}
typedef short bf16x4 __attribute__((ext_vector_type(4)));
DI void s5_pass1_mfma(KArgs A, const Frame& F, int l) {
    const bf16* P = (const bf16*)(A->ws + WS_P); f32x2* E = (f32x2*)(A->ws + WS_S5E);
    const f32x2* pw = (const f32x2*)(A->ws + WS_MISC + MI_S5POW); const v2u* bfp = (const v2u*)(A->ws + WS_MISC + MI_S5BBF);
    const int lane = F.lane, fr = lane & 15, fq = lane >> 4, gwv = F.blk * NWAVES + F.wave;
    if (gwv >= 2048) return;
    const int b = gwv >> 10, g = (gwv >> 5) & 31, cq = gwv & 31;
    const int t0 = b * SEQ + 256 * cq;
    bf16x4 uf[16];
#pragma unroll
    for (int tl = 0; tl < 16; ++tl) uf[tl] = __builtin_bit_cast(bf16x4, *(const GAS v2u*)(P + (size_t)(t0 + 16 * tl + fr) * NINP + S5_OFF + 16 * g + 4 * fq));
#pragma unroll 1
    for (int nt = 0; nt < 4; ++nt) {
        const f32x2* pp = pw + (size_t)(g * 64 + 16 * nt + fr) * 17;
        f32x2 w[4];
#pragma unroll
        for (int i = 0; i < 4; ++i) w[i] = pp[15 - 4 * fq - i];
        const f32x2 L16 = pp[16];
        bf16x4 bf[2][2];
#pragma unroll
        for (int ri = 0; ri < 2; ++ri)
#pragma unroll
            for (int hl = 0; hl < 2; ++hl) bf[ri][hl] = __builtin_bit_cast(bf16x4, bfp[((size_t)((g * 4 + nt) * 2 + ri) * 2 + hl) * 64 + lane]);
#pragma unroll
        for (int k = 0; k < 4; ++k) { float ar_ = 0.f, ai_ = 0.f;
#pragma unroll
            for (int tl = 0; tl < 4; ++tl) { f32x4 dr = {0.f, 0.f, 0.f, 0.f}, di = dr;
                dr = __builtin_amdgcn_mfma_f32_16x16x16bf16_1k(uf[4 * k + tl], bf[0][0], dr, 0, 0, 0); dr = __builtin_amdgcn_mfma_f32_16x16x16bf16_1k(uf[4 * k + tl], bf[0][1], dr, 0, 0, 0);
                di = __builtin_amdgcn_mfma_f32_16x16x16bf16_1k(uf[4 * k + tl], bf[1][0], di, 0, 0, 0); di = __builtin_amdgcn_mfma_f32_16x16x16bf16_1k(uf[4 * k + tl], bf[1][1], di, 0, 0, 0);
                float sr = ar_ * L16.x - ai_ * L16.y, si = ar_ * L16.y + ai_ * L16.x;
#pragma unroll
                for (int i = 0; i < 4; ++i) { sr += w[i].x * dr[i] - w[i].y * di[i]; si += w[i].x * di[i] + w[i].y * dr[i]; }
                ar_ = sr; ai_ = si; }
            ar_ += __shfl_xor(ar_, 16); ar_ += __shfl_xor(ar_, 32); ai_ += __shfl_xor(ai_, 16); ai_ += __shfl_xor(ai_, 32);
            const size_t item = ((size_t)(b * 32 + g) << 7) + 4 * cq + k;
            if (fq == 0) E[item * 64 + 16 * nt + fr] = (f32x2){ar_, ai_}; } }
}
DI void s5_carry(KArgs A, const Frame& F, int l, int blk0) {
    const int i = (F.blk - blk0) * NT + F.tid; if (i < 0 || i >= BATCH * 32 * 64) return;
    const int bg = i >> 6, p = i & 63, g = bg & 31;
    const f32x4 lam = ((const f32x4*)(A->ws + ws_s5c(l) + S5C_LAM))[g * 64 + p];
    const f32x2* E = (const f32x2*)(A->ws + WS_S5E) + (size_t)bg * 128 * 64 + p; f32x2* X0 = (f32x2*)(A->ws + WS_S5X) + (size_t)bg * 128 * 64 + p;
    float xr = 0.f, xi = 0.f;
#pragma unroll 1
    for (int c0 = 0; c0 < 128; c0 += 32) { f32x2 e[32];
#pragma unroll
        for (int k = 0; k < 32; ++k) e[k] = E[(size_t)(c0 + k) * 64];
#pragma unroll
        for (int k = 0; k < 32; ++k) { X0[(size_t)(c0 + k) * 64] = (f32x2){xr, xi}; const float nr = lam.z * xr - lam.w * xi + e[k].x, ni = lam.z * xi + lam.w * xr + e[k].y; xr = nr; xi = ni; } }
}

constexpr int SCH = 32;
constexpr int SB_VEC = 5 * SCH * 64 * 4, SB_V = SCH * 16 * 4, SB_SC = SCH * 8, SB_BYTES = SB_VEC + SB_V + SB_SC;
DI void rwkv_scan(KArgs A, const Frame& F, int blk_) {
    const int bh = blk_ >> 2, q = blk_ & 3, b = bh >> 3, h = bh & 7;
    const float* RW = (const float*)(A->ws + WS_RW); const f32x4* SC = (const f32x4*)(A->ws + WS_RWSC); float* Yo = (float*)(A->ws + WS_RW) + 7 * RWB;
    const int lane = F.lane, w = F.wave;
    const bool loader = (w >= 4); const int lt = F.tid - 256;
    const int rho = lane >> 4, kq = lane & 15;
    f32x2 sa = {0.f, 0.f}, sb = {0.f, 0.f};
    constexpr int NCH = SEQ / SCH;
#define SCAN_LOAD(c_) do { const size_t tb_ = (size_t)b * SEQ + (size_t)(c_) * SCH; \
        _Pragma("unroll") for (int i = 0; i < 4; ++i) { const int idx = lt + 256 * i, ai = idx >> 8, arr = ai + (ai > 0), rem = idx & 255, row = rem >> 3, c8 = rem & 7; \
            rvh[i] = *(const GAS v4u*)((const bf16*)(RW + (size_t)arr * RWB) + (tb_ + row) * GW + 64 * h + 8 * c8); } \
        _Pragma("unroll") for (int i = 0; i < 2; ++i) { const int idx = lt + 256 * i, row = idx >> 4, c4 = idx & 15; rvd[i] = *(const GAS f32x4*)(RW + 1 * RWB + (tb_ + row) * GW + 64 * h + 4 * c4); } \
        if (lt < 64) { const int row = lt >> 1, c8 = lt & 1; rvv = *(const GAS v4u*)((const bf16*)(RW + 5 * RWB) + (tb_ + row) * GW + 64 * h + 16 * q + 8 * c8); } \
        else if (lt >= 128 && lt < 128 + SCH) { rsc = SC[(tb_ + (lt - 128)) * 8 + h]; } } while (0)
#define SCAN_UNPK(d_, u_) do { *(LAS f32x4*)(d_) = (f32x4){bf_lo((u_).x), bf_hi((u_).x), bf_lo((u_).y), bf_hi((u_).y)}; *(LAS f32x4*)((d_) + 16) = (f32x4){bf_lo((u_).z), bf_hi((u_).z), bf_lo((u_).w), bf_hi((u_).w)}; } while (0)
#define SCAN_STORE(buf_) do { LAS unsigned char* base_ = F.lds + RING_OFF + (buf_) * SB_BYTES; \
        _Pragma("unroll") for (int i = 0; i < 4; ++i) { const int idx = lt + 256 * i, ai = idx >> 8, arr = ai + (ai > 0), rem = idx & 255, row = rem >> 3, c8 = rem & 7; \
            SCAN_UNPK(base_ + ((arr * SCH + row) * 64 + 8 * c8) * 4, rvh[i]); } \
        _Pragma("unroll") for (int i = 0; i < 2; ++i) { const int idx = lt + 256 * i; *(LAS f32x4*)(base_ + (1 * SCH * 64) * 4 + idx * 16) = rvd[i]; } \
        if (lt < 64) { SCAN_UNPK(base_ + SB_VEC + lt * 32, rvv); } \
        else if (lt >= 128 && lt < 128 + SCH) *(LAS f32x2*)(base_ + SB_VEC + SB_V + (lt - 128) * 8) = (f32x2){rsc.x, rsc.y}; } while (0)
#define SCAN_LD(P_, t_) do { const LAS unsigned char* p_ = base + (t_) * 256 + 16 * kq; \
        P_##al = *(const LAS f32x4*)(p_); P_##de = *(const LAS f32x4*)(p_ + 1 * SCH * 256); P_##wr = *(const LAS f32x4*)(p_ + 2 * SCH * 256); \
        P_##kp = *(const LAS f32x4*)(p_ + 3 * SCH * 256); P_##be = *(const LAS f32x4*)(p_ + 4 * SCH * 256); \
        P_##vt = *(const LAS float*)(base + SB_VEC + ((t_) * 16 + 4 * w + rho) * 4); P_##sc = *(const LAS f32x2*)(base + SB_VEC + SB_V + (t_) * 8); } while (0)
#define SCAN_STEP(P_, t_) do { \
        f32x2 pa2 = sa * (f32x2){P_##al.x, P_##al.y} + sb * (f32x2){P_##al.z, P_##al.w}, py2 = sa * (f32x2){P_##wr.x, P_##wr.y} + sb * (f32x2){P_##wr.z, P_##wr.w}; \
        float pa = allsum16(pa2.x + pa2.y), py = allsum16(py2.x + py2.y); \
        sa = sa * (f32x2){P_##de.x, P_##de.y} + (f32x2){P_##kp.x, P_##kp.y} * P_##vt + (f32x2){P_##be.x, P_##be.y} * pa; \
        sb = sb * (f32x2){P_##de.z, P_##de.w} + (f32x2){P_##kp.z, P_##kp.w} * P_##vt + (f32x2){P_##be.z, P_##be.w} * pa; \
        const float y_ = py + pa * P_##sc.x + P_##vt * P_##sc.y; ysel = (kq == ((t_) & 15)) ? y_ : ysel; } while (0)
    if (loader) { v4u rvh[4], rvv = {0u, 0u, 0u, 0u}; f32x4 rvd[2], rsc = {0.f, 0.f, 0.f, 0.f}; SCAN_LOAD(0); SCAN_STORE(0); }
    __syncthreads();
#pragma unroll 1
    for (int c = 0; c < NCH; ++c) {
        if (loader) {
            if (c + 1 < NCH) { v4u rvh[4], rvv = {0u, 0u, 0u, 0u}; f32x4 rvd[2], rsc = {0.f, 0.f, 0.f, 0.f}; SCAN_LOAD(c + 1); SCAN_STORE((c + 1) & 1); }
        } else {
            const LAS unsigned char* base = F.lds + RING_OFF + (c & 1) * SB_BYTES;
            const size_t tb = (size_t)b * SEQ + (size_t)c * SCH;
            float* yp = Yo + (tb + kq) * GW + 64 * h + 16 * q + 4 * w + rho;
            f32x4 A_al, A_de, A_wr, A_kp, A_be, B_al, B_de, B_wr, B_kp, B_be; float A_vt, B_vt; f32x2 A_sc, B_sc; float ysel = 0.f;
            SCAN_LD(A_, 0);
#pragma unroll
            for (int t = 0; t < SCH; t += 2) {
                SCAN_LD(B_, t + 1); __builtin_amdgcn_sched_barrier(0);
                SCAN_STEP(A_, t); __builtin_amdgcn_sched_barrier(0);
                if (t + 2 < SCH) SCAN_LD(A_, t + 2);
                __builtin_amdgcn_sched_barrier(0);
                SCAN_STEP(B_, t + 1); __builtin_amdgcn_sched_barrier(0);
                if ((t & 15) == 14) yp[(size_t)(t - 14) * GW] = ysel;
            }
        }
        __syncthreads();
    }
#undef SCAN_LD
#undef SCAN_STEP
}
#define CKEN 7
constexpr int S2WG = 32;
#define CK_SEL_MASK 0
#define CK_SEL_VAL 0
#ifndef CHUNK_Y_TO_Z
#define CHUNK_Y_TO_Z 0
#endif
constexpr int CK_BT = 0, CK_KT = 8192, CK_RT = 16384, CK_VT = 24576  , CK_WT = 32768  , CK_U0T = 40960  , CK_S0 = 49152  ,
              CK_MTH = 57344, CK_MTL = 65536  , CK_GT = 73728  ,
              CK_BTT = 90112  , CK_KTT = 98304  , CK_WTT = 106496  , CK_PC = 114688  , CK_STRIDE = 114944;
DI unsigned short bfbits(float x) { return (unsigned short)(cvt_pk_safe(x, 0.f) & 0xffffu); }
DI v4u ld16(const unsigned char* p) { return *(const GAS v4u*)p; }
DI v2u ld8(const unsigned char* p) { return *(const GAS v2u*)p; }
DI float ldfc(const float* p) { return *p; }
#define CK_SYNC() do { asm volatile("s_waitcnt vmcnt(0)" ::: "memory"); __builtin_amdgcn_fence(__ATOMIC_ACQUIRE, "agent"); asm volatile("s_waitcnt vmcnt(0)" ::: "memory"); } while (0)

DI void rwkv_chunk_stage1(KArgs A, const Frame& F, int item, LAS float* xs) {
    const int b = item >> 10, h = (item >> 7) & 7, c = item & 127, lane = F.lane, fr = lane & 15, fq = lane >> 4;
    const size_t t0 = (size_t)b * SEQ + 64 * c;
    const float* RW = (const float*)(A->ws + WS_RW);
    unsigned char* ck = A->ws + WS_CK + (size_t)item * CK_STRIDE;
    float* atf = (float*)(A->ws + WS_RW) + (size_t)(item >> 10) * 2 * RWB + RWB / 2 + (size_t)(item & 1023) * 4096;
    const float* dec = RW + 1 * RWB + t0 * GW + 64 * h + lane;
    const bf16* pal = (const bf16*)(RW + 0 * RWB) + t0 * GW + 64 * h + lane; const bf16* pwr = (const bf16*)(RW + 2 * RWB) + t0 * GW + 64 * h + lane;
    const bf16* pkp = (const bf16*)(RW + 3 * RWB) + t0 * GW + 64 * h + lane; const bf16* pbe = (const bf16*)(RW + 4 * RWB) + t0 * GW + 64 * h + lane;
    const bf16* pvv = (const bf16*)(RW + 5 * RWB) + t0 * GW + 64 * h + lane;
    unsigned btp[4], ktp[4];
    float P = 1.f;
    {
        unsigned short* oAT = (unsigned short*)(ck + CK_S0) + lane; unsigned short* oBT = (unsigned short*)(ck + CK_BT) + lane; unsigned short* oKT = (unsigned short*)(ck + CK_KT) + lane; unsigned short* oRT = (unsigned short*)(ck + CK_RT) + lane;
        float pb = 0.f, pk = 0.f;
#pragma unroll
        for (int t = 0; t < 64; ++t) {
            const float d = dec[(size_t)t * GW], al = bf1(pal[(size_t)t * GW]), wr = bf1(pwr[(size_t)t * GW]), kp = bf1(pkp[(size_t)t * GW]), be = bf1(pbe[(size_t)t * GW]);
            const float Pm = P; P *= d; const float Pi = 1.f / P;
            const float at = al * Pm, bt = be * Pi, kt = kp * Pi, rt = wr * Pm;
            atf[t * 64 + lane] = at;
            oAT[t * 64] = bfbits(at); oBT[t * 64] = bfbits(bt); oKT[t * 64] = bfbits(kt); oRT[t * 64] = bfbits(rt);
            if (t & 1) { btp[(t >> 1) & 3] = cvt_pk_safe(pb, bt); ktp[(t >> 1) & 3] = cvt_pk_safe(pk, kt);
                if ((t & 7) == 7) { *(GAS v4u*)(ck + CK_BTT + lane * 128 + 16 * (t >> 3)) = (v4u){btp[0], btp[1], btp[2], btp[3]}; *(GAS v4u*)(ck + CK_KTT + lane * 128 + 16 * (t >> 3)) = (v4u){ktp[0], ktp[1], ktp[2], ktp[3]}; } }
            else { pb = bt; pk = kt; }
            if ((t & 15) == 15) __builtin_amdgcn_sched_barrier(0);
        }
        *(GAS float*)((float*)(ck + CK_PC) + lane) = P;
    }
    __builtin_amdgcn_sched_barrier(0);
    {
#pragma unroll
        for (int q = 0; q < 8; ++q) { unsigned w[4];
#pragma unroll
            for (int e = 0; e < 4; ++e) w[e] = (unsigned)pvv[(size_t)(8 * q + 2 * e) * GW] | ((unsigned)pvv[(size_t)(8 * q + 2 * e + 1) * GW] << 16);
            *(GAS v4u*)(ck + CK_VT + lane * 128 + 16 * q) = (v4u){w[0], w[1], w[2], w[3]}; }
    }
    CK_SYNC();
#pragma unroll 1
    for (int tt = 0; tt < 4; ++tt) {
        const bf16x8 fa0 = as_frag(ld16(ck + CK_S0 + (16 * tt + fr) * 128 + 16 * fq)), fa1 = as_frag(ld16(ck + CK_S0 + (16 * tt + fr) * 128 + 64 + 16 * fq));
        f32x4 aak[4];
#pragma unroll
        for (int tj = 0; tj < 4; ++tj) { aak[tj] = (f32x4){0.f, 0.f, 0.f, 0.f};
            if (tj <= tt) {
                const unsigned char* rb = ck + CK_BT + (16 * tj + fr) * 128 + 16 * fq; const unsigned char* rk = ck + CK_KT + (16 * tj + fr) * 128 + 16 * fq;
                f32x4 dab = {0.f, 0.f, 0.f, 0.f}, dak = dab;
                dab = MFMA16(as_frag(ld16(rb)), fa0, dab); dab = MFMA16(as_frag(ld16(rb + 64)), fa1, dab);
                dak = MFMA16(as_frag(ld16(rk)), fa0, dak); dak = MFMA16(as_frag(ld16(rk + 64)), fa1, dak);
                if (tj == tt) {
#pragma unroll
                    for (int i = 0; i < 4; ++i) { const bool keep = (4 * fq + i) < fr; dab[i] = keep ? dab[i] : 0.f; dak[i] = keep ? dak[i] : 0.f; } }
                *(LAS f32x4*)(xs + (16 * tt + fr) * 64 + 16 * tj + 4 * fq) = dab;
                aak[tj] = dak; } }
        f32x4 ru[4] = {{0.f, 0.f, 0.f, 0.f}, {0.f, 0.f, 0.f, 0.f}, {0.f, 0.f, 0.f, 0.f}, {0.f, 0.f, 0.f, 0.f}};
#pragma unroll
        for (int s = 0; s < 2; ++s) { if (2 * s <= tt) {
            v4u pf; pf.x = cvt_pk_safe(aak[2 * s][0], aak[2 * s][1]); pf.y = cvt_pk_safe(aak[2 * s][2], aak[2 * s][3]); pf.z = cvt_pk_safe(aak[2 * s + 1][0], aak[2 * s + 1][1]); pf.w = cvt_pk_safe(aak[2 * s + 1][2], aak[2 * s + 1][3]);
#pragma unroll
            for (int tv = 0; tv < 4; ++tv) { const unsigned char* rv = ck + CK_VT + (16 * tv + fr) * 128 + 64 * s + 8 * fq; const v2u va = ld8(rv), vb = ld8(rv + 32);
                ru[tv] = MFMA16(as_frag((v4u){va.x, va.y, vb.x, vb.y}), as_frag(pf), ru[tv]); } } }
#pragma unroll
        for (int tv = 0; tv < 4; ++tv) *(GAS f32x4*)(ck + CK_MTH + ((16 * tt + fr) * 64 + 16 * tv + 4 * fq) * 4) = ru[tv];
    }
    CK_SYNC(); LDS_WAIT();
#define CK_SOLVE(x_) do { _Pragma("unroll") for (int t = 1; t < 64; ++t) { float acc_ = x_[t]; \
            _Pragma("unroll") for (int jb = 0; jb < t; jb += 4) { const f32x4 a4 = *(const LAS f32x4*)(xs + t * 64 + jb); \
                acc_ += a4.x * x_[jb]; if (jb + 1 < t) acc_ += a4.y * x_[jb + 1]; if (jb + 2 < t) acc_ += a4.z * x_[jb + 2]; if (jb + 3 < t) acc_ += a4.w * x_[jb + 3]; } \
            x_[t] = acc_; } } while (0)
    {
        float xw[64];
#pragma unroll
        for (int t = 0; t < 64; ++t) xw[t] = ldfc(atf + t * 64 + lane);
        CK_SOLVE(xw);
        unsigned short* oWT = (unsigned short*)(ck + CK_WT) + lane;
#pragma unroll
        for (int t = 0; t < 64; ++t) oWT[t * 64] = bfbits(xw[t]);
#pragma unroll
        for (int q = 0; q < 8; ++q) *(GAS v4u*)(ck + CK_WTT + lane * 128 + 16 * q) = (v4u){cvt_pk_safe(xw[8 * q], xw[8 * q + 1]), cvt_pk_safe(xw[8 * q + 2], xw[8 * q + 3]), cvt_pk_safe(xw[8 * q + 4], xw[8 * q + 5]), cvt_pk_safe(xw[8 * q + 6], xw[8 * q + 7])};
    }
    __builtin_amdgcn_sched_barrier(0);
    {
        float xu[64]; const float* ru = (const float*)(ck + CK_MTH) + lane;
#pragma unroll
        for (int t = 0; t < 64; ++t) xu[t] = ldfc(ru + t * 64);
        CK_SOLVE(xu);
#pragma unroll
        for (int q = 0; q < 8; ++q) *(GAS v4u*)(ck + CK_U0T + lane * 128 + 16 * q) = (v4u){cvt_pk_safe(xu[8 * q], xu[8 * q + 1]), cvt_pk_safe(xu[8 * q + 2], xu[8 * q + 3]), cvt_pk_safe(xu[8 * q + 4], xu[8 * q + 5]), cvt_pk_safe(xu[8 * q + 6], xu[8 * q + 7])};
    }
#undef CK_SOLVE
    CK_SYNC();
    const float* pc = (const float*)(ck + CK_PC);
#pragma unroll 1
    for (int t2 = 0; t2 < 4; ++t2) {
        const bf16x8 fb0 = as_frag(ld16(ck + CK_BTT + (16 * t2 + fr) * 128 + 16 * fq)), fb1 = as_frag(ld16(ck + CK_BTT + (16 * t2 + fr) * 128 + 64 + 16 * fq));
        const float pck = ldfc(pc + 16 * t2 + fr);
        unsigned hw[4][2];
#pragma unroll
        for (int t1 = 0; t1 < 4; ++t1) { const unsigned char* rw = ck + CK_WTT + (16 * t1 + fr) * 128 + 16 * fq;
            f32x4 d = {0.f, 0.f, 0.f, 0.f}; d = MFMA16(as_frag(ld16(rw)), fb0, d); d = MFMA16(as_frag(ld16(rw + 64)), fb1, d);
            float m[4];
#pragma unroll
            for (int i = 0; i < 4; ++i) { m[i] = (d[i] + ((t1 == t2 && 4 * fq + i == fr) ? 1.f : 0.f)) * pck; }
            hw[t1][0] = cvt_pk_safe(m[0], m[1]); hw[t1][1] = cvt_pk_safe(m[2], m[3]); }
#pragma unroll
        for (int sx = 0; sx < 2; ++sx) *(GAS v4u*)(ck + CK_MTH + ((t2 * 2 + sx) * 64 + lane) * 16) = (v4u){hw[2 * sx][0], hw[2 * sx][1], hw[2 * sx + 1][0], hw[2 * sx + 1][1]}; }
#pragma unroll 1
    for (int tv = 0; tv < 4; ++tv) {
        const unsigned char* ru = ck + CK_U0T + (16 * tv + fr) * 128 + 16 * fq; const unsigned char* rv = ck + CK_VT + (16 * tv + fr) * 128 + 16 * fq;
        const bf16x8 fu0 = as_frag(ld16(ru)), fu1 = as_frag(ld16(ru + 64)), fv0 = as_frag(ld16(rv)), fv1 = as_frag(ld16(rv + 64));
#pragma unroll
        for (int t2 = 0; t2 < 4; ++t2) { const unsigned char* rb = ck + CK_BTT + (16 * t2 + fr) * 128 + 16 * fq; const unsigned char* rk = ck + CK_KTT + (16 * t2 + fr) * 128 + 16 * fq;
            f32x4 d = {0.f, 0.f, 0.f, 0.f};
            d = MFMA16(as_frag(ld16(rb)), fu0, d); d = MFMA16(as_frag(ld16(rb + 64)), fu1, d); d = MFMA16(as_frag(ld16(rk)), fv0, d); d = MFMA16(as_frag(ld16(rk + 64)), fv1, d);
            const f32x4 pr = *(const GAS f32x4*)(pc + 16 * t2 + 4 * fq);
            *(GAS f32x4*)(ck + CK_GT + ((tv * 4 + t2) * 64 + lane) * 16) = d * pr; } }
}
DI void rwkv_chunk_stage2(KArgs A, const Frame& F, int bh, int vt) {
    const int lane = F.lane, fr = lane & 15, fq = lane >> 4;
    f32x4 acc[4] = {{0.f, 0.f, 0.f, 0.f}, {0.f, 0.f, 0.f, 0.f}, {0.f, 0.f, 0.f, 0.f}, {0.f, 0.f, 0.f, 0.f}};
    unsigned char* ck0 = A->ws + WS_CK + (size_t)(bh * 128) * CK_STRIDE;
    const unsigned voff = (unsigned)lane * 16u;
#define S2_GLD(d_, sb_, imm_) asm volatile("global_load_dwordx4 %0, %1, %2 offset:" #imm_ : "=&v"(d_) : "v"(voff), "s"(sb_) : "memory")
#define S2_LOAD(P_, c_) do { const unsigned char* ck_ = ck0 + (size_t)(c_) * CK_STRIDE; const unsigned char* sg = ck_ + CK_GT + vt * 4096; const unsigned char* sm0 = ck_ + CK_MTH; const unsigned char* sm1 = ck_ + CK_MTH + 4096; \
        S2_GLD(P_##g[0], sg, 0); S2_GLD(P_##g[1], sg, 1024); S2_GLD(P_##g[2], sg, 2048); S2_GLD(P_##g[3], sg, 3072); \
        S2_GLD(P_##m[0][0], sm0, 0); S2_GLD(P_##m[0][1], sm0, 1024); S2_GLD(P_##m[1][0], sm0, 2048); S2_GLD(P_##m[1][1], sm0, 3072); \
        S2_GLD(P_##m[2][0], sm1, 0); S2_GLD(P_##m[2][1], sm1, 1024); S2_GLD(P_##m[3][0], sm1, 2048); S2_GLD(P_##m[3][1], sm1, 3072); } while (0)
#define S2_WAIT(P_, N_) do { asm volatile("s_waitcnt vmcnt(" #N_ ")" : "+v"(P_##g[0]), "+v"(P_##g[1]), "+v"(P_##g[2]), "+v"(P_##g[3]), "+v"(P_##m[0][0]), "+v"(P_##m[0][1]), "+v"(P_##m[1][0]), "+v"(P_##m[1][1]), \
        "+v"(P_##m[2][0]), "+v"(P_##m[2][1]), "+v"(P_##m[3][0]), "+v"(P_##m[3][1]) :: "memory"); } while (0)
#define S2_STEP(P_, c_) do { unsigned char* ck_ = ck0 + (size_t)(c_) * CK_STRIDE; v4u sh[2]; \
        _Pragma("unroll") for (int s = 0; s < 2; ++s) { \
            const unsigned a0 = cvt_pk_safe(acc[2 * s][0], acc[2 * s][1]), a1 = cvt_pk_safe(acc[2 * s][2], acc[2 * s][3]), b0 = cvt_pk_safe(acc[2 * s + 1][0], acc[2 * s + 1][1]), b1 = cvt_pk_safe(acc[2 * s + 1][2], acc[2 * s + 1][3]); \
            sh[s] = (v4u){a0, a1, b0, b1}; \
            *(GAS v2u*)(ck_ + CK_S0 + (16 * vt + fr) * 128 + (32 * s + 4 * fq) * 2) = (v2u){a0, a1}; \
            *(GAS v2u*)(ck_ + CK_S0 + (16 * vt + fr) * 128 + (32 * s + 16 + 4 * fq) * 2) = (v2u){b0, b1}; } \
        _Pragma("unroll") for (int t2 = 0; t2 < 4; ++t2) { f32x4 d = P_##g[t2]; \
            d = MFMA16(as_frag(P_##m[t2][0]), as_frag(sh[0]), d); d = MFMA16(as_frag(P_##m[t2][1]), as_frag(sh[1]), d); acc[t2] = d; } } while (0)
    f32x4 Ag[4], Bg[4], Cg[4]; v4u Am[4][2], Bm[4][2], Cm[4][2];
    S2_LOAD(A, 0); S2_LOAD(B, 1); S2_LOAD(C, 2);
    S2_WAIT(A, 24); S2_STEP(A, 0); S2_LOAD(A, 3);
    S2_WAIT(B, 28); S2_STEP(B, 1); S2_LOAD(B, 4);
    S2_WAIT(C, 32); S2_STEP(C, 2); S2_LOAD(C, 5);
#pragma unroll 1
    for (int c = 3; c < 126; c += 3) {
        S2_WAIT(A, 32); S2_STEP(A, c); S2_LOAD(A, c + 3);
        S2_WAIT(B, 32); S2_STEP(B, c + 1); if (c + 4 < 128) S2_LOAD(B, c + 4);
        S2_WAIT(C, 32); S2_STEP(C, c + 2); if (c + 5 < 128) S2_LOAD(C, c + 5);
    }
    S2_WAIT(A, 0); S2_STEP(A, 126); S2_WAIT(B, 0); S2_STEP(B, 127);
#undef S2_GLD
#undef S2_LOAD
#undef S2_WAIT
#undef S2_STEP
}
DI void rwkv_chunk_stage3(KArgs A, const Frame& F, int item, int l) {
    const int b = item >> 10, h = (item >> 7) & 7, c = item & 127, lane = F.lane, fr = lane & 15, fq = lane >> 4;
    const size_t t0 = (size_t)b * SEQ + 64 * c;
    const unsigned char* ck = A->ws + WS_CK + (size_t)item * CK_STRIDE;
    const f32x4* SC = (const f32x4*)(A->ws + WS_RWSC); const bf16* Gt = (const bf16*)((const float*)(A->ws + WS_RW) + 6 * RWB) + t0 * GW + 64 * h; bf16* Yc = (bf16*)(A->ws + WS_YCAT) + t0 * D + 512 + 64 * h;
    float gng[4], gnb[4];
#pragma unroll
    for (int tv = 0; tv < 4; ++tv) { gng[tv] = A->in[I_GNG][l * GW + 64 * h + 16 * tv + fr]; gnb[tv] = A->in[I_GNB][l * GW + 64 * h + 16 * tv + fr]; }
    bf16x8 s0f[4][2], uf[4][2];
#pragma unroll
    for (int tv = 0; tv < 4; ++tv) { const unsigned char* rs = ck + CK_S0 + (16 * tv + fr) * 128 + 16 * fq; s0f[tv][0] = as_frag(ld16(rs)); s0f[tv][1] = as_frag(ld16(rs + 64)); }
#pragma unroll
    for (int tv = 0; tv < 4; ++tv) { f32x4 u[4];
#pragma unroll
        for (int tt = 0; tt < 4; ++tt) { const unsigned char* rw = ck + CK_WT + (16 * tt + fr) * 128 + 16 * fq;
            f32x4 d = {0.f, 0.f, 0.f, 0.f}; d = MFMA16(as_frag(ld16(rw)), s0f[tv][0], d); d = MFMA16(as_frag(ld16(rw + 64)), s0f[tv][1], d);
            const v2u u0 = ld8(ck + CK_U0T + (16 * tv + fr) * 128 + (16 * tt + 4 * fq) * 2);
            u[tt] = d + (f32x4){bf_lo(u0.x), bf_hi(u0.x), bf_lo(u0.y), bf_hi(u0.y)}; }
#pragma unroll
        for (int s = 0; s < 2; ++s) uf[tv][s] = as_frag((v4u){cvt_pk_safe(u[2 * s][0], u[2 * s][1]), cvt_pk_safe(u[2 * s][2], u[2 * s][3]), cvt_pk_safe(u[2 * s + 1][0], u[2 * s + 1][1]), cvt_pk_safe(u[2 * s + 1][2], u[2 * s + 1][3])}); }
#pragma unroll 1
    for (int tt = 0; tt < 4; ++tt) {
        const unsigned char* rr = ck + CK_RT + (16 * tt + fr) * 128 + 16 * fq; const bf16x8 fr0 = as_frag(ld16(rr)), fr1 = as_frag(ld16(rr + 64));
        float rk4[4]; unsigned short gq[4][4]; v2u vq[4];
#pragma unroll
        for (int i = 0; i < 4; ++i) rk4[i] = SC[(t0 + 16 * tt + 4 * fq + i) * 8 + h].z;
#pragma unroll
        for (int tv = 0; tv < 4; ++tv) { vq[tv] = ld8(ck + CK_VT + (16 * tv + fr) * 128 + (16 * tt + 4 * fq) * 2);
#pragma unroll
            for (int i = 0; i < 4; ++i) gq[tv][i] = Gt[(size_t)(16 * tt + 4 * fq + i) * GW + 16 * tv + fr]; }
        f32x4 arb[4], ark[4];
#pragma unroll
        for (int tj = 0; tj < 4; ++tj) { arb[tj] = (f32x4){0.f, 0.f, 0.f, 0.f}; ark[tj] = arb[tj];
            if (tj <= tt) { const unsigned char* rb = ck + CK_BT + (16 * tj + fr) * 128 + 16 * fq; const unsigned char* rk = ck + CK_KT + (16 * tj + fr) * 128 + 16 * fq;
                f32x4 db = {0.f, 0.f, 0.f, 0.f}, dk = db;
                db = MFMA16(as_frag(ld16(rb)), fr0, db); db = MFMA16(as_frag(ld16(rb + 64)), fr1, db); dk = MFMA16(as_frag(ld16(rk)), fr0, dk); dk = MFMA16(as_frag(ld16(rk + 64)), fr1, dk);
                if (tj == tt) {
#pragma unroll
                    for (int i = 0; i < 4; ++i) { const bool keep = (4 * fq + i) <= fr; db[i] = keep ? db[i] : 0.f; dk[i] = keep ? dk[i] : 0.f; } }
                arb[tj] = db; ark[tj] = dk; } }
        f32x4 y[4] = {{0.f, 0.f, 0.f, 0.f}, {0.f, 0.f, 0.f, 0.f}, {0.f, 0.f, 0.f, 0.f}, {0.f, 0.f, 0.f, 0.f}};
#pragma unroll
        for (int s = 0; s < 2; ++s) { if (2 * s <= tt) {
            const bf16x8 fb = as_frag((v4u){cvt_pk_safe(arb[2 * s][0], arb[2 * s][1]), cvt_pk_safe(arb[2 * s][2], arb[2 * s][3]), cvt_pk_safe(arb[2 * s + 1][0], arb[2 * s + 1][1]), cvt_pk_safe(arb[2 * s + 1][2], arb[2 * s + 1][3])});
            const bf16x8 fk = as_frag((v4u){cvt_pk_safe(ark[2 * s][0], ark[2 * s][1]), cvt_pk_safe(ark[2 * s][2], ark[2 * s][3]), cvt_pk_safe(ark[2 * s + 1][0], ark[2 * s + 1][1]), cvt_pk_safe(ark[2 * s + 1][2], ark[2 * s + 1][3])});
#pragma unroll
            for (int tv = 0; tv < 4; ++tv) { const unsigned char* rv = ck + CK_VT + (16 * tv + fr) * 128 + 64 * s + 8 * fq; const v2u va = ld8(rv), vb = ld8(rv + 32);
                y[tv] = MFMA16(fb, uf[tv][s], y[tv]); y[tv] = MFMA16(fk, as_frag((v4u){va.x, va.y, vb.x, vb.y}), y[tv]); } } }
#pragma unroll
        for (int tv = 0; tv < 4; ++tv) { y[tv] = MFMA16(fr0, s0f[tv][0], y[tv]); y[tv] = MFMA16(fr1, s0f[tv][1], y[tv]); }
#pragma unroll
        for (int i = 0; i < 4; ++i) {
            const float mean = allsum16((y[0][i] + y[1][i]) + (y[2][i] + y[3][i])) * (1.f / 64.f);
            const float d0 = y[0][i] - mean, d1 = y[1][i] - mean, d2 = y[2][i] - mean, d3 = y[3][i] - mean;
            const float rstd = 1.f / sqrtf(allsum16((d0 * d0 + d1 * d1) + (d2 * d2 + d3 * d3)) * (1.f / 64.f) + GN_EPS);
            const float dd[4] = {d0, d1, d2, d3};
#pragma unroll
            for (int tv = 0; tv < 4; ++tv) { const float vv = (i == 0) ? bf_lo(vq[tv].x) : (i == 1) ? bf_hi(vq[tv].x) : (i == 2) ? bf_lo(vq[tv].y) : bf_hi(vq[tv].y);
                const float r = (dd[tv] * rstd * gng[tv] + gnb[tv] + vv * rk4[i]) * bf1(gq[tv][i]);
                Yc[(size_t)(16 * tt + 4 * fq + i) * D + 16 * tv + fr] = bfbits(r); } }
    }
}

DI void rwkv_post_part(KArgs A, const Frame& F, int l, int blk0, int nblk) {
    const float* RW = (const float*)(A->ws + WS_RW); const f32x4* SC = (const f32x4*)(A->ws + WS_RWSC); bf16* Y = (bf16*)(A->ws + WS_YCAT);
    const int gw = (F.blk - blk0) * NWAVES + F.wave, NGW = nblk * NWAVES, c = 8 * F.lane, h = F.lane >> 3;
    const f32x4 g0 = *(const GAS f32x4*)(A->in[I_GNG] + l * GW + c), g1 = *(const GAS f32x4*)(A->in[I_GNG] + l * GW + c + 4), b0 = *(const GAS f32x4*)(A->in[I_GNB] + l * GW + c), b1 = *(const GAS f32x4*)(A->in[I_GNB] + l * GW + c + 4);
    for (int t = gw; t < T; t += NGW) { const size_t o = (size_t)t * GW + c;
        const float* ysrc = (CK_SEL_MASK && ((((t & (SEQ - 1)) >> 6) & CK_SEL_MASK) == CK_SEL_VAL)) ? (const float*)(A->ws + WS_Z) : RW + 7 * RWB;
        const f32x4 y0 = *(const GAS f32x4*)(ysrc + o), y1 = *(const GAS f32x4*)(ysrc + o + 4);
        const v4u vv8 = *(const GAS v4u*)((const bf16*)(RW + 5 * RWB) + o), gg8 = *(const GAS v4u*)((const bf16*)(RW + 6 * RWB) + o);
        const f32x4 v0 = {bf_lo(vv8.x), bf_hi(vv8.x), bf_lo(vv8.y), bf_hi(vv8.y)}, v1 = {bf_lo(vv8.z), bf_hi(vv8.z), bf_lo(vv8.w), bf_hi(vv8.w)},
                    q0 = {bf_lo(gg8.x), bf_hi(gg8.x), bf_lo(gg8.y), bf_hi(gg8.y)}, q1 = {bf_lo(gg8.z), bf_hi(gg8.z), bf_lo(gg8.w), bf_hi(gg8.w)};
        const float rkr = SC[(size_t)t * 8 + h].z;
        float s = (y0.x + y0.y) + (y0.z + y0.w) + (y1.x + y1.y) + (y1.z + y1.w);
        s += __shfl_xor(s, 1); s += __shfl_xor(s, 2); s += __shfl_xor(s, 4);
        const float mean = s * (1.f / 64.f); const f32x4 d0 = y0 - mean, d1 = y1 - mean;
        float s2 = (d0.x * d0.x + d0.y * d0.y) + (d0.z * d0.z + d0.w * d0.w) + (d1.x * d1.x + d1.y * d1.y) + (d1.z * d1.z + d1.w * d1.w);
        s2 += __shfl_xor(s2, 1); s2 += __shfl_xor(s2, 2); s2 += __shfl_xor(s2, 4);
        const float rstd = 1.f / sqrtf(s2 * (1.f / 64.f) + GN_EPS);
        const f32x4 r0 = (d0 * rstd * g0 + b0 + v0 * rkr) * q0, r1 = (d1 * rstd * g1 + b1 + v1 * rkr) * q1;
        v4u ov; ov.x = cvt_pk_bf16(r0.x, r0.y); ov.y = cvt_pk_bf16(r0.z, r0.w); ov.z = cvt_pk_bf16(r1.x, r1.y); ov.w = cvt_pk_bf16(r1.z, r1.w);
        *(GAS v4u*)(Y + (size_t)t * D + 512 + c) = ov; }
}

DI void phase_ln2(KArgs A, const Frame& F, int l) {
    if (l + 1 < DEPTH) mod_finalize(A, F, l + 1);
    LAS float* ms = (LAS float*)(F.lds + RING_OFF);
    stage_mod(A, ms + 4096, l, 3, 0.f, F.tid); stage_mod(A, ms, l, 4, 1.f, F.tid);
    for (int i = F.tid; i < D; i += NT) { ms[8192 + i] = A->in[I_LNG][(size_t)(l * 2 + 0) * D + i]; ms[8192 + D + i] = A->in[I_LNB][(size_t)(l * 2 + 0) * D + i]; }
    __syncthreads();
    const int gw = F.blk * NWAVES + F.wave, NGW = F.G * NWAVES;
    float* Z = (float*)(A->ws + WS_Z); bf16* H = (bf16*)(A->ws + WS_H);
    for (int row0 = gw; row0 < T; row0 += 2 * NGW) { f32x4 v[2][8];
#pragma unroll
        for (int r = 0; r < 2; ++r) { const GAS f32x4* zr = (const GAS f32x4*)(Z + (size_t)(row0 + r * NGW) * D) + F.lane;
#pragma unroll
            for (int j = 0; j < 8; ++j) v[r][j] = zr[64 * j]; }
#pragma unroll
        for (int r = 0; r < 2; ++r) { const int row = row0 + r * NGW, b = row >> 13;
            float mean, rstd; row_stats(v[r], mean, rstd);
            if (F.lane == 0) ((f32x2*)(A->ws + WS_MISC + MI_STATS))[row] = (f32x2){mean, rstd};
#pragma unroll
            for (int j = 0; j < 8; ++j) { const int c = 4 * (F.lane + 64 * j); v[r][j] = (v[r][j] - mean) * rstd * *(const LAS f32x4*)(ms + 8192 + c) + *(const LAS f32x4*)(ms + 8192 + D + c); }
            ada_store(v[r], ms + b * 2048, ms + 4096 + b * 2048, H + (size_t)row * D, nullptr, F.lane); } }
    __syncthreads();
}
DI void phase_router(KArgs A, const Frame& F, int l) {
    LAS int* cnt = (LAS int*)(F.lds + RING_OFF);
    LAS float* lg = (LAS float*)(F.lds + RING_OFF + 1024);
    constexpr int KC = 256, WP = KC * 2 + 16, WBUF = 96 * WP;
    LAS unsigned char* wb = F.lds + RING_OFF + 16384;
    static_assert(16384 + 2 * WBUF <= RING_BYTES, "router LDS");
    if (F.tid < 32) cnt[F.tid] = 0;
    const bf16* H = (const bf16*)(A->ws + WS_H);
    const bf16* W = (const bf16*)(A->ws + WS_ROUT);
    const int lane = F.lane, fr = lane & 15, fq = lane >> 4;
    const int t0 = (F.blk * 4 + (F.wave & 3)) * 16;
    const bf16* hp = H + (size_t)(t0 + fr) * D + 8 * fq;
    f32x4 acc[3] = {{0.f, 0.f, 0.f, 0.f}, {0.f, 0.f, 0.f, 0.f}, {0.f, 0.f, 0.f, 0.f}};
    v4u r[6], rn[6]; v4u xh[8], xn[8];
#pragma unroll
    for (int s2 = 0; s2 < 8; ++s2) { xh[s2] = (v4u){0u, 0u, 0u, 0u}; xn[s2] = xh[s2]; }
#define RT_LDW(dst_, kc_) do { _Pragma("unroll") for (int j = 0; j < 6; ++j) { const int p = F.tid + 512 * j; dst_[j] = *(const GAS v4u*)(W + (size_t)(p >> 5) * D + (kc_) * KC + 8 * (p & 31)); } } while (0)
#define RT_STW(buf_, src_) do { _Pragma("unroll") for (int j = 0; j < 6; ++j) { const int p = F.tid + 512 * j; *(LAS v4u*)(wb + (buf_) * WBUF + (p >> 5) * WP + 16 * (p & 31)) = src_[j]; } } while (0)
#define RT_LDH(dst_, kc_) do { _Pragma("unroll") for (int s2 = 0; s2 < 8; ++s2) dst_[s2] = *(const GAS v4u*)(hp + (kc_) * KC + 32 * s2); } while (0)
    RT_LDW(r, 0); if (F.wave < 4) RT_LDH(xh, 0);
    RT_STW(0, r);
    __syncthreads();
#pragma unroll 1
    for (int kc = 0; kc < D / KC; ++kc) {
        const bool more = (kc + 1 < D / KC);
        if (more) { RT_LDW(rn, kc + 1); if (F.wave < 4) RT_LDH(xn, kc + 1); }
        if (F.wave < 4) { const LAS unsigned char* bw = wb + (kc & 1) * WBUF;
#pragma unroll
            for (int s2 = 0; s2 < 8; ++s2)
#pragma unroll
                for (int nt = 0; nt < 3; ++nt) { const LAS unsigned char* q = bw + (16 * nt + fr) * WP + 64 * s2 + 16 * fq;
                    acc[nt] = MFMA16(as_frag(*(const LAS v4u*)q), as_frag(xh[s2]), acc[nt]); acc[nt] = MFMA16(as_frag(*(const LAS v4u*)(q + 48 * WP)), as_frag(xh[s2]), acc[nt]); } }
        if (more) RT_STW((kc + 1) & 1, rn);
        __syncthreads();
#pragma unroll
        for (int s2 = 0; s2 < 8; ++s2) xh[s2] = xn[s2];
    }
#undef RT_LDW
#undef RT_STW
#undef RT_LDH
    if (F.wave < 4) {
        LAS float* my = lg + F.wave * (16 * 48);
#pragma unroll
        for (int nt = 0; nt < 3; ++nt)
#pragma unroll
            for (int i = 0; i < 4; ++i) my[fr * 48 + 16 * nt + 4 * fq + i] = acc[nt][i];
        LDS_WAIT();
        if (lane < 16) { const int t = t0 + lane; const LAS float* q = my + lane * 48;
            float gl[4]; int gi = 0; float gm = -3.4e38f;
#pragma unroll
            for (int j = 0; j < 4; ++j) { gl[j] = q[j] + A->in[I_RGB][l * 4 + j]; if (gl[j] > gm) { gm = gl[j]; gi = j; } }
            float gs = 0.f;
#pragma unroll
            for (int j = 0; j < 4; ++j) gs += __expf(gl[j] - gm);
            const float gval = 1.f / gs;
            float e1 = -3.4e38f, e2 = -3.4e38f; int i1 = 0, i2 = 0;
            for (int j = 0; j < 8; ++j) { const float v = q[4 + 8 * gi + j] + A->in[I_REB][l * 32 + 8 * gi + j];
                if (v > e1) { e2 = e1; i2 = i1; e1 = v; i1 = j; } else if (v > e2) { e2 = v; i2 = j; } }
            const float w2 = gval / (1.f + __expf(e1 - e2)), w1 = gval - w2;
            const int id1 = 8 * gi + i1, id2 = 8 * gi + i2;
            ((i32x2*)(A->ws + WS_MISC + MI_ROUTE_E))[t] = (i32x2){id1, id2};
            ((f32x2*)(A->ws + WS_MISC + MI_ROUTE_W))[t] = (f32x2){w1, w2};
            __hip_atomic_fetch_add(&cnt[id1], 1, __ATOMIC_RELAXED, __HIP_MEMORY_SCOPE_WORKGROUP); __hip_atomic_fetch_add(&cnt[id2], 1, __ATOMIC_RELAXED, __HIP_MEMORY_SCOPE_WORKGROUP); }
        LDS_WAIT();
    }
    __syncthreads();
    if (F.tid < 32) ((int*)(A->ws + WS_MISC + MI_COUNTS))[F.blk * 32 + F.tid] = cnt[F.tid];
    __syncthreads();
}
DI void phase_dispatch(KArgs A, const Frame& F) {
    LAS int* tot = (LAS int*)(F.lds + RING_OFF);
    LAS int* pre = tot + 32; LAS int* pst = tot + 64; LAS int* part = tot + 96; LAS int* ids = part + 16 * 64; LAS int* dst = ids + 128;
    const int* counts = (const int*)(A->ws + WS_MISC + MI_COUNTS);
    { const int e = F.tid & 31, pt = F.tid >> 5; int s = 0, sp = 0;
      for (int k = 0; k < 16; ++k) { const int bb = pt * 16 + k; if (bb < F.G) { const int c = counts[bb * 32 + e]; s += c; if (bb < F.blk) sp += c; } }
      part[pt * 64 + e] = s; part[pt * 64 + 32 + e] = sp; }
    __syncthreads();
    if (F.tid < 32) { int s = 0, sp = 0; for (int k = 0; k < 16; ++k) { s += part[k * 64 + F.tid]; sp += part[k * 64 + 32 + F.tid]; } tot[F.tid] = s; pre[F.tid] = sp; }
    if (F.tid >= 64 && F.tid < 64 + 64) { const int tk = F.tid - 64; const i32x2 e = ((const i32x2*)(A->ws + WS_MISC + MI_ROUTE_E))[F.blk * 64 + tk]; ids[2 * tk] = e.x; ids[2 * tk + 1] = e.y; }
    __syncthreads();
    if (F.tid == 0) { int s = 0; for (int e = 0; e < 32; ++e) { pst[e] = s; s += (tot[e] + 255) & ~255; }
        if (F.blk == 0) { int* te = (int*)(A->ws + WS_MISC + MI_TILEE); int tl = 0; for (int e = 0; e < 32; ++e) { const int n = (tot[e] + 255) >> 8; for (int k = 0; k < n; ++k) te[tl++] = e; } te[MAXTILES] = tl; } }
    __syncthreads();
    if (F.tid < 32) { int run = pst[F.tid] + pre[F.tid]; for (int a = 0; a < 128; ++a) if (ids[a] == F.tid) dst[a] = run++; }
    __syncthreads();
    if (F.tid < 64) { const int t = F.blk * 64 + F.tid; ((i32x2*)(A->ws + WS_MISC + MI_DEST))[t] = (i32x2){dst[2 * F.tid], dst[2 * F.tid + 1]};
        const f32x2 w = ((const f32x2*)(A->ws + WS_MISC + MI_ROUTE_W))[t]; float* rw = (float*)(A->ws + WS_MISC + MI_ROWW); rw[dst[2 * F.tid]] = w.x; rw[dst[2 * F.tid + 1]] = w.y; }
    const bf16* H = (const bf16*)(A->ws + WS_H); bf16* XB = (bf16*)(A->ws + WS_XB);
    for (int a = (F.tid >> 8); a < 128; a += 2) { const int t = F.blk * 64 + (a >> 1), c = (F.tid & 255) * 8;
        *(GAS v4u*)(XB + (size_t)dst[a] * D + c) = *(const GAS v4u*)(H + (size_t)t * D + c); }
    __syncthreads();
}
DI void phase_ln3(KArgs A, const Frame& F, int l, float* xout) {
    LAS float* ms = (LAS float*)(F.lds + RING_OFF);
    const bool next = (l + 1 < DEPTH);
    stage_mod(A, ms, l, 5, 1.f, F.tid);
    if (next) { stage_mod(A, ms + 4096, l + 1, 1, 1.f, F.tid); stage_mod(A, ms + 8192, l + 1, 0, 0.f, F.tid); }
    for (int i = F.tid; i < D; i += NT) { ms[12288 + i] = A->in[I_LNG][(size_t)(l * 2 + 1) * D + i]; ms[12288 + D + i] = A->in[I_LNB][(size_t)(l * 2 + 1) * D + i];
        ms[16384 + i] = A->in[I_LNG][(size_t)(l * 2 + 0) * D + i]; ms[16384 + D + i] = A->in[I_LNB][(size_t)(l * 2 + 0) * D + i]; }
    __syncthreads();
    const int gw = F.blk * NWAVES + F.wave, NGW = F.G * NWAVES;
    const f32x2* stats = (const f32x2*)(A->ws + WS_MISC + MI_STATS);
    const float* Z = (const float*)(A->ws + WS_Z); const bf16* YR = (const bf16*)(A->ws + WS_YR); bf16* H = (bf16*)(A->ws + WS_H);
    const i32x2* dest = (const i32x2*)(A->ws + WS_MISC + MI_DEST);
    for (int row0 = gw; row0 < T; row0 += 2 * NGW) { f32x4 v[2][8];
        const i32x2 d0 = dest[row0], d1 = dest[row0 + NGW];
#pragma unroll
        for (int r = 0; r < 2; ++r) { const GAS f32x4* zr = (const GAS f32x4*)(Z + (size_t)(row0 + r * NGW) * D) + F.lane;
#pragma unroll
            for (int j = 0; j < 8; ++j) v[r][j] = zr[64 * j]; }
#pragma unroll
        for (int r = 0; r < 2; ++r) { const int row = row0 + r * NGW, b = row >> 13; const i32x2 d = r ? d1 : d0; const f32x2 st = stats[row];
            const GAS v2u* y0 = (const GAS v2u*)(YR + (size_t)d.x * D) + F.lane; const GAS v2u* y1 = (const GAS v2u*)(YR + (size_t)d.y * D) + F.lane;
            v2u ya[8], yb[8];
#pragma unroll
            for (int j = 0; j < 8; ++j) { ya[j] = y0[64 * j]; yb[j] = y1[64 * j]; }
            __builtin_amdgcn_sched_barrier(0);
#pragma unroll
            for (int j = 0; j < 8; ++j) { const int c = 4 * (F.lane + 64 * j); const v2u a = ya[j], q = yb[j]; const f32x4 gt = *(const LAS f32x4*)(ms + b * 2048 + c);
                const f32x4 ym = {bf_lo(a.x) + bf_lo(q.x), bf_hi(a.x) + bf_hi(q.x), bf_lo(a.y) + bf_lo(q.y), bf_hi(a.y) + bf_hi(q.y)};
                const f32x4 x1 = (v[r][j] - st.x) * st.y * *(const LAS f32x4*)(ms + 16384 + c) + *(const LAS f32x4*)(ms + 16384 + D + c);
                v[r][j] = x1 * ALPHA + gt * ym; }
            float mean, rstd; row_stats(v[r], mean, rstd);
            GAS f32x4* xo = (GAS f32x4*)(xout + (size_t)row * D) + F.lane;
#pragma unroll
            for (int j = 0; j < 8; ++j) { const int c = 4 * (F.lane + 64 * j); v[r][j] = (v[r][j] - mean) * rstd * *(const LAS f32x4*)(ms + 12288 + c) + *(const LAS f32x4*)(ms + 12288 + D + c); xo[64 * j] = v[r][j]; }
            if (next) ada_store(v[r], ms + 4096 + b * 2048, ms + 8192 + b * 2048, H + (size_t)row * D, nullptr, F.lane);
            __builtin_amdgcn_sched_barrier(0); } }
    __syncthreads();
}

constexpr int NPH = 15;
#ifdef ONLY_PHASE
#define IN(k) ((((k) % NPH) == ONLY_PHASE) && lo <= (k) && (k) < hi)
#else
#define IN(k) (lo <= (k) && (k) < hi)
#endif
#ifndef REPMASK
#define REPMASK 0
#endif
#ifndef BARREP
#define BARREP 1
#endif
#define REP4A 1
#define REP4B 1
#define REP_S2 1
#define REP_PREP 1
#define REP_S5A 1
#define REP_S5C 1
#define REP_CONV 1
#define REP_ATT 1
#define REP_ST1 1
#define NREP(k) (1 + ((REPMASK >> (k)) & 1))
#define SEAM(k) do { if (IN(k) && IN((k) + 1)) { for (int br_ = 0; br_ < BARREP; ++br_) xcd_barrier(bar); } } while (0)
template <int l> DI void run_layer(KArgs A0, LAS unsigned char* lds, const XcdBarrier& bar, const int lo, const int hi, const int wv) {
    KArgs A = A0; Frame F;
    {
        constexpr int p0 = l * NPH;

        for (int rep_ = 0; rep_ < NREP(0); ++rep_) { A = launder(A0); F = mkframe(lds, wv); if (IN(p0 + 0) && l == 0) phase_wprep_a(A, F, l, F.blk * NWAVES + F.wave, F.G * NWAVES);
        if (NREP(0) > 1) __syncthreads(); } SEAM(p0 + 0);
        for (int rep_ = 0; rep_ < NREP(1); ++rep_) { A = launder(A0); F = mkframe(lds, wv); if (IN(p0 + 1) && l == 0) phase_ln_in(A, F, l);
        if (NREP(1) > 1) __syncthreads(); } SEAM(p0 + 1);
        for (int rep_ = 0; rep_ < NREP(2); ++rep_) { A = launder(A0); F = mkframe(lds, wv); if (IN(p0 + 2)) { pg8::Gemm g{(const bf16*)(A->ws + WS_H), (const bf16*)(A->ws + ws_win(l)), D}; pg8::StaticOrder S; S.init(T, NINP, F.G, F.blk);
            EpiP E{(bf16*)(A->ws + WS_P), NINP}; pg8::gemm_phase<EpiP, pg8::StaticOrder, true, true>(F.lds + RING_OFF, g, S, E, F.wave); }
        if (NREP(2) > 1) __syncthreads(); } SEAM(p0 + 2);
        for (int rep_ = 0; rep_ < NREP(3); ++rep_) { A = launder(A0); F = mkframe(lds, wv); if (IN(p0 + 3)) { for (int q_ = 0; q_ < REP_S5A; ++q_) s5_pass1_mfma(A, F, l); for (int q_ = 0; q_ < REP_PREP; ++q_) rwkv_prep_part(A, F, l, 0, F.G); }
        if (NREP(3) > 1) __syncthreads(); } SEAM(p0 + 3);
        for (int rep_ = 0; rep_ < NREP(4); ++rep_) { A = launder(A0); F = mkframe(lds, wv); if (IN(p0 + 4)) {
            if (F.blk < 8) s5_carry(A, F, l, 0);
            for (int q_ = 0; q_ < REP_ATT; ++q_) attn_part(A, F, l, 0, F.G, 0, 256);
            __syncthreads();
            { const int item = F.blk * NWAVES + F.wave; for (int q_ = 0; q_ < REP_ST1; ++q_) if (CKEN & 1) if (item < 2048) rwkv_chunk_stage1(A, F, item, (LAS float*)(F.lds + RING_OFF + F.wave * 16384)); } }
        if (NREP(4) > 1) __syncthreads(); } SEAM(p0 + 4);
        for (int rep_ = 0; rep_ < NREP(5); ++rep_) { A = launder(A0); F = mkframe(lds, wv); if (IN(p0 + 5)) {
            if (F.blk < S2WG) { for (int r2_ = 0; r2_ < REP_S2; ++r2_) if (F.wave < 2) rwkv_chunk_stage2(A, F, F.blk >> 1, 2 * (F.blk & 1) + F.wave); }
            else if (CHUNK_Y_TO_Z && F.blk < 72) rwkv_scan(A, F, F.blk - 8);
            else { constexpr int B0 = S2WG; const int nb = F.G - B0;
                if (F.wave < 4) { const int cw = (F.blk - B0) * 4 + F.wave, NCW = nb * 4;
                    for (int q_ = 0; q_ < REP_S5C; ++q_) s5_pass<true>(A, F, l, cw, NCW); for (int q_ = 0; q_ < REP_CONV; ++q_) conv_part(A, F, l, cw, NCW);
                    if (l + 1 < DEPTH) phase_wprep_a(A, F, l + 1, cw, NCW, 2); }
                else { const int mw = (F.blk - B0) * 4 + F.wave - 4, NMW = nb * 4;
                    for (int r4_ = 0; r4_ < REP4B; ++r4_) phase_wprep_b(A, F, l, mw, NMW);
                    if (l + 1 < DEPTH) phase_wprep_a(A, F, l + 1, mw, NMW, 1); } } }
        if (NREP(5) > 1) __syncthreads(); } SEAM(p0 + 5);
        for (int rep_ = 0; rep_ < NREP(6); ++rep_) { A = launder(A0); F = mkframe(lds, wv); if (IN(p0 + 6)) {
            const int item = F.blk * NWAVES + F.wave; if (item < 2048) rwkv_chunk_stage3(A, F, item, l); }
        if (NREP(6) > 1) __syncthreads(); } SEAM(p0 + 6);
        for (int rep_ = 0; rep_ < NREP(7); ++rep_) { A = launder(A0); F = mkframe(lds, wv); if (IN(p0 + 7)) {
            constexpr int GLUWG = 128;
            if (F.blk < GLUWG) { pg8::Gemm g{(const bf16*)(A->ws + WS_YS), (const bf16*)(A->ws + WS_GLU), 512}; pg8::StaticOrder S; S.init(T, 512, GLUWG, F.blk);
                EpiGlu E{(const bf16*)(A->ws + WS_YS), (bf16*)(A->ws + WS_YCAT), A->in[I_GLUB] + l * GW}; pg8::gemm_phase<EpiGlu, pg8::StaticOrder, true, true>(F.lds + RING_OFF, g, S, E, F.wave); } }
        if (NREP(7) > 1) __syncthreads(); } SEAM(p0 + 7);
        for (int rep_ = 0; rep_ < NREP(8); ++rep_) { A = launder(A0); F = mkframe(lds, wv); if (IN(p0 + 8)) { LAS float* g1p = (LAS float*)(F.lds + XTRA_OFF); stage_mod(A, g1p, l, 2, 1.f, F.tid); __syncthreads();
            pg8::Gemm g{(const bf16*)(A->ws + WS_YCAT), (const bf16*)(A->ws + WS_WOUT), D}; pg8::StaticOrder S; S.init(T, D, F.G, F.blk);
            const float* xin = (l == 0) ? A->in[I_X] : (const float*)A->out; EpiZ E{xin, (float*)(A->ws + WS_Z), g1p}; pg8::gemm_phase<EpiZ, pg8::StaticOrder, true, true>(F.lds + RING_OFF, g, S, E, F.wave); }
        if (NREP(8) > 1) __syncthreads(); } SEAM(p0 + 8);
        for (int rep_ = 0; rep_ < NREP(9); ++rep_) { A = launder(A0); F = mkframe(lds, wv); if (IN(p0 + 9)) phase_ln2(A, F, l);
        if (NREP(9) > 1) __syncthreads(); } SEAM(p0 + 9);
        for (int rep_ = 0; rep_ < NREP(10); ++rep_) { A = launder(A0); F = mkframe(lds, wv); if (IN(p0 + 10)) phase_router(A, F, l);
        if (NREP(10) > 1) __syncthreads(); } SEAM(p0 + 10);
        for (int rep_ = 0; rep_ < NREP(11); ++rep_) { A = launder(A0); F = mkframe(lds, wv); if (IN(p0 + 11)) phase_dispatch(A, F);
        if (NREP(11) > 1) __syncthreads(); } SEAM(p0 + 11);
        for (int rep_ = 0; rep_ < NREP(12); ++rep_) { A = launder(A0); F = mkframe(lds, wv); if (IN(p0 + 12)) { const int* te = (const int*)(A->ws + WS_MISC + MI_TILEE); pg8::Gemm g{(const bf16*)(A->ws + WS_XB), (const bf16*)(A->ws + WS_W13), D};
            pg8::GroupedOrder S{te[MAXTILES], 4, F.G, F.blk, te}; EpiMoeA E{(bf16*)(A->ws + WS_HMID)}; pg8::gemm_phase<EpiMoeA, pg8::GroupedOrder, true, true>(F.lds + RING_OFF, g, S, E, F.wave); }
        if (NREP(12) > 1) __syncthreads(); } SEAM(p0 + 12);
        for (int rep_ = 0; rep_ < NREP(13); ++rep_) { A = launder(A0); F = mkframe(lds, wv); if (IN(p0 + 13)) { const int* te = (const int*)(A->ws + WS_MISC + MI_TILEE); pg8::Gemm g{(const bf16*)(A->ws + WS_HMID), (const bf16*)(A->ws + WS_W2), DEXP};
            pg8::GroupedOrder S{te[MAXTILES], 8, F.G, F.blk, te}; EpiMoeB E{(bf16*)(A->ws + WS_YR), (const float*)(A->ws + WS_MISC + MI_ROWW)}; pg8::gemm_phase<EpiMoeB, pg8::GroupedOrder, true, true>(F.lds + RING_OFF, g, S, E, F.wave); }
        if (NREP(13) > 1) __syncthreads(); } SEAM(p0 + 13);
        for (int rep_ = 0; rep_ < NREP(14); ++rep_) { A = launder(A0); F = mkframe(lds, wv); if (IN(p0 + 14)) phase_ln3(A, F, l, A->out);
        if (NREP(14) > 1) __syncthreads(); } SEAM(p0 + 14);
    }
}
__global__ void __launch_bounds__(NT, 2) hybrid_fwd(Args Aval) {
    KArgs A0 = (KArgs)__builtin_amdgcn_kernarg_segment_ptr(); KArgs A = A0;
    extern __shared__ __attribute__((aligned(16))) unsigned char lds[];
    Frame F;
    F.lds = (LAS unsigned char*)lds;
    F.tid = threadIdx.x; F.lane = F.tid & 63; F.wave = __builtin_amdgcn_readfirstlane(F.tid >> 6);
    F.G = gridDim.x; F.blk = blockIdx.x;
    volatile LAS unsigned* MISC = (volatile LAS unsigned*)(F.lds + MISC_OFF);
    for (int u = F.tid; u < 1024 / 4; u += NT) ((LAS unsigned*)(F.lds + LDSCTL_OFF))[u] = 0u;
    __syncthreads();
    XcdBarrier bar = xcd_barrier_post((unsigned*)(A->ws + WS_CTL) + CW_BAR, MISC + 8);
    const int lo = A->ph_lo, hi = A->ph_hi;
    const int wv = F.wave;
    run_layer<0>(A0, (LAS unsigned char*)lds, bar, lo, hi, wv);
    run_layer<1>(A0, (LAS unsigned char*)lds, bar, lo, hi, wv);
}

#ifndef N_LAUNCH_MODE
#define N_LAUNCH_MODE 1
#endif
extern "C" void kernel_launch(void* const* d_in, const int* in_sizes, int n_in, void* d_out, int out_size, void* d_ws, size_t ws_size, hipStream_t stream) {
    static int grid = 0;
    if (grid == 0) {
        if (n_in != 39 || out_size != T * D || ws_size < WS_END) { fprintf(stderr, "kernel_launch: unexpected shapes (n_in %d, out %d, ws %zu)\n", n_in, out_size, ws_size); grid = -1; return; }
        int dev = 0, cus = 0, per_cu = 0;
        if (hipGetDevice(&dev) != hipSuccess || hipDeviceGetAttribute(&cus, hipDeviceAttributeMultiprocessorCount, dev) != hipSuccess) { grid = -1; return; }
        if (hipFuncSetAttribute((const void*)hybrid_fwd, hipFuncAttributeMaxDynamicSharedMemorySize, LDS_BYTES) != hipSuccess) { fprintf(stderr, "kernel_launch: hipFuncSetAttribute failed\n"); grid = -1; return; }
        if (hipOccupancyMaxActiveBlocksPerMultiprocessor(&per_cu, (const void*)hybrid_fwd, NT, LDS_BYTES) != hipSuccess || per_cu < 1) fprintf(stderr, "kernel_launch: occupancy query says %d\n", per_cu);
        (void)hipGetLastError();
        grid = cus;
        if (grid != 256) { fprintf(stderr, "kernel_launch: %d CUs; this kernel is built for 256\n", grid); grid = -1; return; }
    }
    if (grid < 0) return;
    Args a{};
    for (int i = 0; i < 39; ++i) a.in[i] = (const float*)d_in[i];
    a.out = (float*)d_out; a.ws = (unsigned char*)d_ws;
#if N_LAUNCH_MODE == 1
    (void)hipMemsetAsync((char*)d_ws + WS_CTL, 0, CTL_ZERO_BYTES, stream);
    a.ph_lo = 0; a.ph_hi = DEPTH * NPH;
    hipLaunchKernelGGL(hybrid_fwd, dim3(grid), dim3(NT), LDS_BYTES, stream, a);
#else
    for (int ph = 0; ph < DEPTH * NPH; ++ph) {
        if (ph == 1 * NPH + 1) continue;
        (void)hipMemsetAsync((char*)d_ws + WS_CTL, 0, CTL_ZERO_BYTES, stream);
        a.ph_lo = ph; a.ph_hi = ph + 1;
        hipLaunchKernelGGL(hybrid_fwd, dim3(grid), dim3(NT), LDS_BYTES, stream, a);
    }
#endif
}
```

```cpp
#include <hip/hip_runtime.h>
#include <cstdio>
#include <cstdint>
namespace pg8 {
#define PG8_LAS __attribute__((address_space(3)))
typedef unsigned short bf16_t;
typedef short bf16x8 __attribute__((ext_vector_type(8)));
typedef float f32x4 __attribute__((ext_vector_type(4)));
typedef unsigned u32x4 __attribute__((ext_vector_type(4)));
constexpr int BM = 256, BK = 64, HALF = 128, HTB = HALF * BK * 2  , STAGE_BYTES = 8 * HTB, NXCD = 8, WGM = 8;

__host__ __device__ __forceinline__ int lds_byte(int r, int c) { const int st = (r >> 4) * 2 + (c >> 5), rr = r & 15, cc = c & 31, ob = rr * 64 + cc * 2; return st * 1024 + (ob ^ (((ob >> 9) & 1) << 5)); }
__host__ __device__ __forceinline__ void stage_rc(int b, int& R, int& C) { const int st = b / 1024, sb = b % 1024, swz = sb ^ (((sb >> 9) & 1) << 5); R = (st >> 1) * 16 + swz / 64; C = (st & 1) * 32 + (swz % 64) / 2; }
__host__ __device__ __forceinline__ int perm32(int rho) { const int n = rho >> 4, i = rho & 15; return 8 * (i >> 2) + 4 * n + (i & 3); }


struct Unit { int pm, pn, po; };
struct Gemm { const bf16_t* A; const bf16_t* Bt; int K; };

struct StaticOrder {
    int nM, nN, nwg, G, c;
    __device__ void init(int M, int N, int G_, int c_) { nM = M / BM; nN = N / BM; nwg = nM * nN; G = G_; c = c_; }
    __device__ bool next(int i, Unit& u) const {
        const long L = (long)i * G + c; if (L >= nwg) return false;
        int wgid = (int)L; { const int q = nwg / NXCD, r = nwg % NXCD, xcd = wgid % NXCD, off = wgid / NXCD; wgid = (xcd < r ? xcd * (q + 1) : r * (q + 1) + (xcd - r) * q) + off; }
        const int nig = WGM * nN, gid = wgid / nig, fm = gid * WGM, gsz = (nM - fm) < WGM ? (nM - fm) : WGM;
        u.pm = fm + ((wgid % nig) % gsz); u.pn = (wgid % nig) / gsz; u.po = u.pn; return true;
    }
    __device__ __forceinline__ void a_ready(const Unit&) const {}
    __device__ __forceinline__ void done(const Unit&) const {}
};
struct GroupedOrder {
    int ntiles, npn, G, c; const int* tile_e;
    __device__ bool next(int i, Unit& u) const {
        const int idx = c >> 3, pn = idx % npn, rpx = (G >> 3) / npn, t = (i * 8 + (c & 7)) * rpx + idx / npn; if (t >= ntiles) return false;
        u.pm = t; u.po = pn; u.pn = tile_e[t] * npn + pn; return true;
    }
    __device__ __forceinline__ void a_ready(const Unit&) const {}
    __device__ __forceinline__ void done(const Unit&) const {}
};
__device__ __forceinline__ unsigned cvt_pk_bf16(float lo, float hi) { unsigned r; asm volatile("s_nop 0\n\tv_cvt_pk_bf16_f32 %0, %1, %2" : "=v"(r) : "v"(lo), "v"(hi)); return r; }
template <class Epi, class Sched, bool ALIGN_EPI = false, bool SP2 = false>
__device__ __forceinline__ void gemm_phase(PG8_LAS unsigned char* lds, const Gemm g, const Sched& S, const Epi& E, int wv) {
    int tid_ = (wv << 6) | (int)__builtin_amdgcn_mbcnt_hi(~0u, __builtin_amdgcn_mbcnt_lo(~0u, 0u)); asm volatile("" : "+v"(tid_));
    const int tid = tid_, wid = __builtin_amdgcn_readfirstlane(tid >> 6), lane = tid & 63, wr = wid >> 2, wc = wid & 3, fr = lane & 15, fq = lane >> 4;
    const int K = g.K, nt = K / BK;
    unsigned voffA[2], voffB[2];
#pragma unroll
    for (int i = 0; i < 2; ++i) { int R, C; stage_rc(tid * 16 + i * 8192, R, C); const int Rb = Epi::PERM ? ((R & ~31) + perm32(R & 31)) : R;
        voffA[i] = (unsigned)(R * K + C) * 2u; voffB[i] = (unsigned)(Rb * K + C) * 2u; }
    const size_t kstep = (size_t)(BK * 2);
    const size_t hstep = (size_t)HALF * K * 2;
    const size_t tstep = 2 * hstep;
    const unsigned ldsw = (unsigned)wid * 1024u;
    const int aoff = lds_byte(wr * 64 + fr, fq * 8), boff = lds_byte(wc * 32 + fr, fq * 8);
#define PG8_SA(b, h) (((b) * 2 + (h)) * HTB)
#define PG8_SB(b, h) ((4 + (b) * 2 + (h)) * HTB)
#define PG8_STAGE(bufoff, gbase, voff) do { _Pragma("unroll") for (int _i = 0; _i < 2; ++_i) \
        __builtin_amdgcn_global_load_lds((const unsigned*)((const char*)(gbase) + (voff)[_i]), (PG8_LAS unsigned*)(lds + (bufoff) + ldsw + _i * 8192), 16, 0, 0); } while (0)
#define PG8_LDA(dst, b, h) do { _Pragma("unroll") for (int m = 0; m < 4; ++m) _Pragma("unroll") for (int k = 0; k < 2; ++k) dst[m][k] = *(const PG8_LAS bf16x8*)(lds + PG8_SA(b, h) + aoff + m * 2048 + k * 1024); } while (0)
#define PG8_LDB(dst, b, h) do { _Pragma("unroll") for (int n = 0; n < 2; ++n) _Pragma("unroll") for (int k = 0; k < 2; ++k) dst[n][k] = *(const PG8_LAS bf16x8*)(lds + PG8_SB(b, h) + boff + n * 2048 + k * 1024); } while (0)
#define PG8_MMA(ai, bj, At, Bt) do { __builtin_amdgcn_s_setprio(1); _Pragma("unroll") for (int m = 0; m < 4; ++m) _Pragma("unroll") for (int n = 0; n < 2; ++n) _Pragma("unroll") for (int k = 0; k < 2; ++k) \
        acc[ai][bj][m][n] = __builtin_amdgcn_mfma_f32_16x16x32_bf16(Bt[n][k], At[m][k], acc[ai][bj][m][n], 0, 0, 0); __builtin_amdgcn_s_setprio(0); } while (0)
#define PG8_WAIT_V(n) asm volatile("s_waitcnt vmcnt(" #n ")" ::: "memory")
#define PG8_WAIT_L(n) asm volatile("s_waitcnt lgkmcnt(" #n ")" ::: "memory")
#define PG8_BAR __builtin_amdgcn_s_barrier()
#define PG8_SCHED __builtin_amdgcn_sched_barrier(0)
    Unit cur, nxt; int ui = 0;
    if (!S.next(0, cur)) return;
    f32x4 acc[2][2][4][2];
#pragma unroll
    for (int a = 0; a < 2; ++a)
#pragma unroll
        for (int b = 0; b < 2; ++b)
#pragma unroll
            for (int m = 0; m < 4; ++m)
#pragma unroll
                for (int n = 0; n < 2; ++n) acc[a][b][m][n] = (f32x4){0.f, 0.f, 0.f, 0.f};
    bf16x8 At[4][2], B0[2][2], B1[2][2];
    const char* cA = (const char*)g.A + (size_t)cur.pm * tstep; const char* cB = (const char*)g.Bt + (size_t)cur.pn * tstep;
    S.a_ready(cur);
    if constexpr (SP2) {
        PG8_STAGE(PG8_SB(0, 0), cB, voffB); PG8_STAGE(PG8_SB(0, 1), cB + hstep, voffB); PG8_STAGE(PG8_SA(0, 0), cA, voffA); PG8_STAGE(PG8_SA(0, 1), cA + hstep, voffA);
        if (wr == 1) PG8_BAR;
        PG8_WAIT_V(2); PG8_BAR;
        PG8_STAGE(PG8_SB(1, 0), cB + kstep, voffB); PG8_STAGE(PG8_SA(1, 0), cA + kstep, voffA); PG8_STAGE(PG8_SB(1, 1), cB + hstep + kstep, voffB);
        PG8_WAIT_V(6); PG8_BAR;
    } else {
        PG8_STAGE(PG8_SB(0, 0), cB, voffB); PG8_STAGE(PG8_SA(0, 0), cA, voffA); PG8_STAGE(PG8_SB(0, 1), cB + hstep, voffB); PG8_STAGE(PG8_SA(0, 1), cA + hstep, voffA);
        if (wr == 1) PG8_BAR;
        PG8_WAIT_V(4); PG8_BAR;
        PG8_STAGE(PG8_SB(1, 0), cB + kstep, voffB); PG8_STAGE(PG8_SA(1, 0), cA + kstep, voffA); PG8_STAGE(PG8_SB(1, 1), cB + hstep + kstep, voffB);
        PG8_WAIT_V(6); PG8_BAR;
    }
    for (;;) {
        const bool has_next = S.next(ui + 1, nxt);
        const char* nA = has_next ? (const char*)g.A + (size_t)nxt.pm * tstep : cA; const char* nB = has_next ? (const char*)g.Bt + (size_t)nxt.pn * tstep : cB;
        asm volatile(".p2align 8");
        for (int t = 0; t < nt; t += 2) {
            const bool last = (t == nt - 2);
            const char* a1 = cA + (size_t)(t + 1) * kstep;
            const char* a2 = last ? nA : cA + (size_t)(t + 2) * kstep; const char* b2 = last ? nB : cB + (size_t)(t + 2) * kstep;
            const char* a3 = a2 + kstep; const char* b3 = b2 + kstep;
            if (last && has_next) S.a_ready(nxt);
            if constexpr (SP2) {
            PG8_LDB(B0, 0, 0); PG8_LDB(B1, 0, 1); PG8_SCHED; PG8_LDA(At, 0, 0); PG8_STAGE(PG8_SA(1, 1), a1 + hstep, voffA);
            PG8_WAIT_V(8); PG8_WAIT_L(0); PG8_BAR; PG8_MMA(0, 0, At, B0); PG8_MMA(0, 1, At, B1); PG8_BAR; PG8_SCHED;
            PG8_LDA(At, 0, 1); PG8_STAGE(PG8_SB(0, 0), b2, voffB); PG8_STAGE(PG8_SB(0, 1), b2 + hstep, voffB); PG8_STAGE(PG8_SA(0, 0), a2, voffA);
            PG8_WAIT_V(8); PG8_WAIT_L(0); PG8_BAR; PG8_MMA(1, 0, At, B0); PG8_MMA(1, 1, At, B1); PG8_BAR; PG8_SCHED;
            PG8_LDB(B0, 1, 0); PG8_LDB(B1, 1, 1); PG8_SCHED; PG8_LDA(At, 1, 0); PG8_STAGE(PG8_SA(0, 1), a2 + hstep, voffA);
            PG8_WAIT_V(8); PG8_WAIT_L(0); PG8_BAR; PG8_MMA(0, 0, At, B0); PG8_MMA(0, 1, At, B1); PG8_BAR; PG8_SCHED;
            PG8_LDA(At, 1, 1); PG8_STAGE(PG8_SB(1, 0), b3, voffB); PG8_STAGE(PG8_SB(1, 1), b3 + hstep, voffB); PG8_STAGE(PG8_SA(1, 0), a3, voffA);
            PG8_WAIT_V(8); PG8_WAIT_L(0); PG8_BAR; PG8_MMA(1, 0, At, B0); PG8_MMA(1, 1, At, B1); PG8_BAR; PG8_SCHED;
            } else {
            PG8_LDB(B0, 0, 0); PG8_SCHED; PG8_LDA(At, 0, 0); PG8_STAGE(PG8_SA(1, 1), a1 + hstep, voffA);
            PG8_WAIT_L(8); PG8_BAR; PG8_WAIT_L(0); PG8_MMA(0, 0, At, B0); PG8_BAR; PG8_SCHED;
            PG8_LDB(B1, 0, 1); PG8_STAGE(PG8_SB(0, 0), b2, voffB);
            PG8_BAR; PG8_WAIT_L(0); PG8_MMA(0, 1, At, B1); PG8_BAR;
            PG8_LDA(At, 0, 1); PG8_STAGE(PG8_SA(0, 0), a2, voffA);
            PG8_BAR; PG8_WAIT_L(0); PG8_MMA(1, 0, At, B0); PG8_BAR; PG8_SCHED;
            PG8_STAGE(PG8_SB(0, 1), b2 + hstep, voffB);
            PG8_WAIT_V(6); PG8_BAR; PG8_MMA(1, 1, At, B1); PG8_BAR;
            PG8_LDB(B0, 1, 0); PG8_SCHED; PG8_LDA(At, 1, 0); PG8_STAGE(PG8_SA(0, 1), a2 + hstep, voffA);
            PG8_WAIT_L(8); PG8_BAR; PG8_WAIT_L(0); PG8_MMA(0, 0, At, B0); PG8_BAR; PG8_SCHED;
            PG8_LDB(B1, 1, 1); PG8_STAGE(PG8_SB(1, 0), b3, voffB);
            PG8_BAR; PG8_WAIT_L(0); PG8_MMA(0, 1, At, B1); PG8_BAR;
            PG8_LDA(At, 1, 1); PG8_STAGE(PG8_SA(1, 0), a3, voffA);
            PG8_BAR; PG8_WAIT_L(0); PG8_MMA(1, 0, At, B0); PG8_BAR; PG8_SCHED;
            PG8_STAGE(PG8_SB(1, 1), b3 + hstep, voffB);
            PG8_WAIT_V(6); PG8_BAR; PG8_MMA(1, 1, At, B1); PG8_BAR;
            }
        }
        if constexpr (ALIGN_EPI) { if (wr == 0) PG8_BAR; }
        if constexpr (!Epi::AFTER_DRAIN) { E(acc, cur, wr, wc, fr, fq); S.done(cur); }
        if (!has_next) break;
#pragma unroll
        for (int a = 0; a < 2; ++a)
#pragma unroll
            for (int b = 0; b < 2; ++b)
#pragma unroll
                for (int m = 0; m < 4; ++m)
#pragma unroll
                    for (int n = 0; n < 2; ++n) acc[a][b][m][n] = (f32x4){0.f, 0.f, 0.f, 0.f};
        cur = nxt; cA = nA; cB = nB; ++ui;
        if constexpr (ALIGN_EPI) { if (wr == 1) PG8_BAR; }
    }
    PG8_WAIT_V(0);
    if constexpr (!ALIGN_EPI) { if (wr == 0) PG8_BAR; }
    PG8_BAR;
    if constexpr (Epi::AFTER_DRAIN) { E.fused(acc, cur, wr, wc, fr, fq, lds, wid, lane); S.done(cur); }
#undef PG8_SA
#undef PG8_SB
#undef PG8_STAGE
#undef PG8_LDA
#undef PG8_LDB
#undef PG8_MMA
#undef PG8_WAIT_V
#undef PG8_WAIT_L
#undef PG8_BAR
#undef PG8_SCHED
}
}

constexpr int D = 2048, BATCH = 2, SEQ = 8192, T = BATCH * SEQ, DEPTH = 2, GW = 512;
constexpr int RW_OFF = 3 * GW, RW_COLS = 3 * GW + 96 + 96 + 128, ATT_OFF = RW_OFF + RW_COLS, S5_OFF = ATT_OFF + 512 + 256, NIN = S5_OFF + GW, NINP = 4864;
static_assert(NIN == 4672 && ATT_OFF == 3392 && S5_OFF == 4160, "column layout");
constexpr int NEXP = 32, DEXP = 512, MAXTILES = 160, MAXROWS = MAXTILES * 256;
constexpr float ALPHA = 1.41421356237f, LN_EPS = 1e-5f, GN_EPS = 64e-5f;
constexpr int NWAVES = 8, NT = 512;
constexpr int KS_MOD = 8;

constexpr size_t MiB = 1u << 20;
constexpr size_t WS_CTL = 0, CTL_ZERO_BYTES = 1 * MiB;
constexpr size_t WS_MODP = 1 * MiB;
constexpr size_t WS_MODF = 4 * MiB;
constexpr size_t WS_WIN = 5 * MiB;
constexpr size_t WS_WOUT = 24 * MiB;
constexpr size_t WS_GLU = 32 * MiB;
constexpr size_t WS_LORA = WS_GLU + MiB / 2;
constexpr size_t WS_ROUT = 33 * MiB;
constexpr size_t WS_S5C = WS_ROUT + MiB / 2;
constexpr size_t WS_MISC = 34 * MiB;
constexpr size_t WS_W13 = 36 * MiB;
constexpr size_t WS_W2 = 164 * MiB;
constexpr size_t WS_H = 228 * MiB;
constexpr size_t WS_Z = 292 * MiB;
constexpr size_t WS_P = 420 * MiB;
constexpr size_t WS_YCAT = 572 * MiB;
constexpr size_t WS_RW = 636 * MiB;
constexpr size_t WS_RWSC = 892 * MiB;
constexpr size_t WS_YS = 894 * MiB;
constexpr size_t WS_S5E = 910 * MiB;
constexpr size_t WS_S5X = 914 * MiB;
constexpr size_t WS_WIN2 = 918 * MiB;
constexpr size_t WS_LORA2 = 937 * MiB, WS_S5C2 = 938 * MiB;
constexpr size_t WS_CK = 939 * MiB;
constexpr size_t WS_END = 1164 * MiB;
constexpr size_t WS_XB = WS_P;
constexpr size_t WS_YR = WS_P;
constexpr size_t WS_HLO = WS_RW;
constexpr size_t WS_HMID = WS_RW + 64 * MiB;
static_assert(WS_P + (size_t)MAXROWS * 2048 * 2 <= WS_RW, "XB overlay");
constexpr size_t MI_COUNTS = 0;
constexpr size_t MI_TILEE = 64 * 1024;
constexpr size_t MI_ROUTE_E = 128 * 1024;
constexpr size_t MI_ROUTE_W = 256 * 1024;
constexpr size_t MI_DEST = 384 * 1024;
constexpr size_t MI_ROWW = 512 * 1024;
constexpr size_t MI_S5POW = 1280 * 1024;
constexpr size_t MI_S5BBF = MI_S5POW + 320 * 1024;
constexpr size_t MI_STATS = 1024 * 1024;
constexpr size_t S5C_LAM = 0;
constexpr size_t S5C_BB = 32 * 1024;
constexpr size_t S5C_CP = 32 * 1024 + 256 * 1024;
static_assert(S5C_CP + 32 * 16 * 128 * 2 <= MiB / 2, "S5C");
__device__ __forceinline__ constexpr size_t ws_win(int l) { return (l & 1) ? WS_WIN2 : WS_WIN; }
__device__ __forceinline__ constexpr size_t ws_lora(int l) { return (l & 1) ? WS_LORA2 : WS_LORA; }
__device__ __forceinline__ constexpr size_t ws_s5c(int l) { return (l & 1) ? WS_S5C2 : WS_S5C; }
constexpr int CW_BAR = 4096;

constexpr int RING_OFF = 0, RING_BYTES = 131072;
constexpr int XTRA_OFF = RING_BYTES;
constexpr int LDSCTL_OFF = XTRA_OFF + 16384, MISC_OFF = LDSCTL_OFF + 320;
constexpr int LDS_BYTES = LDSCTL_OFF + 1024;
static_assert(LDS_BYTES <= 163840, "LDS");

#define GAS __attribute__((address_space(1)))
#define LAS __attribute__((address_space(3)))
#define DI __device__ __forceinline__
typedef unsigned short bf16;
typedef unsigned v4u __attribute__((ext_vector_type(4)));
typedef unsigned v2u __attribute__((ext_vector_type(2)));
typedef float f32x4 __attribute__((ext_vector_type(4)));
typedef float f32x2 __attribute__((ext_vector_type(2)));
typedef int i32x2 __attribute__((ext_vector_type(2)));
typedef short bf16x8 __attribute__((ext_vector_type(8)));
typedef GAS unsigned gu32;
#define RLX_AGENT __ATOMIC_RELAXED, __HIP_MEMORY_SCOPE_AGENT
#define LDS_WAIT() asm volatile("s_waitcnt lgkmcnt(0)" ::: "memory")
#define VM_WAIT() asm volatile("s_waitcnt vmcnt(0)" ::: "memory")
using pg8::cvt_pk_bf16;
typedef __bf16 bf2_t __attribute__((ext_vector_type(2)));
DI unsigned cvt_pk_safe(float lo, float hi) { const bf2_t r = __builtin_convertvector((f32x2){lo, hi}, bf2_t); return __builtin_bit_cast(unsigned, r); }
DI float bf_lo(unsigned u) { return __builtin_bit_cast(float, u << 16); }
DI float bf_hi(unsigned u) { return __builtin_bit_cast(float, u & 0xffff0000u); }
DI float bf1(bf16 b) { return __builtin_bit_cast(float, (unsigned)b << 16); }
DI float rcpf_(float x) { return __builtin_amdgcn_rcpf(x); }
DI float sigmoidf_(float x) { return rcpf_(1.f + __expf(-x)); }
DI float siluf_(float x) { return x * rcpf_(1.f + __expf(-x)); }
DI float tanhf_(float x) { const float e = __expf(-2.f * fabsf(x)); const float t = (1.f - e) * rcpf_(1.f + e); return x < 0.f ? -t : t; }
DI float gelu_tanh(float x) { const float u = 0.7978845608028654f * (x + 0.044715f * x * x * x); return 0.5f * x * (1.f + tanhf_(u)); }
template <int CTRL> DI float dppf(float x) { return __builtin_bit_cast(float, __builtin_amdgcn_update_dpp(0, __builtin_bit_cast(int, x), CTRL, 0xF, 0xF, true)); }
DI float allsum16(float x) { x += dppf<0xB1>(x); x += dppf<0x4E>(x); x += dppf<0x141>(x); x += dppf<0x140>(x); return x; }
DI float rdlane(float x, int l) { return __builtin_bit_cast(float, __builtin_amdgcn_readlane(__builtin_bit_cast(int, x), l)); }
DI float wave_sum(float v) { v = allsum16(v); return (rdlane(v, 0) + rdlane(v, 16)) + (rdlane(v, 32) + rdlane(v, 48)); }
DI bf16x8 as_frag(v4u v) { return __builtin_bit_cast(bf16x8, v); }
#define MFMA16(a, b, c) __builtin_amdgcn_mfma_f32_16x16x32_bf16((a), (b), (c), 0, 0, 0)

#define XB_TMO      128
#define XB_XCNT(j)  (256  + 64 * (j))
#define XB_XSUB(j)  (1280 + 64 * (j))
#define XB_XGEN(j)  (2304 + 64 * (j))
#define XB_TOP      3328
#define XB_TOPGEN   3392
#define XCD_BAR_WORDS 3456
#define XB_SPIN_CAP (1u << 18)
__device__ __forceinline__ unsigned xb_ld(unsigned* p)              { return __hip_atomic_load(p, __ATOMIC_RELAXED, __HIP_MEMORY_SCOPE_AGENT); }
__device__ __forceinline__ unsigned xb_add(unsigned* p, unsigned v) { return __hip_atomic_fetch_add(p, v, __ATOMIC_RELAXED, __HIP_MEMORY_SCOPE_AGENT); }
__device__ __forceinline__ unsigned xb_xcc_id() { return (unsigned)__builtin_amdgcn_s_getreg((3 << 11) | 20) & 0xFu; }
#define XB_SPIN(cond, bar) do { unsigned _sp = 0; while (cond) { __builtin_amdgcn_s_sleep(1); \
    if ((++_sp & 255u) == 0u) { if (xb_ld(&(bar)[XB_TMO])) break; if (_sp > XB_SPIN_CAP) { atomicAdd(&(bar)[XB_TMO], 1u); break; } } } } while (0)
struct XcdBarrier { unsigned* bar; unsigned x; volatile LAS unsigned* st; int wv; };
__device__ __forceinline__ XcdBarrier xcd_barrier_post(unsigned* bar, volatile LAS unsigned* st) {
    XcdBarrier b; b.bar = bar; b.x = xb_xcc_id(); b.st = st; b.wv = __builtin_amdgcn_readfirstlane((int)threadIdx.x >> 6);
    if (threadIdx.x == 0) (void)xb_add(&bar[XB_XCNT(b.x)], 1u);
    return b;
}
__device__ __forceinline__ void xcd_barrier_complete(unsigned* bar, unsigned x, unsigned& nloc, unsigned& nx) {
    const unsigned G = gridDim.x * gridDim.y * gridDim.z;
    unsigned sum, cnt, mine, sp = 0u;
    for (;;) {
        sum = 0u; cnt = 0u; mine = 0u;
#pragma unroll
        for (unsigned j = 0; j < 16; ++j) { const unsigned c = xb_ld(&bar[XB_XCNT(j)]); sum += c; cnt += (c > 0u) ? 1u : 0u; mine = (j == x) ? c : mine; }
        if (sum == G) break;
        __builtin_amdgcn_s_sleep(1);
        if ((++sp & 255u) == 0u) { if (xb_ld(&bar[XB_TMO])) break; if (sp > XB_SPIN_CAP) { atomicAdd(&bar[XB_TMO], 1u); break; } }
    }
    nloc = mine > 0u ? mine : 1u; nx = cnt > 0u ? cnt : 1u;
}
__device__ __forceinline__ void xcd_barrier(const XcdBarrier& b) {
    asm volatile("s_waitcnt vmcnt(0)" ::: "memory");
    __syncthreads();
    if (b.wv == 0 && __builtin_amdgcn_mbcnt_hi(~0u, __builtin_amdgcn_mbcnt_lo(~0u, 0u)) == 0u) {
        unsigned* bar = b.bar;
        __builtin_amdgcn_s_waitcnt(0);
        unsigned nloc = b.st[0], nx = b.st[1];
        if (nloc == 0u) { xcd_barrier_complete(bar, b.x, nloc, nx); b.st[0] = nloc; b.st[1] = nx; }
        const unsigned old = xb_add(&bar[XB_XSUB(b.x)], 1u);
        const unsigned gen = old / nloc;
        if (old + 1u == (gen + 1u) * nloc) {
            __builtin_amdgcn_fence(__ATOMIC_RELEASE, "agent");
            asm volatile("s_waitcnt vmcnt(0)" ::: "memory");
            const unsigned og = xb_add(&bar[XB_TOP], 1u);
            const unsigned tg = og / nx;
            if (og + 1u == (tg + 1u) * nx) xb_add(&bar[XB_TOPGEN], 1u);
            else XB_SPIN(xb_ld(&bar[XB_TOPGEN]) == tg, bar);
            __builtin_amdgcn_fence(__ATOMIC_ACQUIRE, "agent");
            xb_add(&bar[XB_XGEN(b.x)], 1u);
            asm volatile("s_waitcnt vmcnt(0)" ::: "memory");
        } else {
            XB_SPIN(xb_ld(&bar[XB_XGEN(b.x)]) == gen, bar);
            __builtin_amdgcn_fence(__ATOMIC_ACQUIRE, "agent");
            asm volatile("s_waitcnt vmcnt(0)" ::: "memory");
        }
    }
    __syncthreads();
}

struct Frame {
    LAS unsigned char* lds;
    int tid, lane, wave, G, blk;
};
struct Args { const float* in[39]; float* out; unsigned char* ws; int ph_lo, ph_hi; };
typedef const __attribute__((address_space(4))) Args* KArgs;
DI KArgs launder(KArgs p) { asm volatile("" : "+s"(p)); return p; }
enum { I_X = 0, I_C, I_WADA, I_BADA, I_LNG, I_LNB, I_WIN, I_WOUT, I_CONVW, I_MU, I_W0, I_W2, I_A0, I_A2, I_G2, I_KK, I_KA, I_RK, I_GNG, I_GNB,
       I_SINKS, I_RELB, I_LRE, I_LIM, I_LOGDT, I_BRE, I_BIM, I_CRE, I_CIM, I_S5D, I_GLUW, I_GLUB, I_RGW, I_RGB, I_REW, I_REB, I_MW1, I_MW3, I_MW2 };

DI Frame mkframe(LAS unsigned char* lds, int wv) {
    Frame F; int w_ = wv; asm volatile("" : "+s"(w_)); int t = (w_ << 6) | (int)__builtin_amdgcn_mbcnt_hi(~0u, __builtin_amdgcn_mbcnt_lo(~0u, 0u)); asm volatile("" : "+v"(t)); int g = gridDim.x, b = blockIdx.x; asm volatile("" : "+s"(g), "+s"(b));
    F.lds = lds; F.tid = t; F.lane = t & 63; F.wave = __builtin_amdgcn_readfirstlane(t >> 6); F.G = g; F.blk = b; return F;
}
DI float mod_val(KArgs A, int l, int b, int col) {
    const float* mp = (const float*)(A->ws + WS_MODP) + ((size_t)(l * KS_MOD) * 2 + b) * 12288 + col;
    float s = A->in[I_BADA][l * 12288 + col];
#pragma unroll
    for (int ks = 0; ks < KS_MOD; ++ks) s += mp[(size_t)ks * 2 * 12288];
    return s;
}
template <bool PARTIAL = false>
DI void stage_mod(KArgs A, LAS float* dst, int l, int which, float add, int tid) {
    const float* mf = (const float*)(A->ws + WS_MODF) + (size_t)l * 2 * 12288 + which * 2048;
    for (int i = tid; i < 2 * 2048; i += NT) { const int b = i >> 11, c = i & 2047; dst[i] = add + (PARTIAL ? mod_val(A, l, b, which * 2048 + c) : mf[b * 12288 + c]); }
}
DI void mod_finalize(KArgs A, const Frame& F, int l) {
    float* mf = (float*)(A->ws + WS_MODF) + (size_t)l * 2 * 12288;
    for (int i = F.blk * NT + F.tid; i < 2 * 12288; i += F.G * NT) { const int b = i / 12288, c = i % 12288; mf[i] = mod_val(A, l, b, c); }
}
constexpr int TSCR = 64 * 65 * 4;
DI void transpose_item(const float* W, int K, int N, bf16* WT, int k0, int n0, int drow0, LAS float* scr, int lane) {
    f32x4 r[16]; const int rs = lane >> 4, cj = 4 * (lane & 15);
#pragma unroll
    for (int i = 0; i < 16; ++i) r[i] = *(const GAS f32x4*)(W + (size_t)(k0 + 4 * i + rs) * N + n0 + cj);
#pragma unroll
    for (int i = 0; i < 16; ++i) { LAS float* d = scr + (4 * i + rs) * 65 + cj; d[0] = r[i].x; d[1] = r[i].y; d[2] = r[i].z; d[3] = r[i].w; }
    LDS_WAIT(); asm volatile("" ::: "memory");
    const int c = lane & 7;
#pragma unroll
    for (int j = 0; j < 8; ++j) { const int n = (lane >> 3) + 8 * j; const LAS float* q = scr + (8 * c) * 65 + n;
        v4u o; o.x = cvt_pk_bf16(q[0 * 65], q[1 * 65]); o.y = cvt_pk_bf16(q[2 * 65], q[3 * 65]); o.z = cvt_pk_bf16(q[4 * 65], q[5 * 65]); o.w = cvt_pk_bf16(q[6 * 65], q[7 * 65]);
        *(GAS v4u*)(WT + (size_t)(drow0 + n) * K + k0 + 8 * c) = o; }
    LDS_WAIT(); asm volatile("" ::: "memory");
}
DI void phase_wprep_a(KArgs A, const Frame& F, int l, int wid, int nw, int parts = 3) {
    LAS float* scr = (LAS float*)(F.lds + RING_OFF + F.wave * TSCR);
    const int gw = wid, NGW = nw;
    if (parts & 1) { const float* W = A->in[I_WIN] + (size_t)l * D * NIN; bf16* WT = (bf16*)(A->ws + ws_win(l));
      constexpr int NB = NIN / 64, ITEMS = (D / 64) * NB;
      for (int it = gw; it < ITEMS; it += NGW) { const int kb = it / NB, nb = it % NB; transpose_item(W, D, NIN, WT, 64 * kb, 64 * nb, 64 * nb, scr, F.lane); }
      for (int i = gw * 64 + F.lane; i < (NINP - NIN) * D / 8; i += NGW * 64) *(GAS v4u*)(WT + (size_t)NIN * D + (size_t)i * 8) = (v4u){0u, 0u, 0u, 0u};
    }
    if (!(parts & 2)) return;
    const int gt = wid * 64 + F.lane, NGT = nw * 64;
    { bf16* L0 = (bf16*)(A->ws + ws_lora(l)); bf16* L1 = L0 + 512 * 96; bf16* L2 = L1 + 512 * 96;
      const float* w2 = A->in[I_W2] + (size_t)l * 96 * 512; const float* a2 = A->in[I_A2] + (size_t)l * 96 * 512; const float* g2 = A->in[I_G2] + (size_t)l * 128 * 512;
      for (int i = gt; i < 512 * 96; i += NGT) { const int n = i / 96, k = i % 96; L0[i] = (bf16)(cvt_pk_bf16(w2[k * 512 + n], 0.f) & 0xffffu); L1[i] = (bf16)(cvt_pk_bf16(a2[k * 512 + n], 0.f) & 0xffffu); }
      for (int i = gt; i < 512 * 128; i += NGT) { const int n = i / 128, k = i % 128; L2[i] = (bf16)(cvt_pk_bf16(g2[k * 512 + n], 0.f) & 0xffffu); }
    }
    { unsigned char* sc = A->ws + ws_s5c(l);
      for (int i = gt; i < 32 * 64; i += NGT) { const int g = i >> 6;
          const float lr = A->in[I_LRE][l * 2048 + i], li = A->in[I_LIM][l * 2048 + i], dt = expf(A->in[I_LOGDT][l * 32 + g]);
          const float mag = expf(lr * dt), ar = mag * cosf(li * dt), ai = mag * sinf(li * dt);
          float pr = ar, pi = ai;
#pragma unroll
          for (int s = 0; s < 6; ++s) { const float nr = pr * pr - pi * pi, ni = 2.f * pr * pi; pr = nr; pi = ni; }
          ((f32x4*)(sc + S5C_LAM))[i] = (f32x4){ar, ai, pr, pi};
          const float den = lr * lr + li * li, zr = ((ar - 1.f) * lr + ai * li) / den, zi = (ai * lr - (ar - 1.f) * li) / den;
          float* bb = (float*)(sc + S5C_BB) + (size_t)i * 32;
          const float* brp = A->in[I_BRE] + ((size_t)l * 2048 + i) * 16; const float* bip = A->in[I_BIM] + ((size_t)l * 2048 + i) * 16;
          f32x4 brv[4], biv[4];
#pragma unroll
          for (int q = 0; q < 4; ++q) { brv[q] = *(const GAS f32x4*)(brp + 4 * q); biv[q] = *(const GAS f32x4*)(bip + 4 * q); }
          float bbv[32];
#pragma unroll
          for (int c = 0; c < 16; ++c) { const float br_ = brv[c >> 2][c & 3], bi_ = biv[c >> 2][c & 3]; bbv[c] = zr * br_ - zi * bi_; bbv[16 + c] = zr * bi_ + zi * br_; }
#pragma unroll
          for (int q = 0; q < 8; ++q) *(GAS f32x4*)(bb + 4 * q) = (f32x4){bbv[4 * q], bbv[4 * q + 1], bbv[4 * q + 2], bbv[4 * q + 3]};
          { f32x2* pw = (f32x2*)(A->ws + WS_MISC + MI_S5POW) + (size_t)i * 17; float qr = 1.f, qi = 0.f;
#pragma unroll 1
            for (int e = 0; e <= 16; ++e) { pw[e] = (f32x2){qr, qi}; const float nr = qr * ar - qi * ai, ni = qr * ai + qi * ar; qr = nr; qi = ni; } }
          { v2u* bfp = (v2u*)(A->ws + WS_MISC + MI_S5BBF); const int p = i & 63, nt = p >> 4, frl = p & 15;
#pragma unroll
            for (int ri = 0; ri < 2; ++ri)
#pragma unroll
                for (int q4 = 0; q4 < 4; ++q4) { const float* v = bbv + 16 * ri + 4 * q4;
                    const unsigned h0 = cvt_pk_bf16(v[0], v[1]), h1 = cvt_pk_bf16(v[2], v[3]);
                    const unsigned l0 = cvt_pk_bf16(v[0] - bf_lo(h0), v[1] - bf_hi(h0)), l1 = cvt_pk_bf16(v[2] - bf_lo(h1), v[3] - bf_hi(h1));
                    const size_t ix = ((size_t)((g * 4 + nt) * 2 + ri) * 2) * 64 + q4 * 16 + frl;
                    bfp[ix] = (v2u){h0, h1}; bfp[ix + 64] = (v2u){l0, l1}; } } }
      bf16* cp = (bf16*)(sc + S5C_CP);
      for (int i = gt; i < 32 * 16 * 128; i += NGT) { const int k = i & 127, gc = i >> 7, p = k >> 1;
          const float v = (k & 1) ? -A->in[I_CIM][((size_t)l * 512 + gc) * 64 + p] : A->in[I_CRE][((size_t)l * 512 + gc) * 64 + p];
          cp[i] = (bf16)(cvt_pk_bf16(v, 0.f) & 0xffffu); }
    }
    {
        constexpr int NCG = 12288 / 256, ITEMS = NCG * KS_MOD, ROWS = D / KS_MOD;
        for (int it = gw; it < ITEMS; it += NGW) {
            const int ll = l, r = it, cg = r / KS_MOD, ks = r % KS_MOD, col = cg * 256 + 4 * F.lane;
            const float* wp = A->in[I_WADA] + ((size_t)ll * D + ks * ROWS) * 12288 + col; const float* cv = A->in[I_C] + ks * ROWS;
            f32x4 a0 = {0.f, 0.f, 0.f, 0.f}, a1 = {0.f, 0.f, 0.f, 0.f};
            LAS float* sl = scr;
            static_assert(2 * ROWS * 4 <= TSCR, "silu table");
#pragma unroll
            for (int j = 0; j < 2 * ROWS / 64; ++j) { const int q = F.lane + 64 * j; sl[q] = siluf_(cv[(q / ROWS) * D + (q % ROWS)]); }
            LDS_WAIT(); asm volatile("" ::: "memory");
#pragma unroll 8
            for (int k = 0; k < ROWS; ++k) { const f32x4 w = *(const GAS f32x4*)(wp + (size_t)k * 12288); const float s0 = sl[k], s1 = sl[ROWS + k]; a0 += w * s0; a1 += w * s1; }
            LDS_WAIT(); asm volatile("" ::: "memory");
            float* mp = (float*)(A->ws + WS_MODP) + ((size_t)(ll * KS_MOD + ks) * 2) * 12288 + col;
            *(GAS f32x4*)mp = a0; *(GAS f32x4*)(mp + 12288) = a1;
        }
    }
}
DI void phase_wprep_b(KArgs A, const Frame& F, int l, int gw, int NGW) {
    LAS float* scr = (LAS float*)(F.lds + RING_OFF + F.wave * TSCR);
    constexpr int IT_O = (D / 64) * (D / 64), IT_G = (512 / 64) * (512 / 64), IT_13 = (D / 64) * (DEXP / 64), IT_2 = (DEXP / 64) * (D / 64);
    constexpr int TOTAL = IT_O + IT_G + NEXP * (2 * IT_13 + IT_2);
    for (int it = gw; it < TOTAL; it += NGW) {
        int r = it;
        if (r < IT_O) { const int nbk = D / 64, kb = r / nbk, nb = r % nbk; transpose_item(A->in[I_WOUT] + (size_t)l * D * D, D, D, (bf16*)(A->ws + WS_WOUT), 64 * kb, 64 * nb, 64 * nb, scr, F.lane); continue; } r -= IT_O;
        if (r < IT_G) { const int nbk = 512 / 64, kb = r / nbk, nb = r % nbk; transpose_item(A->in[I_GLUW] + (size_t)l * 512 * 512, 512, 512, (bf16*)(A->ws + WS_GLU), 64 * kb, 64 * nb, 64 * nb, scr, F.lane); continue; } r -= IT_G;
        const int e = r / (2 * IT_13 + IT_2); r %= (2 * IT_13 + IT_2);
        if (r < 2 * IT_13) { const int which = r / IT_13, rr = r % IT_13, nbk = DEXP / 64, kb = rr / nbk, nb = rr % nbk, n0 = 64 * nb;
            const float* W = A->in[which ? I_MW3 : I_MW1] + ((size_t)l * NEXP + e) * D * DEXP;
            const int drow0 = e * 1024 + (n0 >> 7) * 256 + which * 128 + (n0 & 127);
            transpose_item(W, D, DEXP, (bf16*)(A->ws + WS_W13), 64 * kb, n0, drow0, scr, F.lane); continue; }
        r -= 2 * IT_13;
        { const int nbk = D / 64, kb = r / nbk, nb = r % nbk; const float* W = A->in[I_MW2] + ((size_t)l * NEXP + e) * DEXP * D;
          transpose_item(W, DEXP, D, (bf16*)(A->ws + WS_W2), 64 * kb, 64 * nb, e * 2048 + 64 * nb, scr, F.lane); }
    }
    { bf16* hi = (bf16*)(A->ws + WS_ROUT); bf16* lo = hi + 48 * 2048;
      for (int i = gw * 64 + F.lane; i < 48 * 2048; i += NGW * 64) { const int j = i >> 11, k = i & 2047;
          float w = 0.f; if (j < 4) w = A->in[I_RGW][((size_t)l * D + k) * 4 + j]; else if (j < 36) w = A->in[I_REW][((size_t)l * D + k) * 32 + (j - 4)];
          const unsigned h = cvt_pk_bf16(w, 0.f) & 0xffffu; const float wl = w - bf_lo(h);
          hi[i] = (bf16)h; lo[i] = (bf16)(cvt_pk_bf16(wl, 0.f) & 0xffffu); } }
}

DI void row_stats(const f32x4 (&v)[8], float& mean, float& rstd) {
    float s = 0.f;
#pragma unroll
    for (int j = 0; j < 8; ++j) s += (v[j].x + v[j].y) + (v[j].z + v[j].w);
    mean = wave_sum(s) * (1.f / D); float s2 = 0.f;
#pragma unroll
    for (int j = 0; j < 8; ++j) { const f32x4 d = v[j] - mean; s2 += (d.x * d.x + d.y * d.y) + (d.z * d.z + d.w * d.w); }
    rstd = 1.f / sqrtf(wave_sum(s2) * (1.f / D) + LN_EPS);
}
DI void ada_store(const f32x4 (&v)[8], const LAS float* sc1p, const LAS float* sh, bf16* hrow, bf16* lorow, int lane) {
    float mean, rstd; row_stats(v, mean, rstd);
#pragma unroll
    for (int j = 0; j < 8; ++j) { const int c = 4 * (lane + 64 * j);
        const f32x4 a = *(const LAS f32x4*)(sc1p + c), b = *(const LAS f32x4*)(sh + c);
        const f32x4 h = (v[j] - mean) * rstd * a + b;
        v2u o; o.x = cvt_pk_bf16(h.x, h.y); o.y = cvt_pk_bf16(h.z, h.w);
        *(GAS v2u*)(hrow + c) = o;
        if (lorow) { v2u q; q.x = cvt_pk_bf16(h.x - bf_lo(o.x), h.y - bf_hi(o.x)); q.y = cvt_pk_bf16(h.z - bf_lo(o.y), h.w - bf_hi(o.y)); *(GAS v2u*)(lorow + c) = q; } }
}
DI void phase_ln_in(KArgs A, const Frame& F, int l) {
    LAS float* ms = (LAS float*)(F.lds + RING_OFF);
    stage_mod<true>(A, ms + 4096, l, 0, 0.f, F.tid); stage_mod<true>(A, ms, l, 1, 1.f, F.tid);
    mod_finalize(A, F, l);
    __syncthreads();
    const int gw = F.blk * NWAVES + F.wave, NGW = F.G * NWAVES;
    const float* x = A->in[I_X]; bf16* H = (bf16*)(A->ws + WS_H);
    for (int row0 = gw; row0 < T; row0 += 2 * NGW) { f32x4 v[2][8];
#pragma unroll
        for (int r = 0; r < 2; ++r) { const GAS f32x4* xr = (const GAS f32x4*)(x + (size_t)(row0 + r * NGW) * D) + F.lane;
#pragma unroll
            for (int j = 0; j < 8; ++j) v[r][j] = xr[64 * j]; }
#pragma unroll
        for (int r = 0; r < 2; ++r) { const int row = row0 + r * NGW, b = row >> 13; ada_store(v[r], ms + b * 2048, ms + 4096 + b * 2048, H + (size_t)row * D, nullptr, F.lane); } }
    __syncthreads();
}

struct EpiP {
    static constexpr bool PERM = true, AFTER_DRAIN = false;
    bf16* O; int ldc;
    DI void operator()(const f32x4 (&acc)[2][2][4][2], const pg8::Unit& u, int wr, int wc, int fr, int fq) const {
        const int row0 = u.pm * 256 + wr * 64 + fr, col0 = u.po * 256 + wc * 32 + 8 * fq;
#pragma unroll
        for (int ai = 0; ai < 2; ++ai)
#pragma unroll
            for (int m = 0; m < 4; ++m) { bf16* rowp = O + (size_t)(row0 + ai * 128 + m * 16) * ldc + col0;
#pragma unroll
                for (int bj = 0; bj < 2; ++bj) { const f32x4 v0 = acc[ai][bj][m][0], v1 = acc[ai][bj][m][1];
                    v4u w; w.x = cvt_pk_bf16(v0[0], v0[1]); w.y = cvt_pk_bf16(v0[2], v0[3]); w.z = cvt_pk_bf16(v1[0], v1[1]); w.w = cvt_pk_bf16(v1[2], v1[3]);
                    *(GAS v4u*)(rowp + bj * 128) = w; } }
    }
};
struct EpiGlu {
    static constexpr bool PERM = true, AFTER_DRAIN = false;
    const bf16* YS; bf16* O; const float* bias;
    DI void operator()(const f32x4 (&acc)[2][2][4][2], const pg8::Unit& u, int wr, int wc, int fr, int fq) const {
        const int row0 = u.pm * 256 + wr * 64 + fr, col0 = u.po * 256 + wc * 32 + 8 * fq;
        f32x4 bb[2][2];
#pragma unroll
        for (int bj = 0; bj < 2; ++bj) { bb[bj][0] = *(const GAS f32x4*)(bias + col0 + bj * 128); bb[bj][1] = *(const GAS f32x4*)(bias + col0 + bj * 128 + 4); }
#pragma unroll
        for (int ai = 0; ai < 2; ++ai) { v4u yv[4][2];
#pragma unroll
            for (int m = 0; m < 4; ++m)
#pragma unroll
                for (int bj = 0; bj < 2; ++bj) yv[m][bj] = *(const GAS v4u*)(YS + (size_t)(row0 + ai * 128 + m * 16) * 512 + col0 + bj * 128);
            __builtin_amdgcn_sched_barrier(0);
#pragma unroll
            for (int m = 0; m < 4; ++m) { const int row = row0 + ai * 128 + m * 16;
#pragma unroll
                for (int bj = 0; bj < 2; ++bj) { const int col = col0 + bj * 128;
                    const v4u y = yv[m][bj];
                    const f32x4 b0 = bb[bj][0], b1 = bb[bj][1];
                    const f32x4 v0 = acc[ai][bj][m][0] + b0, v1 = acc[ai][bj][m][1] + b1;
                    v4u w;
                    w.x = cvt_pk_bf16(bf_lo(y.x) * sigmoidf_(v0[0]), bf_hi(y.x) * sigmoidf_(v0[1]));
                    w.y = cvt_pk_bf16(bf_lo(y.y) * sigmoidf_(v0[2]), bf_hi(y.y) * sigmoidf_(v0[3]));
                    w.z = cvt_pk_bf16(bf_lo(y.z) * sigmoidf_(v1[0]), bf_hi(y.z) * sigmoidf_(v1[1]));
                    w.w = cvt_pk_bf16(bf_lo(y.w) * sigmoidf_(v1[2]), bf_hi(y.w) * sigmoidf_(v1[3]));
                    *(GAS v4u*)(O + (size_t)row * D + 1536 + col) = w; } }
            __builtin_amdgcn_sched_barrier(0); }
    }
};
struct EpiZ {
    static constexpr bool PERM = false, AFTER_DRAIN = false;
    const float* X; float* Z; const LAS float* g1p;
    DI void operator()(const f32x4 (&acc)[2][2][4][2], const pg8::Unit& u, int wr, int wc, int fr, int fq) const {
        const int row0 = u.pm * 256 + wr * 64 + fr, col0 = u.po * 256 + wc * 32 + 4 * fq; const int b = (u.pm * 256) >> 13;
        f32x4 gv[2][2];
#pragma unroll
        for (int bj = 0; bj < 2; ++bj)
#pragma unroll
            for (int n = 0; n < 2; ++n) gv[bj][n] = *(const LAS f32x4*)(g1p + b * 2048 + col0 + bj * 128 + n * 16);
#pragma unroll
        for (int ai = 0; ai < 2; ++ai) { f32x4 xv[4][2][2];
#pragma unroll
            for (int m = 0; m < 4; ++m) { const size_t ro = (size_t)(row0 + ai * 128 + m * 16) * D + col0;
#pragma unroll
                for (int bj = 0; bj < 2; ++bj)
#pragma unroll
                    for (int n = 0; n < 2; ++n) xv[m][bj][n] = *(const GAS f32x4*)(X + ro + bj * 128 + n * 16); }
            __builtin_amdgcn_sched_barrier(0);
#pragma unroll
            for (int m = 0; m < 4; ++m) { const size_t ro = (size_t)(row0 + ai * 128 + m * 16) * D + col0;
#pragma unroll
                for (int bj = 0; bj < 2; ++bj)
#pragma unroll
                    for (int n = 0; n < 2; ++n) *(GAS f32x4*)(Z + ro + bj * 128 + n * 16) = xv[m][bj][n] * ALPHA + gv[bj][n] * acc[ai][bj][m][n]; }
            __builtin_amdgcn_sched_barrier(0); }
    }
};
struct EpiMoeA {
    static constexpr bool PERM = true, AFTER_DRAIN = false;
    bf16* O;
    DI void operator()(const f32x4 (&acc)[2][2][4][2], const pg8::Unit& u, int wr, int wc, int fr, int fq) const {
        const int row0 = u.pm * 256 + wr * 64 + fr, col0 = u.po * 128 + wc * 32 + 8 * fq;
#pragma unroll
        for (int ai = 0; ai < 2; ++ai)
#pragma unroll
            for (int m = 0; m < 4; ++m) { const f32x4 a0 = acc[ai][0][m][0], a1 = acc[ai][0][m][1], b0 = acc[ai][1][m][0], b1 = acc[ai][1][m][1];
                v4u w; w.x = cvt_pk_bf16(siluf_(a0[0]) * b0[0], siluf_(a0[1]) * b0[1]); w.y = cvt_pk_bf16(siluf_(a0[2]) * b0[2], siluf_(a0[3]) * b0[3]);
                w.z = cvt_pk_bf16(siluf_(a1[0]) * b1[0], siluf_(a1[1]) * b1[1]); w.w = cvt_pk_bf16(siluf_(a1[2]) * b1[2], siluf_(a1[3]) * b1[3]);
                *(GAS v4u*)(O + (size_t)(row0 + ai * 128 + m * 16) * DEXP + col0) = w; }
    }
};
struct EpiMoeB {
    static constexpr bool PERM = true, AFTER_DRAIN = false;
    bf16* O; const float* roww;
    DI void operator()(const f32x4 (&acc)[2][2][4][2], const pg8::Unit& u, int wr, int wc, int fr, int fq) const {
        const int row0 = u.pm * 256 + wr * 64 + fr, col0 = u.po * 256 + wc * 32 + 8 * fq;
        float rws[2][4];
#pragma unroll
        for (int ai = 0; ai < 2; ++ai)
#pragma unroll
            for (int m = 0; m < 4; ++m) rws[ai][m] = roww[row0 + ai * 128 + m * 16];
        __builtin_amdgcn_sched_barrier(0);
#pragma unroll
        for (int ai = 0; ai < 2; ++ai)
#pragma unroll
            for (int m = 0; m < 4; ++m) { const int row = row0 + ai * 128 + m * 16; const float s = rws[ai][m]; bf16* rowp = O + (size_t)row * D + col0;
#pragma unroll
                for (int bj = 0; bj < 2; ++bj) { const f32x4 v0 = acc[ai][bj][m][0] * s, v1 = acc[ai][bj][m][1] * s;
                    v4u w; w.x = cvt_pk_bf16(v0[0], v0[1]); w.y = cvt_pk_bf16(v0[2], v0[3]); w.z = cvt_pk_bf16(v1[0], v1[1]); w.w = cvt_pk_bf16(v1[2], v1[3]);
                    *(GAS v4u*)(rowp + bj * 128) = w; } }
    }
};

DI void conv_part(KArgs A, const Frame& F, int l, int gw, int NGW) {
    const bf16* P = (const bf16*)(A->ws + WS_P); bf16* Y = (bf16*)(A->ws + WS_YCAT); const float* cw = A->in[I_CONVW] + (size_t)l * 3 * GW;
    for (int i = gw * 64 + F.lane; i < T * 64; i += NGW * 64) { const int t = i >> 6, c = (i & 63) * 8, ts = t & (SEQ - 1);
        const bf16* pr = P + (size_t)t * NINP + c;
        const v4u bg = *(const GAS v4u*)pr, c0 = *(const GAS v4u*)(pr + 512), h0 = *(const GAS v4u*)(pr + 1024);
        v4u c1 = {0u, 0u, 0u, 0u}, h1 = c1, c2 = c1, h2 = c1;
        if (ts >= 1) { c1 = *(const GAS v4u*)(pr - NINP + 512); h1 = *(const GAS v4u*)(pr - NINP + 1024); }
        if (ts >= 2) { c2 = *(const GAS v4u*)(pr - 2 * NINP + 512); h2 = *(const GAS v4u*)(pr - 2 * NINP + 1024); }
        const unsigned bgv[4] = {bg.x, bg.y, bg.z, bg.w}, c0v[4] = {c0.x, c0.y, c0.z, c0.w}, h0v[4] = {h0.x, h0.y, h0.z, h0.w}, c1v[4] = {c1.x, c1.y, c1.z, c1.w},
                       h1v[4] = {h1.x, h1.y, h1.z, h1.w}, c2v[4] = {c2.x, c2.y, c2.z, c2.w}, h2v[4] = {h2.x, h2.y, h2.z, h2.w};
        unsigned o[4];
#pragma unroll
        for (int k = 0; k < 4; ++k) {
            const float w0a = cw[c + 2 * k], w1a = cw[GW + c + 2 * k], w2a = cw[2 * GW + c + 2 * k], w0b = cw[c + 2 * k + 1], w1b = cw[GW + c + 2 * k + 1], w2b = cw[2 * GW + c + 2 * k + 1];
            const float ya = bf_lo(bgv[k]) * (w0a * bf_lo(c2v[k]) * bf_lo(h2v[k]) + w1a * bf_lo(c1v[k]) * bf_lo(h1v[k]) + w2a * bf_lo(c0v[k]) * bf_lo(h0v[k]));
            const float yb = bf_hi(bgv[k]) * (w0b * bf_hi(c2v[k]) * bf_hi(h2v[k]) + w1b * bf_hi(c1v[k]) * bf_hi(h1v[k]) + w2b * bf_hi(c0v[k]) * bf_hi(h0v[k]));
            o[k] = cvt_pk_bf16(ya, yb); }
        *(GAS v4u*)(Y + (size_t)t * D + c) = (v4u){o[0], o[1], o[2], o[3]}; }
}

constexpr int AK_PITCH = 144, AV_PITCH = 528;
constexpr int ATT_K_OFF = 0, ATT_V_OFF = 256 * AK_PITCH, ATT_B_OFF = ATT_V_OFF + 64 * AV_PITCH;
DI void attn_part(KArgs A, const Frame& F, int l, int blk0, int nblk, int item0, int item1) {
    const bf16* P = (const bf16*)(A->ws + WS_P); bf16* Y = (bf16*)(A->ws + WS_YCAT);
    LAS unsigned char* Ks = F.lds + RING_OFF + ATT_K_OFF; LAS unsigned char* Vs = F.lds + RING_OFF + ATT_V_OFF; LAS float* Bs = (LAS float*)(F.lds + RING_OFF + ATT_B_OFF);
    const int lane = F.lane, fr = lane & 15, fq = lane >> 4, w = F.wave;
    for (int item = item0 + (F.blk - blk0); item < item1; item += nblk) {
        const int b = item >> 7, g = (item >> 6) & 1, n = item & 63;
        const int tok0 = b * SEQ + 128 * (n - 1);
        float relb_v; { const int r = F.tid >> 7, rel = F.tid & 127;
          int bucket = rel; if (rel >= 16) { bucket = 16 + (int)(logf((float)rel * (1.f / 16.f)) / logf(8.f) * 16.f); bucket = bucket < 31 ? bucket : 31; }
          relb_v = A->in[I_RELB][bucket * 8 + 4 * g + r]; }
        const f32x4 sink4 = *(const GAS f32x4*)(A->in[I_SINKS] + l * 8 + 4 * g);
        for (int id = F.tid; id < 2048; id += NT) { const int key = id & 255, part = id >> 8; const bool ok = (n > 0) || (key >= 128);
            v4u kv = {0u, 0u, 0u, 0u}, vv = {0u, 0u, 0u, 0u};
            if (ok) { const bf16* src = P + (size_t)(tok0 + key) * NINP + ATT_OFF + 512 + 64 * g + 8 * part; kv = *(const GAS v4u*)src; vv = *(const GAS v4u*)(src + 128); }
            *(LAS v4u*)(Ks + key * AK_PITCH + 16 * part) = kv;
            LAS bf16* vd = (LAS bf16*)(Vs + (8 * part) * AV_PITCH) + key;
            vd[0 * (AV_PITCH / 2)] = (bf16)(vv.x & 0xffffu); vd[1 * (AV_PITCH / 2)] = (bf16)(vv.x >> 16); vd[2 * (AV_PITCH / 2)] = (bf16)(vv.y & 0xffffu); vd[3 * (AV_PITCH / 2)] = (bf16)(vv.y >> 16);
            vd[4 * (AV_PITCH / 2)] = (bf16)(vv.z & 0xffffu); vd[5 * (AV_PITCH / 2)] = (bf16)(vv.z >> 16); vd[6 * (AV_PITCH / 2)] = (bf16)(vv.w & 0xffffu); vd[7 * (AV_PITCH / 2)] = (bf16)(vv.w >> 16); }
        Bs[(F.tid >> 7) * 128 + (F.tid & 127)] = relb_v;
        __syncthreads();
        const int qi = 16 * w + fr, qtok = b * SEQ + 128 * n + qi;
        const bf16* qp0 = P + (size_t)qtok * NINP + ATT_OFF + 64 * (4 * g) + 8 * fq;
        v4u qn0 = *(const GAS v4u*)qp0, qn1 = *(const GAS v4u*)(qp0 + 32);
#pragma unroll 1
        for (int r = 0; r < 4; ++r) { const int h = 4 * g + r;
            const bf16x8 q0 = as_frag(qn0), q1 = as_frag(qn1);
            if (r < 3) { qn0 = *(const GAS v4u*)(qp0 + 64 * (r + 1)); qn1 = *(const GAS v4u*)(qp0 + 64 * (r + 1) + 32); }
            const float sink = (r == 0) ? sink4.x : (r == 1) ? sink4.y : (r == 2) ? sink4.z : sink4.w;
            f32x4 s[9]; float mx = sink;
#pragma unroll
            for (int kt = 0; kt < 9; ++kt) { const int nt = w + kt;
                const LAS unsigned char* kp = Ks + (16 * nt + fr) * AK_PITCH + 16 * fq;
                f32x4 acc = {0.f, 0.f, 0.f, 0.f};
                acc = MFMA16(as_frag(*(const LAS v4u*)kp), q0, acc); acc = MFMA16(as_frag(*(const LAS v4u*)(kp + 64)), q1, acc);
#pragma unroll
                for (int i = 0; i < 4; ++i) { const int j = 16 * nt + 4 * fq + i, rel = qi + 128 - j; const bool ok = (rel >= 0) && (rel < 128) && ((n > 0) || (j >= 128));
                    const float sc = ok ? acc[i] * 0.125f + Bs[r * 128 + (rel & 127)] : -1e30f; acc[i] = sc; mx = fmaxf(mx, sc); }
                s[kt] = acc; }
            mx = fmaxf(mx, __shfl_xor(mx, 16)); mx = fmaxf(mx, __shfl_xor(mx, 32));
            float den = 0.f;
#pragma unroll
            for (int kt = 0; kt < 9; ++kt)
#pragma unroll
                for (int i = 0; i < 4; ++i) { const float p = s[kt][i] > -1e29f ? __expf(s[kt][i] - mx) : 0.f; s[kt][i] = p; den += p; }
            den += __shfl_xor(den, 16); den += __shfl_xor(den, 32); den += __expf(sink - mx);
            const float inv = 1.f / den;
            f32x4 o[4];
#pragma unroll
            for (int dt = 0; dt < 4; ++dt) o[dt] = (f32x4){0.f, 0.f, 0.f, 0.f};
#pragma unroll
            for (int sp = 0; sp < 5; ++sp) { const int k0 = 2 * sp, k1 = 2 * sp + 1;
                v4u pf; pf.x = cvt_pk_bf16(s[k0][0], s[k0][1]); pf.y = cvt_pk_bf16(s[k0][2], s[k0][3]);
                if (k1 < 9) { pf.z = cvt_pk_bf16(s[k1 < 9 ? k1 : 8][0], s[k1 < 9 ? k1 : 8][1]); pf.w = cvt_pk_bf16(s[k1 < 9 ? k1 : 8][2], s[k1 < 9 ? k1 : 8][3]); } else { pf.z = 0u; pf.w = 0u; }
                int t0 = w + k0, t1 = w + k1; t1 = t1 < 16 ? t1 : 15;
#pragma unroll
                for (int dt = 0; dt < 4; ++dt) { const LAS unsigned char* vp = Vs + (16 * dt + fr) * AV_PITCH + 8 * fq;
                    const v2u va = *(const LAS v2u*)(vp + 32 * t0), vb = *(const LAS v2u*)(vp + 32 * t1);
                    o[dt] = MFMA16(as_frag((v4u){va.x, va.y, vb.x, vb.y}), as_frag(pf), o[dt]); } }
            bf16* op = Y + (size_t)qtok * D + 1024 + 64 * h + 4 * fq;
#pragma unroll
            for (int dt = 0; dt < 4; ++dt) { v2u ov; ov.x = cvt_pk_bf16(o[dt][0] * inv, o[dt][1] * inv); ov.y = cvt_pk_bf16(o[dt][2] * inv, o[dt][3] * inv); *(GAS v2u*)(op + 16 * dt) = ov; }
        }
        __syncthreads();
    }
}

DI void lerp8(const bf16* cur, const bf16* prv, bool has_prev, const float* mu, float (&o)[8]) {
    const v4u a = *(const GAS v4u*)cur; v4u b = {0u, 0u, 0u, 0u}; if (has_prev) b = *(const GAS v4u*)prv;
    const f32x4 m0 = *(const GAS f32x4*)mu, m1 = *(const GAS f32x4*)(mu + 4);
    const float av[8] = {bf_lo(a.x), bf_hi(a.x), bf_lo(a.y), bf_hi(a.y), bf_lo(a.z), bf_hi(a.z), bf_lo(a.w), bf_hi(a.w)};
    const float bv[8] = {bf_lo(b.x), bf_hi(b.x), bf_lo(b.y), bf_hi(b.y), bf_lo(b.z), bf_hi(b.z), bf_lo(b.w), bf_hi(b.w)};
    const float mv[8] = {m0.x, m0.y, m0.z, m0.w, m1.x, m1.y, m1.z, m1.w};
#pragma unroll
    for (int i = 0; i < 8; ++i) o[i] = av[i] + (bv[i] - av[i]) * mv[i];
}
DI void lerp4(const bf16* cur, const bf16* prv, bool has_prev, const float* mu, float (&o)[4]) {
    const v2u a = *(const GAS v2u*)cur; v2u b = {0u, 0u}; if (has_prev) b = *(const GAS v2u*)prv;
    const f32x4 m0 = *(const GAS f32x4*)mu;
    o[0] = bf_lo(a.x) + (bf_lo(b.x) - bf_lo(a.x)) * m0.x; o[1] = bf_hi(a.x) + (bf_hi(b.x) - bf_hi(a.x)) * m0.y;
    o[2] = bf_lo(a.y) + (bf_lo(b.y) - bf_lo(a.y)) * m0.z; o[3] = bf_hi(a.y) + (bf_hi(b.y) - bf_hi(a.y)) * m0.w;
}
constexpr size_t RWB = (size_t)T * GW;
constexpr int RP_L0 = 0, RP_L1 = 64 * 208, RP_L2 = 2 * 64 * 208, RP_PRM = RP_L2 + 64 * 272, RP_MUL = RP_PRM + 2048, RP_END = RP_MUL + 1280;
DI void rwkv_prep_part(KArgs A, const Frame& F, int l, int blk0, int nblk) {
    const bf16* P = (const bf16*)(A->ws + WS_P); float* RW = (float*)(A->ws + WS_RW); f32x4* SC = (f32x4*)(A->ws + WS_RWSC);
    const bf16* L0 = (const bf16*)(A->ws + ws_lora(l)); const bf16* L1 = L0 + 512 * 96; const bf16* L2 = L1 + 512 * 96;
    const float* mu = A->in[I_MU] + (size_t)l * RW_COLS;
    const int lane = F.lane, fr = lane & 15, fq = lane >> 4, h = (F.blk - blk0) & 7;
    LAS unsigned char* lb = F.lds + RING_OFF;
    for (int i = F.tid; i < 64 * 12; i += NT) { const int r = i / 12, p = i % 12;
        *(LAS v4u*)(lb + RP_L0 + r * 208 + 16 * p) = *(const GAS v4u*)(L0 + (size_t)(64 * h + r) * 96 + 8 * p); *(LAS v4u*)(lb + RP_L1 + r * 208 + 16 * p) = *(const GAS v4u*)(L1 + (size_t)(64 * h + r) * 96 + 8 * p); }
    for (int i = F.tid; i < 64 * 16; i += NT) { const int r = i >> 4, p = i & 15; *(LAS v4u*)(lb + RP_L2 + r * 272 + 16 * p) = *(const GAS v4u*)(L2 + (size_t)(64 * h + r) * 128 + 8 * p); }
    { LAS float* prm = (LAS float*)(lb + RP_PRM);
      if (F.tid < 64) { const int c = 64 * h + F.tid; prm[F.tid] = A->in[I_W0][l * GW + c]; prm[64 + F.tid] = A->in[I_A0][l * GW + c]; prm[128 + F.tid] = A->in[I_KK][l * GW + c]; prm[192 + F.tid] = A->in[I_KA][l * GW + c];
          prm[256 + F.tid] = A->in[I_RK][l * GW + c]; prm[320 + F.tid] = mu[c]; prm[384 + F.tid] = mu[512 + c]; prm[448 + F.tid] = mu[1024 + c]; }
      if (F.tid >= 128 && F.tid < 128 + 320) ((LAS float*)(lb + RP_MUL))[F.tid - 128] = mu[1536 + F.tid - 128]; }
    __syncthreads();
    const LAS float* prm = (const LAS float*)(lb + RP_PRM); const LAS float* mul = (const LAS float*)(lb + RP_MUL);
#pragma unroll 1
    for (int j = 0; j < 4; ++j) {
        const int tg = ((F.blk - blk0) >> 3) + 32 * (F.wave + 8 * j), t = tg * 16 + fr; const bool hp = (t & (SEQ - 1)) != 0;
        const bf16* pc = P + (size_t)t * NINP + RW_OFF; const bf16* pp = pc - NINP;
        v4u la[10], lp[10]; v2u xa[3][4], xb[3][4];
#pragma unroll
        for (int s2 = 0; s2 < 10; ++s2) { const int c = 1536 + 32 * s2 + 8 * fq; la[s2] = *(const GAS v4u*)(pc + c); lp[s2] = (v4u){0u, 0u, 0u, 0u}; if (hp) lp[s2] = *(const GAS v4u*)(pp + c); }
#pragma unroll
        for (int q = 0; q < 3; ++q)
#pragma unroll
            for (int nt = 0; nt < 4; ++nt) { const int c = 512 * q + 64 * h + 16 * nt + 4 * fq; xa[q][nt] = *(const GAS v2u*)(pc + c); xb[q][nt] = (v2u){0u, 0u}; if (hp) xb[q][nt] = *(const GAS v2u*)(pp + c); }
        bf16x8 fx[10];
#pragma unroll
        for (int s2 = 0; s2 < 10; ++s2) { const f32x4 m0 = *(const LAS f32x4*)(mul + 32 * s2 + 8 * fq), m1 = *(const LAS f32x4*)(mul + 32 * s2 + 8 * fq + 4);
            const v4u a = la[s2], b = lp[s2];
            float v[8] = {bf_lo(a.x), bf_hi(a.x), bf_lo(a.y), bf_hi(a.y), bf_lo(a.z), bf_hi(a.z), bf_lo(a.w), bf_hi(a.w)};
            const float bv[8] = {bf_lo(b.x), bf_hi(b.x), bf_lo(b.y), bf_hi(b.y), bf_lo(b.z), bf_hi(b.z), bf_lo(b.w), bf_hi(b.w)};
            const float mv[8] = {m0.x, m0.y, m0.z, m0.w, m1.x, m1.y, m1.z, m1.w};
#pragma unroll
            for (int i = 0; i < 8; ++i) { v[i] = v[i] + (bv[i] - v[i]) * mv[i]; if (s2 < 3) v[i] = tanhf_(v[i]); else if (s2 >= 6) v[i] = sigmoidf_(v[i]); }
            v4u o; o.x = cvt_pk_bf16(v[0], v[1]); o.y = cvt_pk_bf16(v[2], v[3]); o.z = cvt_pk_bf16(v[4], v[5]); o.w = cvt_pk_bf16(v[6], v[7]); fx[s2] = as_frag(o); }
        f32x4 r4[4], k4[4], v4[4];
#pragma unroll
        for (int nt = 0; nt < 4; ++nt) {
#define RP_LERP(dst_, q_) do { const f32x4 m_ = *(const LAS f32x4*)(prm + 320 + 64 * (q_) + 16 * nt + 4 * fq); const v2u a_ = xa[q_][nt], b_ = xb[q_][nt]; \
            dst_ = (f32x4){bf_lo(a_.x) + (bf_lo(b_.x) - bf_lo(a_.x)) * m_.x, bf_hi(a_.x) + (bf_hi(b_.x) - bf_hi(a_.x)) * m_.y, bf_lo(a_.y) + (bf_lo(b_.y) - bf_lo(a_.y)) * m_.z, bf_hi(a_.y) + (bf_hi(b_.y) - bf_hi(a_.y)) * m_.w}; } while (0)
            RP_LERP(r4[nt], 0); RP_LERP(k4[nt], 1); RP_LERP(v4[nt], 2);
#undef RP_LERP
        }
        float ss = 0.f;
#pragma unroll
        for (int nt = 0; nt < 4; ++nt) { const f32x4 kkw = *(const LAS f32x4*)(prm + 128 + 16 * nt + 4 * fq);
#pragma unroll
            for (int i = 0; i < 4; ++i) { const float kq = k4[nt][i] * kkw[i]; ss += kq * kq; } }
        ss += __shfl_xor(ss, 16); ss += __shfl_xor(ss, 32);
        const float inv = rcpf_(fmaxf(sqrtf(ss), 1e-12f));
        float br = 0.f, kr = 0.f, rkr = 0.f;
#pragma unroll
        for (int nt = 0; nt < 4; ++nt) { const int row = 16 * nt + fr;
            f32x4 aw = {0.f, 0.f, 0.f, 0.f}, ac = aw, ag = aw;
#pragma unroll
            for (int s2 = 0; s2 < 3; ++s2) { aw = MFMA16(as_frag(*(const LAS v4u*)(lb + RP_L0 + row * 208 + 64 * s2 + 16 * fq)), fx[s2], aw); ac = MFMA16(as_frag(*(const LAS v4u*)(lb + RP_L1 + row * 208 + 64 * s2 + 16 * fq)), fx[3 + s2], ac); }
#pragma unroll
            for (int s2 = 0; s2 < 4; ++s2) ag = MFMA16(as_frag(*(const LAS v4u*)(lb + RP_L2 + row * 272 + 64 * s2 + 16 * fq)), fx[6 + s2], ag);
            const int cl = 16 * nt + 4 * fq, c = 64 * h + cl;
            const f32x4 w0 = *(const LAS f32x4*)(prm + cl), a0 = *(const LAS f32x4*)(prm + 64 + cl), kkw = *(const LAS f32x4*)(prm + 128 + cl), kaw = *(const LAS f32x4*)(prm + 192 + cl), rkw = *(const LAS f32x4*)(prm + 256 + cl);
            f32x4 o_wr, o_kp, o_de, o_v, o_g, o_al, o_be;
#pragma unroll
            for (int i = 0; i < 4; ++i) {
                const float x = -(w0[i] + aw[i]);
                const float sp = (x > 20.f) ? x : __logf(1.f + __expf(x));
                const float wv = -sp - 0.5f, de = __expf(-__expf(wv));
                const float a = sigmoidf_(a0[i] + ac[i]);
                const float kn = k4[nt][i] * kkw[i] * inv, be = kn * a;
                const float kpv = k4[nt][i] * (1.f + (a - 1.f) * kaw[i]);
                o_al[i] = -kn; o_be[i] = be; o_de[i] = de; o_wr[i] = de * r4[nt][i]; o_kp[i] = kpv; o_v[i] = v4[nt][i]; o_g[i] = ag[i];
                br += be * r4[nt][i]; kr += kpv * r4[nt][i]; rkr += r4[nt][i] * kpv * rkw[i]; }
            const size_t o = (size_t)t * GW + c;
            *(GAS f32x4*)(RW + 1 * RWB + o) = o_de;
#define RW_ST16(k_, v_) *(GAS v2u*)((bf16*)(RW + (k_) * RWB) + o) = (v2u){cvt_pk_safe((v_)[0], (v_)[1]), cvt_pk_safe((v_)[2], (v_)[3])}
            RW_ST16(0, o_al); RW_ST16(2, o_wr); RW_ST16(3, o_kp); RW_ST16(4, o_be); RW_ST16(5, o_v); RW_ST16(6, o_g); }
#undef RW_ST16
        br += __shfl_xor(br, 16); br += __shfl_xor(br, 32); kr += __shfl_xor(kr, 16); kr += __shfl_xor(kr, 32); rkr += __shfl_xor(rkr, 16); rkr += __shfl_xor(rkr, 32);
        if (fq == 0) SC[(size_t)t * 8 + h] = (f32x4){br, kr, rkr, 0.f};
    }
    __syncthreads();
}

template <bool FINAL>
DI void s5_pass(KArgs A, const Frame& F, int l, int gw, int NGW) {
    const bf16* P = (const bf16*)(A->ws + WS_P); const unsigned char* sc = A->ws + ws_s5c(l);
    f32x2* E = (f32x2*)(A->ws + WS_S5E); const f32x2* X0 = (const f32x2*)(A->ws + WS_S5X); bf16* YS = (bf16*)(A->ws + WS_YS);
    const int lane = F.lane, fr = lane & 15, fq = lane >> 4;
    constexpr int XP = 272;
    LAS unsigned char* xs = F.lds + RING_OFF + F.wave * TSCR;
    static_assert(32 * XP <= TSCR, "S5 image");
    for (int item = gw; item < BATCH * 32 * 128; item += NGW) {
        const int b = item >> 12, g = (item >> 7) & 31, ch = item & 127, t0 = b * SEQ + 64 * ch;
        const f32x4 lam = ((const f32x4*)(sc + S5C_LAM))[g * 64 + lane];
        float bre[16], bim[16];
        { const f32x4* bp = (const f32x4*)((const float*)(sc + S5C_BB) + (size_t)(g * 64 + lane) * 32);
#pragma unroll
          for (int q = 0; q < 4; ++q) { const f32x4 a = bp[q], c = bp[4 + q]; bre[4 * q] = a.x; bre[4 * q + 1] = a.y; bre[4 * q + 2] = a.z; bre[4 * q + 3] = a.w; bim[4 * q] = c.x; bim[4 * q + 1] = c.y; bim[4 * q + 2] = c.z; bim[4 * q + 3] = c.w; } }
        const bf16* up = P + (size_t)(t0 + lane) * NINP + S5_OFF + 16 * g;
        const v4u u0 = *(const GAS v4u*)up, u1 = *(const GAS v4u*)(up + 8);
        const unsigned uw[8] = {u0.x, u0.y, u0.z, u0.w, u1.x, u1.y, u1.z, u1.w};
        float xr = 0.f, xi = 0.f;
        if (FINAL) { const f32x2 x0 = X0[(size_t)item * 64 + lane]; xr = x0.x; xi = x0.y; }
        bf16x8 cf[4];
        if (FINAL) {
#pragma unroll
            for (int s = 0; s < 4; ++s) cf[s] = as_frag(*(const GAS v4u*)((const bf16*)(sc + S5C_CP) + (size_t)(g * 16 + fr) * 128 + 32 * s + 8 * fq)); }
#pragma unroll 1
        for (int half = 0; half < 2; ++half) {
#pragma unroll 4
            for (int tt = 0; tt < 32; ++tt) { const int tl = half * 32 + tt;
                float br_ = 0.f, bi_ = 0.f;
#pragma unroll
                for (int k = 0; k < 8; ++k) { const unsigned uu = (unsigned)__builtin_amdgcn_readlane((int)uw[k], tl);
                    const float ua = bf_lo(uu), ub = bf_hi(uu);
                    br_ += bre[2 * k] * ua + bre[2 * k + 1] * ub; bi_ += bim[2 * k] * ua + bim[2 * k + 1] * ub; }
                const float nr = lam.x * xr - lam.y * xi + br_, ni = lam.x * xi + lam.y * xr + bi_; xr = nr; xi = ni;
                if (FINAL) *(LAS unsigned*)(xs + tt * XP + 4 * lane) = cvt_pk_bf16(xr, xi); }
            if (FINAL) {
                LDS_WAIT();
#pragma unroll
                for (int mt = 0; mt < 2; ++mt) { f32x4 acc = {0.f, 0.f, 0.f, 0.f};
#pragma unroll
                    for (int s = 0; s < 4; ++s) acc = MFMA16(cf[s], as_frag(*(const LAS v4u*)(xs + (16 * mt + fr) * XP + 64 * s + 16 * fq)), acc);
                    const int t = t0 + half * 32 + 16 * mt + fr, c = 16 * g + 4 * fq;
                    const v2u uq = *(const GAS v2u*)(P + (size_t)t * NINP + S5_OFF + c); const f32x4 dk = *(const GAS f32x4*)(A->in[I_S5D] + l * GW + c);
                    const float y0 = gelu_tanh(acc[0] + dk.x * bf_lo(uq.x)), y1 = gelu_tanh(acc[1] + dk.y * bf_hi(uq.x)), y2 = gelu_tanh(acc[2] + dk.z * bf_lo(uq.y)), y3 = gelu_tanh(acc[3] + dk.w * bf_hi(uq.y));
                    v2u o; o.x = cvt_pk_bf16(y0, y1); o.y = cvt_pk_bf16(y2, y3); *(GAS v2u*)(YS + (size_t)t * GW + c) = o; }
                LDS_WAIT();
            }
        }
        if (!FINAL) E[(size_t)item * 64 + lane] = (f32x2){xr, xi};
    }
}
typedef short bf16x4 __attribute__((ext_vector_type(4)));
DI void s5_pass1_mfma(KArgs A, const Frame& F, int l) {
    const bf16* P = (const bf16*)(A->ws + WS_P); f32x2* E = (f32x2*)(A->ws + WS_S5E);
    const f32x2* pw = (const f32x2*)(A->ws + WS_MISC + MI_S5POW); const v2u* bfp = (const v2u*)(A->ws + WS_MISC + MI_S5BBF);
    const int lane = F.lane, fr = lane & 15, fq = lane >> 4, gwv = F.blk * NWAVES + F.wave;
    if (gwv >= 2048) return;
    const int b = gwv >> 10, g = (gwv >> 5) & 31, cq = gwv & 31;
    const int t0 = b * SEQ + 256 * cq;
    bf16x4 uf[16];
#pragma unroll
    for (int tl = 0; tl < 16; ++tl) uf[tl] = __builtin_bit_cast(bf16x4, *(const GAS v2u*)(P + (size_t)(t0 + 16 * tl + fr) * NINP + S5_OFF + 16 * g + 4 * fq));
#pragma unroll 1
    for (int nt = 0; nt < 4; ++nt) {
        const f32x2* pp = pw + (size_t)(g * 64 + 16 * nt + fr) * 17;
        f32x2 w[4];
#pragma unroll
        for (int i = 0; i < 4; ++i) w[i] = pp[15 - 4 * fq - i];
        const f32x2 L16 = pp[16];
        bf16x4 bf[2][2];
#pragma unroll
        for (int ri = 0; ri < 2; ++ri)
#pragma unroll
            for (int hl = 0; hl < 2; ++hl) bf[ri][hl] = __builtin_bit_cast(bf16x4, bfp[((size_t)((g * 4 + nt) * 2 + ri) * 2 + hl) * 64 + lane]);
#pragma unroll
        for (int k = 0; k < 4; ++k) { float ar_ = 0.f, ai_ = 0.f;
#pragma unroll
            for (int tl = 0; tl < 4; ++tl) { f32x4 dr = {0.f, 0.f, 0.f, 0.f}, di = dr;
                dr = __builtin_amdgcn_mfma_f32_16x16x16bf16_1k(uf[4 * k + tl], bf[0][0], dr, 0, 0, 0); dr = __builtin_amdgcn_mfma_f32_16x16x16bf16_1k(uf[4 * k + tl], bf[0][1], dr, 0, 0, 0);
                di = __builtin_amdgcn_mfma_f32_16x16x16bf16_1k(uf[4 * k + tl], bf[1][0], di, 0, 0, 0); di = __builtin_amdgcn_mfma_f32_16x16x16bf16_1k(uf[4 * k + tl], bf[1][1], di, 0, 0, 0);
                float sr = ar_ * L16.x - ai_ * L16.y, si = ar_ * L16.y + ai_ * L16.x;
#pragma unroll
                for (int i = 0; i < 4; ++i) { sr += w[i].x * dr[i] - w[i].y * di[i]; si += w[i].x * di[i] + w[i].y * dr[i]; }
                ar_ = sr; ai_ = si; }
            ar_ += __shfl_xor(ar_, 16); ar_ += __shfl_xor(ar_, 32); ai_ += __shfl_xor(ai_, 16); ai_ += __shfl_xor(ai_, 32);
            const size_t item = ((size_t)(b * 32 + g) << 7) + 4 * cq + k;
            if (fq == 0) E[item * 64 + 16 * nt + fr] = (f32x2){ar_, ai_}; } }
}
DI void s5_carry(KArgs A, const Frame& F, int l, int blk0) {
    const int i = (F.blk - blk0) * NT + F.tid; if (i < 0 || i >= BATCH * 32 * 64) return;
    const int bg = i >> 6, p = i & 63, g = bg & 31;
    const f32x4 lam = ((const f32x4*)(A->ws + ws_s5c(l) + S5C_LAM))[g * 64 + p];
    const f32x2* E = (const f32x2*)(A->ws + WS_S5E) + (size_t)bg * 128 * 64 + p; f32x2* X0 = (f32x2*)(A->ws + WS_S5X) + (size_t)bg * 128 * 64 + p;
    float xr = 0.f, xi = 0.f;
#pragma unroll 1
    for (int c0 = 0; c0 < 128; c0 += 32) { f32x2 e[32];
#pragma unroll
        for (int k = 0; k < 32; ++k) e[k] = E[(size_t)(c0 + k) * 64];
#pragma unroll
        for (int k = 0; k < 32; ++k) { X0[(size_t)(c0 + k) * 64] = (f32x2){xr, xi}; const float nr = lam.z * xr - lam.w * xi + e[k].x, ni = lam.z * xi + lam.w * xr + e[k].y; xr = nr; xi = ni; } }
}

constexpr int SCH = 32;
constexpr int SB_VEC = 5 * SCH * 64 * 4, SB_V = SCH * 16 * 4, SB_SC = SCH * 8, SB_BYTES = SB_VEC + SB_V + SB_SC;
DI void rwkv_scan(KArgs A, const Frame& F, int blk_) {
    const int bh = blk_ >> 2, q = blk_ & 3, b = bh >> 3, h = bh & 7;
    const float* RW = (const float*)(A->ws + WS_RW); const f32x4* SC = (const f32x4*)(A->ws + WS_RWSC); float* Yo = (float*)(A->ws + WS_RW) + 7 * RWB;
    const int lane = F.lane, w = F.wave;
    const bool loader = (w >= 4); const int lt = F.tid - 256;
    const int rho = lane >> 4, kq = lane & 15;
    f32x2 sa = {0.f, 0.f}, sb = {0.f, 0.f};
    constexpr int NCH = SEQ / SCH;
#define SCAN_LOAD(c_) do { const size_t tb_ = (size_t)b * SEQ + (size_t)(c_) * SCH; \
        _Pragma("unroll") for (int i = 0; i < 4; ++i) { const int idx = lt + 256 * i, ai = idx >> 8, arr = ai + (ai > 0), rem = idx & 255, row = rem >> 3, c8 = rem & 7; \
            rvh[i] = *(const GAS v4u*)((const bf16*)(RW + (size_t)arr * RWB) + (tb_ + row) * GW + 64 * h + 8 * c8); } \
        _Pragma("unroll") for (int i = 0; i < 2; ++i) { const int idx = lt + 256 * i, row = idx >> 4, c4 = idx & 15; rvd[i] = *(const GAS f32x4*)(RW + 1 * RWB + (tb_ + row) * GW + 64 * h + 4 * c4); } \
        if (lt < 64) { const int row = lt >> 1, c8 = lt & 1; rvv = *(const GAS v4u*)((const bf16*)(RW + 5 * RWB) + (tb_ + row) * GW + 64 * h + 16 * q + 8 * c8); } \
        else if (lt >= 128 && lt < 128 + SCH) { rsc = SC[(tb_ + (lt - 128)) * 8 + h]; } } while (0)
#define SCAN_UNPK(d_, u_) do { *(LAS f32x4*)(d_) = (f32x4){bf_lo((u_).x), bf_hi((u_).x), bf_lo((u_).y), bf_hi((u_).y)}; *(LAS f32x4*)((d_) + 16) = (f32x4){bf_lo((u_).z), bf_hi((u_).z), bf_lo((u_).w), bf_hi((u_).w)}; } while (0)
#define SCAN_STORE(buf_) do { LAS unsigned char* base_ = F.lds + RING_OFF + (buf_) * SB_BYTES; \
        _Pragma("unroll") for (int i = 0; i < 4; ++i) { const int idx = lt + 256 * i, ai = idx >> 8, arr = ai + (ai > 0), rem = idx & 255, row = rem >> 3, c8 = rem & 7; \
            SCAN_UNPK(base_ + ((arr * SCH + row) * 64 + 8 * c8) * 4, rvh[i]); } \
        _Pragma("unroll") for (int i = 0; i < 2; ++i) { const int idx = lt + 256 * i; *(LAS f32x4*)(base_ + (1 * SCH * 64) * 4 + idx * 16) = rvd[i]; } \
        if (lt < 64) { SCAN_UNPK(base_ + SB_VEC + lt * 32, rvv); } \
        else if (lt >= 128 && lt < 128 + SCH) *(LAS f32x2*)(base_ + SB_VEC + SB_V + (lt - 128) * 8) = (f32x2){rsc.x, rsc.y}; } while (0)
#define SCAN_LD(P_, t_) do { const LAS unsigned char* p_ = base + (t_) * 256 + 16 * kq; \
        P_##al = *(const LAS f32x4*)(p_); P_##de = *(const LAS f32x4*)(p_ + 1 * SCH * 256); P_##wr = *(const LAS f32x4*)(p_ + 2 * SCH * 256); \
        P_##kp = *(const LAS f32x4*)(p_ + 3 * SCH * 256); P_##be = *(const LAS f32x4*)(p_ + 4 * SCH * 256); \
        P_##vt = *(const LAS float*)(base + SB_VEC + ((t_) * 16 + 4 * w + rho) * 4); P_##sc = *(const LAS f32x2*)(base + SB_VEC + SB_V + (t_) * 8); } while (0)
#define SCAN_STEP(P_, t_) do { \
        f32x2 pa2 = sa * (f32x2){P_##al.x, P_##al.y} + sb * (f32x2){P_##al.z, P_##al.w}, py2 = sa * (f32x2){P_##wr.x, P_##wr.y} + sb * (f32x2){P_##wr.z, P_##wr.w}; \
        float pa = allsum16(pa2.x + pa2.y), py = allsum16(py2.x + py2.y); \
        sa = sa * (f32x2){P_##de.x, P_##de.y} + (f32x2){P_##kp.x, P_##kp.y} * P_##vt + (f32x2){P_##be.x, P_##be.y} * pa; \
        sb = sb * (f32x2){P_##de.z, P_##de.w} + (f32x2){P_##kp.z, P_##kp.w} * P_##vt + (f32x2){P_##be.z, P_##be.w} * pa; \
        const float y_ = py + pa * P_##sc.x + P_##vt * P_##sc.y; ysel = (kq == ((t_) & 15)) ? y_ : ysel; } while (0)
    if (loader) { v4u rvh[4], rvv = {0u, 0u, 0u, 0u}; f32x4 rvd[2], rsc = {0.f, 0.f, 0.f, 0.f}; SCAN_LOAD(0); SCAN_STORE(0); }
    __syncthreads();
#pragma unroll 1
    for (int c = 0; c < NCH; ++c) {
        if (loader) {
            if (c + 1 < NCH) { v4u rvh[4], rvv = {0u, 0u, 0u, 0u}; f32x4 rvd[2], rsc = {0.f, 0.f, 0.f, 0.f}; SCAN_LOAD(c + 1); SCAN_STORE((c + 1) & 1); }
        } else {
            const LAS unsigned char* base = F.lds + RING_OFF + (c & 1) * SB_BYTES;
            const size_t tb = (size_t)b * SEQ + (size_t)c * SCH;
            float* yp = Yo + (tb + kq) * GW + 64 * h + 16 * q + 4 * w + rho;
            f32x4 A_al, A_de, A_wr, A_kp, A_be, B_al, B_de, B_wr, B_kp, B_be; float A_vt, B_vt; f32x2 A_sc, B_sc; float ysel = 0.f;
            SCAN_LD(A_, 0);
#pragma unroll
            for (int t = 0; t < SCH; t += 2) {
                SCAN_LD(B_, t + 1); __builtin_amdgcn_sched_barrier(0);
                SCAN_STEP(A_, t); __builtin_amdgcn_sched_barrier(0);
                if (t + 2 < SCH) SCAN_LD(A_, t + 2);
                __builtin_amdgcn_sched_barrier(0);
                SCAN_STEP(B_, t + 1); __builtin_amdgcn_sched_barrier(0);
                if ((t & 15) == 14) yp[(size_t)(t - 14) * GW] = ysel;
            }
        }
        __syncthreads();
    }
#undef SCAN_LD
#undef SCAN_STEP
}
#define CKEN 7
constexpr int S2WG = 32;
#define CK_SEL_MASK 0
#define CK_SEL_VAL 0
#ifndef CHUNK_Y_TO_Z
#define CHUNK_Y_TO_Z 0
#endif
constexpr int CK_BT = 0, CK_KT = 8192, CK_RT = 16384, CK_VT = 24576  , CK_WT = 32768  , CK_U0T = 40960  , CK_S0 = 49152  ,
              CK_MTH = 57344, CK_MTL = 65536  , CK_GT = 73728  ,
              CK_BTT = 90112  , CK_KTT = 98304  , CK_WTT = 106496  , CK_PC = 114688  , CK_STRIDE = 114944;
DI unsigned short bfbits(float x) { return (unsigned short)(cvt_pk_safe(x, 0.f) & 0xffffu); }
DI v4u ld16(const unsigned char* p) { return *(const GAS v4u*)p; }
DI v2u ld8(const unsigned char* p) { return *(const GAS v2u*)p; }
DI float ldfc(const float* p) { return *p; }
#define CK_SYNC() do { asm volatile("s_waitcnt vmcnt(0)" ::: "memory"); __builtin_amdgcn_fence(__ATOMIC_ACQUIRE, "agent"); asm volatile("s_waitcnt vmcnt(0)" ::: "memory"); } while (0)

DI void rwkv_chunk_stage1(KArgs A, const Frame& F, int item, LAS float* xs) {
    const int b = item >> 10, h = (item >> 7) & 7, c = item & 127, lane = F.lane, fr = lane & 15, fq = lane >> 4;
    const size_t t0 = (size_t)b * SEQ + 64 * c;
    const float* RW = (const float*)(A->ws + WS_RW);
    unsigned char* ck = A->ws + WS_CK + (size_t)item * CK_STRIDE;
    float* atf = (float*)(A->ws + WS_RW) + (size_t)(item >> 10) * 2 * RWB + RWB / 2 + (size_t)(item & 1023) * 4096;
    const float* dec = RW + 1 * RWB + t0 * GW + 64 * h + lane;
    const bf16* pal = (const bf16*)(RW + 0 * RWB) + t0 * GW + 64 * h + lane; const bf16* pwr = (const bf16*)(RW + 2 * RWB) + t0 * GW + 64 * h + lane;
    const bf16* pkp = (const bf16*)(RW + 3 * RWB) + t0 * GW + 64 * h + lane; const bf16* pbe = (const bf16*)(RW + 4 * RWB) + t0 * GW + 64 * h + lane;
    const bf16* pvv = (const bf16*)(RW + 5 * RWB) + t0 * GW + 64 * h + lane;
    unsigned btp[4], ktp[4];
    float P = 1.f;
    {
        unsigned short* oAT = (unsigned short*)(ck + CK_S0) + lane; unsigned short* oBT = (unsigned short*)(ck + CK_BT) + lane; unsigned short* oKT = (unsigned short*)(ck + CK_KT) + lane; unsigned short* oRT = (unsigned short*)(ck + CK_RT) + lane;
        float pb = 0.f, pk = 0.f;
#pragma unroll
        for (int t = 0; t < 64; ++t) {
            const float d = dec[(size_t)t * GW], al = bf1(pal[(size_t)t * GW]), wr = bf1(pwr[(size_t)t * GW]), kp = bf1(pkp[(size_t)t * GW]), be = bf1(pbe[(size_t)t * GW]);
            const float Pm = P; P *= d; const float Pi = 1.f / P;
            const float at = al * Pm, bt = be * Pi, kt = kp * Pi, rt = wr * Pm;
            atf[t * 64 + lane] = at;
            oAT[t * 64] = bfbits(at); oBT[t * 64] = bfbits(bt); oKT[t * 64] = bfbits(kt); oRT[t * 64] = bfbits(rt);
            if (t & 1) { btp[(t >> 1) & 3] = cvt_pk_safe(pb, bt); ktp[(t >> 1) & 3] = cvt_pk_safe(pk, kt);
                if ((t & 7) == 7) { *(GAS v4u*)(ck + CK_BTT + lane * 128 + 16 * (t >> 3)) = (v4u){btp[0], btp[1], btp[2], btp[3]}; *(GAS v4u*)(ck + CK_KTT + lane * 128 + 16 * (t >> 3)) = (v4u){ktp[0], ktp[1], ktp[2], ktp[3]}; } }
            else { pb = bt; pk = kt; }
            if ((t & 15) == 15) __builtin_amdgcn_sched_barrier(0);
        }
        *(GAS float*)((float*)(ck + CK_PC) + lane) = P;
    }
    __builtin_amdgcn_sched_barrier(0);
    {
#pragma unroll
        for (int q = 0; q < 8; ++q) { unsigned w[4];
#pragma unroll
            for (int e = 0; e < 4; ++e) w[e] = (unsigned)pvv[(size_t)(8 * q + 2 * e) * GW] | ((unsigned)pvv[(size_t)(8 * q + 2 * e + 1) * GW] << 16);
            *(GAS v4u*)(ck + CK_VT + lane * 128 + 16 * q) = (v4u){w[0], w[1], w[2], w[3]}; }
    }
    CK_SYNC();
#pragma unroll 1
    for (int tt = 0; tt < 4; ++tt) {
        const bf16x8 fa0 = as_frag(ld16(ck + CK_S0 + (16 * tt + fr) * 128 + 16 * fq)), fa1 = as_frag(ld16(ck + CK_S0 + (16 * tt + fr) * 128 + 64 + 16 * fq));
        f32x4 aak[4];
#pragma unroll
        for (int tj = 0; tj < 4; ++tj) { aak[tj] = (f32x4){0.f, 0.f, 0.f, 0.f};
            if (tj <= tt) {
                const unsigned char* rb = ck + CK_BT + (16 * tj + fr) * 128 + 16 * fq; const unsigned char* rk = ck + CK_KT + (16 * tj + fr) * 128 + 16 * fq;
                f32x4 dab = {0.f, 0.f, 0.f, 0.f}, dak = dab;
                dab = MFMA16(as_frag(ld16(rb)), fa0, dab); dab = MFMA16(as_frag(ld16(rb + 64)), fa1, dab);
                dak = MFMA16(as_frag(ld16(rk)), fa0, dak); dak = MFMA16(as_frag(ld16(rk + 64)), fa1, dak);
                if (tj == tt) {
#pragma unroll
                    for (int i = 0; i < 4; ++i) { const bool keep = (4 * fq + i) < fr; dab[i] = keep ? dab[i] : 0.f; dak[i] = keep ? dak[i] : 0.f; } }
                *(LAS f32x4*)(xs + (16 * tt + fr) * 64 + 16 * tj + 4 * fq) = dab;
                aak[tj] = dak; } }
        f32x4 ru[4] = {{0.f, 0.f, 0.f, 0.f}, {0.f, 0.f, 0.f, 0.f}, {0.f, 0.f, 0.f, 0.f}, {0.f, 0.f, 0.f, 0.f}};
#pragma unroll
        for (int s = 0; s < 2; ++s) { if (2 * s <= tt) {
            v4u pf; pf.x = cvt_pk_safe(aak[2 * s][0], aak[2 * s][1]); pf.y = cvt_pk_safe(aak[2 * s][2], aak[2 * s][3]); pf.z = cvt_pk_safe(aak[2 * s + 1][0], aak[2 * s + 1][1]); pf.w = cvt_pk_safe(aak[2 * s + 1][2], aak[2 * s + 1][3]);
#pragma unroll
            for (int tv = 0; tv < 4; ++tv) { const unsigned char* rv = ck + CK_VT + (16 * tv + fr) * 128 + 64 * s + 8 * fq; const v2u va = ld8(rv), vb = ld8(rv + 32);
                ru[tv] = MFMA16(as_frag((v4u){va.x, va.y, vb.x, vb.y}), as_frag(pf), ru[tv]); } } }
#pragma unroll
        for (int tv = 0; tv < 4; ++tv) *(GAS f32x4*)(ck + CK_MTH + ((16 * tt + fr) * 64 + 16 * tv + 4 * fq) * 4) = ru[tv];
    }
    CK_SYNC(); LDS_WAIT();
#define CK_SOLVE(x_) do { _Pragma("unroll") for (int t = 1; t < 64; ++t) { float acc_ = x_[t]; \
            _Pragma("unroll") for (int jb = 0; jb < t; jb += 4) { const f32x4 a4 = *(const LAS f32x4*)(xs + t * 64 + jb); \
                acc_ += a4.x * x_[jb]; if (jb + 1 < t) acc_ += a4.y * x_[jb + 1]; if (jb + 2 < t) acc_ += a4.z * x_[jb + 2]; if (jb + 3 < t) acc_ += a4.w * x_[jb + 3]; } \
            x_[t] = acc_; } } while (0)
    {
        float xw[64];
#pragma unroll
        for (int t = 0; t < 64; ++t) xw[t] = ldfc(atf + t * 64 + lane);
        CK_SOLVE(xw);
        unsigned short* oWT = (unsigned short*)(ck + CK_WT) + lane;
#pragma unroll
        for (int t = 0; t < 64; ++t) oWT[t * 64] = bfbits(xw[t]);
#pragma unroll
        for (int q = 0; q < 8; ++q) *(GAS v4u*)(ck + CK_WTT + lane * 128 + 16 * q) = (v4u){cvt_pk_safe(xw[8 * q], xw[8 * q + 1]), cvt_pk_safe(xw[8 * q + 2], xw[8 * q + 3]), cvt_pk_safe(xw[8 * q + 4], xw[8 * q + 5]), cvt_pk_safe(xw[8 * q + 6], xw[8 * q + 7])};
    }
    __builtin_amdgcn_sched_barrier(0);
    {
        float xu[64]; const float* ru = (const float*)(ck + CK_MTH) + lane;
#pragma unroll
        for (int t = 0; t < 64; ++t) xu[t] = ldfc(ru + t * 64);
        CK_SOLVE(xu);
#pragma unroll
        for (int q = 0; q < 8; ++q) *(GAS v4u*)(ck + CK_U0T + lane * 128 + 16 * q) = (v4u){cvt_pk_safe(xu[8 * q], xu[8 * q + 1]), cvt_pk_safe(xu[8 * q + 2], xu[8 * q + 3]), cvt_pk_safe(xu[8 * q + 4], xu[8 * q + 5]), cvt_pk_safe(xu[8 * q + 6], xu[8 * q + 7])};
    }
#undef CK_SOLVE
    CK_SYNC();
    const float* pc = (const float*)(ck + CK_PC);
#pragma unroll 1
    for (int t2 = 0; t2 < 4; ++t2) {
        const bf16x8 fb0 = as_frag(ld16(ck + CK_BTT + (16 * t2 + fr) * 128 + 16 * fq)), fb1 = as_frag(ld16(ck + CK_BTT + (16 * t2 + fr) * 128 + 64 + 16 * fq));
        const float pck = ldfc(pc + 16 * t2 + fr);
        unsigned hw[4][2];
#pragma unroll
        for (int t1 = 0; t1 < 4; ++t1) { const unsigned char* rw = ck + CK_WTT + (16 * t1 + fr) * 128 + 16 * fq;
            f32x4 d = {0.f, 0.f, 0.f, 0.f}; d = MFMA16(as_frag(ld16(rw)), fb0, d); d = MFMA16(as_frag(ld16(rw + 64)), fb1, d);
            float m[4];
#pragma unroll
            for (int i = 0; i < 4; ++i) { m[i] = (d[i] + ((t1 == t2 && 4 * fq + i == fr) ? 1.f : 0.f)) * pck; }
            hw[t1][0] = cvt_pk_safe(m[0], m[1]); hw[t1][1] = cvt_pk_safe(m[2], m[3]); }
#pragma unroll
        for (int sx = 0; sx < 2; ++sx) *(GAS v4u*)(ck + CK_MTH + ((t2 * 2 + sx) * 64 + lane) * 16) = (v4u){hw[2 * sx][0], hw[2 * sx][1], hw[2 * sx + 1][0], hw[2 * sx + 1][1]}; }
#pragma unroll 1
    for (int tv = 0; tv < 4; ++tv) {
        const unsigned char* ru = ck + CK_U0T + (16 * tv + fr) * 128 + 16 * fq; const unsigned char* rv = ck + CK_VT + (16 * tv + fr) * 128 + 16 * fq;
        const bf16x8 fu0 = as_frag(ld16(ru)), fu1 = as_frag(ld16(ru + 64)), fv0 = as_frag(ld16(rv)), fv1 = as_frag(ld16(rv + 64));
#pragma unroll
        for (int t2 = 0; t2 < 4; ++t2) { const unsigned char* rb = ck + CK_BTT + (16 * t2 + fr) * 128 + 16 * fq; const unsigned char* rk = ck + CK_KTT + (16 * t2 + fr) * 128 + 16 * fq;
            f32x4 d = {0.f, 0.f, 0.f, 0.f};
            d = MFMA16(as_frag(ld16(rb)), fu0, d); d = MFMA16(as_frag(ld16(rb + 64)), fu1, d); d = MFMA16(as_frag(ld16(rk)), fv0, d); d = MFMA16(as_frag(ld16(rk + 64)), fv1, d);
            const f32x4 pr = *(const GAS f32x4*)(pc + 16 * t2 + 4 * fq);
            *(GAS f32x4*)(ck + CK_GT + ((tv * 4 + t2) * 64 + lane) * 16) = d * pr; } }
}
DI void rwkv_chunk_stage2(KArgs A, const Frame& F, int bh, int vt) {
    const int lane = F.lane, fr = lane & 15, fq = lane >> 4;
    f32x4 acc[4] = {{0.f, 0.f, 0.f, 0.f}, {0.f, 0.f, 0.f, 0.f}, {0.f, 0.f, 0.f, 0.f}, {0.f, 0.f, 0.f, 0.f}};
    unsigned char* ck0 = A->ws + WS_CK + (size_t)(bh * 128) * CK_STRIDE;
    const unsigned voff = (unsigned)lane * 16u;
#define S2_GLD(d_, sb_, imm_) asm volatile("global_load_dwordx4 %0, %1, %2 offset:" #imm_ : "=&v"(d_) : "v"(voff), "s"(sb_) : "memory")
#define S2_LOAD(P_, c_) do { const unsigned char* ck_ = ck0 + (size_t)(c_) * CK_STRIDE; const unsigned char* sg = ck_ + CK_GT + vt * 4096; const unsigned char* sm0 = ck_ + CK_MTH; const unsigned char* sm1 = ck_ + CK_MTH + 4096; \
        S2_GLD(P_##g[0], sg, 0); S2_GLD(P_##g[1], sg, 1024); S2_GLD(P_##g[2], sg, 2048); S2_GLD(P_##g[3], sg, 3072); \
        S2_GLD(P_##m[0][0], sm0, 0); S2_GLD(P_##m[0][1], sm0, 1024); S2_GLD(P_##m[1][0], sm0, 2048); S2_GLD(P_##m[1][1], sm0, 3072); \
        S2_GLD(P_##m[2][0], sm1, 0); S2_GLD(P_##m[2][1], sm1, 1024); S2_GLD(P_##m[3][0], sm1, 2048); S2_GLD(P_##m[3][1], sm1, 3072); } while (0)
#define S2_WAIT(P_, N_) do { asm volatile("s_waitcnt vmcnt(" #N_ ")" : "+v"(P_##g[0]), "+v"(P_##g[1]), "+v"(P_##g[2]), "+v"(P_##g[3]), "+v"(P_##m[0][0]), "+v"(P_##m[0][1]), "+v"(P_##m[1][0]), "+v"(P_##m[1][1]), \
        "+v"(P_##m[2][0]), "+v"(P_##m[2][1]), "+v"(P_##m[3][0]), "+v"(P_##m[3][1]) :: "memory"); } while (0)
#define S2_STEP(P_, c_) do { unsigned char* ck_ = ck0 + (size_t)(c_) * CK_STRIDE; v4u sh[2]; \
        _Pragma("unroll") for (int s = 0; s < 2; ++s) { \
            const unsigned a0 = cvt_pk_safe(acc[2 * s][0], acc[2 * s][1]), a1 = cvt_pk_safe(acc[2 * s][2], acc[2 * s][3]), b0 = cvt_pk_safe(acc[2 * s + 1][0], acc[2 * s + 1][1]), b1 = cvt_pk_safe(acc[2 * s + 1][2], acc[2 * s + 1][3]); \
            sh[s] = (v4u){a0, a1, b0, b1}; \
            *(GAS v2u*)(ck_ + CK_S0 + (16 * vt + fr) * 128 + (32 * s + 4 * fq) * 2) = (v2u){a0, a1}; \
            *(GAS v2u*)(ck_ + CK_S0 + (16 * vt + fr) * 128 + (32 * s + 16 + 4 * fq) * 2) = (v2u){b0, b1}; } \
        _Pragma("unroll") for (int t2 = 0; t2 < 4; ++t2) { f32x4 d = P_##g[t2]; \
            d = MFMA16(as_frag(P_##m[t2][0]), as_frag(sh[0]), d); d = MFMA16(as_frag(P_##m[t2][1]), as_frag(sh[1]), d); acc[t2] = d; } } while (0)
    f32x4 Ag[4], Bg[4], Cg[4]; v4u Am[4][2], Bm[4][2], Cm[4][2];
    S2_LOAD(A, 0); S2_LOAD(B, 1); S2_LOAD(C, 2);
    S2_WAIT(A, 24); S2_STEP(A, 0); S2_LOAD(A, 3);
    S2_WAIT(B, 28); S2_STEP(B, 1); S2_LOAD(B, 4);
    S2_WAIT(C, 32); S2_STEP(C, 2); S2_LOAD(C, 5);
#pragma unroll 1
    for (int c = 3; c < 126; c += 3) {
        S2_WAIT(A, 32); S2_STEP(A, c); S2_LOAD(A, c + 3);
        S2_WAIT(B, 32); S2_STEP(B, c + 1); if (c + 4 < 128) S2_LOAD(B, c + 4);
        S2_WAIT(C, 32); S2_STEP(C, c + 2); if (c + 5 < 128) S2_LOAD(C, c + 5);
    }
    S2_WAIT(A, 0); S2_STEP(A, 126); S2_WAIT(B, 0); S2_STEP(B, 127);
#undef S2_GLD
#undef S2_LOAD
#undef S2_WAIT
#undef S2_STEP
}
DI void rwkv_chunk_stage3(KArgs A, const Frame& F, int item, int l) {
    const int b = item >> 10, h = (item >> 7) & 7, c = item & 127, lane = F.lane, fr = lane & 15, fq = lane >> 4;
    const size_t t0 = (size_t)b * SEQ + 64 * c;
    const unsigned char* ck = A->ws + WS_CK + (size_t)item * CK_STRIDE;
    const f32x4* SC = (const f32x4*)(A->ws + WS_RWSC); const bf16* Gt = (const bf16*)((const float*)(A->ws + WS_RW) + 6 * RWB) + t0 * GW + 64 * h; bf16* Yc = (bf16*)(A->ws + WS_YCAT) + t0 * D + 512 + 64 * h;
    float gng[4], gnb[4];
#pragma unroll
    for (int tv = 0; tv < 4; ++tv) { gng[tv] = A->in[I_GNG][l * GW + 64 * h + 16 * tv + fr]; gnb[tv] = A->in[I_GNB][l * GW + 64 * h + 16 * tv + fr]; }
    bf16x8 s0f[4][2], uf[4][2];
#pragma unroll
    for (int tv = 0; tv < 4; ++tv) { const unsigned char* rs = ck + CK_S0 + (16 * tv + fr) * 128 + 16 * fq; s0f[tv][0] = as_frag(ld16(rs)); s0f[tv][1] = as_frag(ld16(rs + 64)); }
#pragma unroll
    for (int tv = 0; tv < 4; ++tv) { f32x4 u[4];
#pragma unroll
        for (int tt = 0; tt < 4; ++tt) { const unsigned char* rw = ck + CK_WT + (16 * tt + fr) * 128 + 16 * fq;
            f32x4 d = {0.f, 0.f, 0.f, 0.f}; d = MFMA16(as_frag(ld16(rw)), s0f[tv][0], d); d = MFMA16(as_frag(ld16(rw + 64)), s0f[tv][1], d);
            const v2u u0 = ld8(ck + CK_U0T + (16 * tv + fr) * 128 + (16 * tt + 4 * fq) * 2);
            u[tt] = d + (f32x4){bf_lo(u0.x), bf_hi(u0.x), bf_lo(u0.y), bf_hi(u0.y)}; }
#pragma unroll
        for (int s = 0; s < 2; ++s) uf[tv][s] = as_frag((v4u){cvt_pk_safe(u[2 * s][0], u[2 * s][1]), cvt_pk_safe(u[2 * s][2], u[2 * s][3]), cvt_pk_safe(u[2 * s + 1][0], u[2 * s + 1][1]), cvt_pk_safe(u[2 * s + 1][2], u[2 * s + 1][3])}); }
#pragma unroll 1
    for (int tt = 0; tt < 4; ++tt) {
        const unsigned char* rr = ck + CK_RT + (16 * tt + fr) * 128 + 16 * fq; const bf16x8 fr0 = as_frag(ld16(rr)), fr1 = as_frag(ld16(rr + 64));
        float rk4[4]; unsigned short gq[4][4]; v2u vq[4];
#pragma unroll
        for (int i = 0; i < 4; ++i) rk4[i] = SC[(t0 + 16 * tt + 4 * fq + i) * 8 + h].z;
#pragma unroll
        for (int tv = 0; tv < 4; ++tv) { vq[tv] = ld8(ck + CK_VT + (16 * tv + fr) * 128 + (16 * tt + 4 * fq) * 2);
#pragma unroll
            for (int i = 0; i < 4; ++i) gq[tv][i] = Gt[(size_t)(16 * tt + 4 * fq + i) * GW + 16 * tv + fr]; }
        f32x4 arb[4], ark[4];
#pragma unroll
        for (int tj = 0; tj < 4; ++tj) { arb[tj] = (f32x4){0.f, 0.f, 0.f, 0.f}; ark[tj] = arb[tj];
            if (tj <= tt) { const unsigned char* rb = ck + CK_BT + (16 * tj + fr) * 128 + 16 * fq; const unsigned char* rk = ck + CK_KT + (16 * tj + fr) * 128 + 16 * fq;
                f32x4 db = {0.f, 0.f, 0.f, 0.f}, dk = db;
                db = MFMA16(as_frag(ld16(rb)), fr0, db); db = MFMA16(as_frag(ld16(rb + 64)), fr1, db); dk = MFMA16(as_frag(ld16(rk)), fr0, dk); dk = MFMA16(as_frag(ld16(rk + 64)), fr1, dk);
                if (tj == tt) {
#pragma unroll
                    for (int i = 0; i < 4; ++i) { const bool keep = (4 * fq + i) <= fr; db[i] = keep ? db[i] : 0.f; dk[i] = keep ? dk[i] : 0.f; } }
                arb[tj] = db; ark[tj] = dk; } }
        f32x4 y[4] = {{0.f, 0.f, 0.f, 0.f}, {0.f, 0.f, 0.f, 0.f}, {0.f, 0.f, 0.f, 0.f}, {0.f, 0.f, 0.f, 0.f}};
#pragma unroll
        for (int s = 0; s < 2; ++s) { if (2 * s <= tt) {
            const bf16x8 fb = as_frag((v4u){cvt_pk_safe(arb[2 * s][0], arb[2 * s][1]), cvt_pk_safe(arb[2 * s][2], arb[2 * s][3]), cvt_pk_safe(arb[2 * s + 1][0], arb[2 * s + 1][1]), cvt_pk_safe(arb[2 * s + 1][2], arb[2 * s + 1][3])});
            const bf16x8 fk = as_frag((v4u){cvt_pk_safe(ark[2 * s][0], ark[2 * s][1]), cvt_pk_safe(ark[2 * s][2], ark[2 * s][3]), cvt_pk_safe(ark[2 * s + 1][0], ark[2 * s + 1][1]), cvt_pk_safe(ark[2 * s + 1][2], ark[2 * s + 1][3])});
#pragma unroll
            for (int tv = 0; tv < 4; ++tv) { const unsigned char* rv = ck + CK_VT + (16 * tv + fr) * 128 + 64 * s + 8 * fq; const v2u va = ld8(rv), vb = ld8(rv + 32);
                y[tv] = MFMA16(fb, uf[tv][s], y[tv]); y[tv] = MFMA16(fk, as_frag((v4u){va.x, va.y, vb.x, vb.y}), y[tv]); } } }
#pragma unroll
        for (int tv = 0; tv < 4; ++tv) { y[tv] = MFMA16(fr0, s0f[tv][0], y[tv]); y[tv] = MFMA16(fr1, s0f[tv][1], y[tv]); }
#pragma unroll
        for (int i = 0; i < 4; ++i) {
            const float mean = allsum16((y[0][i] + y[1][i]) + (y[2][i] + y[3][i])) * (1.f / 64.f);
            const float d0 = y[0][i] - mean, d1 = y[1][i] - mean, d2 = y[2][i] - mean, d3 = y[3][i] - mean;
            const float rstd = 1.f / sqrtf(allsum16((d0 * d0 + d1 * d1) + (d2 * d2 + d3 * d3)) * (1.f / 64.f) + GN_EPS);
            const float dd[4] = {d0, d1, d2, d3};
#pragma unroll
            for (int tv = 0; tv < 4; ++tv) { const float vv = (i == 0) ? bf_lo(vq[tv].x) : (i == 1) ? bf_hi(vq[tv].x) : (i == 2) ? bf_lo(vq[tv].y) : bf_hi(vq[tv].y);
                const float r = (dd[tv] * rstd * gng[tv] + gnb[tv] + vv * rk4[i]) * bf1(gq[tv][i]);
                Yc[(size_t)(16 * tt + 4 * fq + i) * D + 16 * tv + fr] = bfbits(r); } }
    }
}

DI void rwkv_post_part(KArgs A, const Frame& F, int l, int blk0, int nblk) {
    const float* RW = (const float*)(A->ws + WS_RW); const f32x4* SC = (const f32x4*)(A->ws + WS_RWSC); bf16* Y = (bf16*)(A->ws + WS_YCAT);
    const int gw = (F.blk - blk0) * NWAVES + F.wave, NGW = nblk * NWAVES, c = 8 * F.lane, h = F.lane >> 3;
    const f32x4 g0 = *(const GAS f32x4*)(A->in[I_GNG] + l * GW + c), g1 = *(const GAS f32x4*)(A->in[I_GNG] + l * GW + c + 4), b0 = *(const GAS f32x4*)(A->in[I_GNB] + l * GW + c), b1 = *(const GAS f32x4*)(A->in[I_GNB] + l * GW + c + 4);
    for (int t = gw; t < T; t += NGW) { const size_t o = (size_t)t * GW + c;
        const float* ysrc = (CK_SEL_MASK && ((((t & (SEQ - 1)) >> 6) & CK_SEL_MASK) == CK_SEL_VAL)) ? (const float*)(A->ws + WS_Z) : RW + 7 * RWB;
        const f32x4 y0 = *(const GAS f32x4*)(ysrc + o), y1 = *(const GAS f32x4*)(ysrc + o + 4);
        const v4u vv8 = *(const GAS v4u*)((const bf16*)(RW + 5 * RWB) + o), gg8 = *(const GAS v4u*)((const bf16*)(RW + 6 * RWB) + o);
        const f32x4 v0 = {bf_lo(vv8.x), bf_hi(vv8.x), bf_lo(vv8.y), bf_hi(vv8.y)}, v1 = {bf_lo(vv8.z), bf_hi(vv8.z), bf_lo(vv8.w), bf_hi(vv8.w)},
                    q0 = {bf_lo(gg8.x), bf_hi(gg8.x), bf_lo(gg8.y), bf_hi(gg8.y)}, q1 = {bf_lo(gg8.z), bf_hi(gg8.z), bf_lo(gg8.w), bf_hi(gg8.w)};
        const float rkr = SC[(size_t)t * 8 + h].z;
        float s = (y0.x + y0.y) + (y0.z + y0.w) + (y1.x + y1.y) + (y1.z + y1.w);
        s += __shfl_xor(s, 1); s += __shfl_xor(s, 2); s += __shfl_xor(s, 4);
        const float mean = s * (1.f / 64.f); const f32x4 d0 = y0 - mean, d1 = y1 - mean;
        float s2 = (d0.x * d0.x + d0.y * d0.y) + (d0.z * d0.z + d0.w * d0.w) + (d1.x * d1.x + d1.y * d1.y) + (d1.z * d1.z + d1.w * d1.w);
        s2 += __shfl_xor(s2, 1); s2 += __shfl_xor(s2, 2); s2 += __shfl_xor(s2, 4);
        const float rstd = 1.f / sqrtf(s2 * (1.f / 64.f) + GN_EPS);
        const f32x4 r0 = (d0 * rstd * g0 + b0 + v0 * rkr) * q0, r1 = (d1 * rstd * g1 + b1 + v1 * rkr) * q1;
        v4u ov; ov.x = cvt_pk_bf16(r0.x, r0.y); ov.y = cvt_pk_bf16(r0.z, r0.w); ov.z = cvt_pk_bf16(r1.x, r1.y); ov.w = cvt_pk_bf16(r1.z, r1.w);
        *(GAS v4u*)(Y + (size_t)t * D + 512 + c) = ov; }
}

DI void phase_ln2(KArgs A, const Frame& F, int l) {
    if (l + 1 < DEPTH) mod_finalize(A, F, l + 1);
    LAS float* ms = (LAS float*)(F.lds + RING_OFF);
    stage_mod(A, ms + 4096, l, 3, 0.f, F.tid); stage_mod(A, ms, l, 4, 1.f, F.tid);
    for (int i = F.tid; i < D; i += NT) { ms[8192 + i] = A->in[I_LNG][(size_t)(l * 2 + 0) * D + i]; ms[8192 + D + i] = A->in[I_LNB][(size_t)(l * 2 + 0) * D + i]; }
    __syncthreads();
    const int gw = F.blk * NWAVES + F.wave, NGW = F.G * NWAVES;
    float* Z = (float*)(A->ws + WS_Z); bf16* H = (bf16*)(A->ws + WS_H);
    for (int row0 = gw; row0 < T; row0 += 2 * NGW) { f32x4 v[2][8];
#pragma unroll
        for (int r = 0; r < 2; ++r) { const GAS f32x4* zr = (const GAS f32x4*)(Z + (size_t)(row0 + r * NGW) * D) + F.lane;
#pragma unroll
            for (int j = 0; j < 8; ++j) v[r][j] = zr[64 * j]; }
#pragma unroll
        for (int r = 0; r < 2; ++r) { const int row = row0 + r * NGW, b = row >> 13;
            float mean, rstd; row_stats(v[r], mean, rstd);
            if (F.lane == 0) ((f32x2*)(A->ws + WS_MISC + MI_STATS))[row] = (f32x2){mean, rstd};
#pragma unroll
            for (int j = 0; j < 8; ++j) { const int c = 4 * (F.lane + 64 * j); v[r][j] = (v[r][j] - mean) * rstd * *(const LAS f32x4*)(ms + 8192 + c) + *(const LAS f32x4*)(ms + 8192 + D + c); }
            ada_store(v[r], ms + b * 2048, ms + 4096 + b * 2048, H + (size_t)row * D, nullptr, F.lane); } }
    __syncthreads();
}
DI void phase_router(KArgs A, const Frame& F, int l) {
    LAS int* cnt = (LAS int*)(F.lds + RING_OFF);
    LAS float* lg = (LAS float*)(F.lds + RING_OFF + 1024);
    constexpr int KC = 256, WP = KC * 2 + 16, WBUF = 96 * WP;
    LAS unsigned char* wb = F.lds + RING_OFF + 16384;
    static_assert(16384 + 2 * WBUF <= RING_BYTES, "router LDS");
    if (F.tid < 32) cnt[F.tid] = 0;
    const bf16* H = (const bf16*)(A->ws + WS_H);
    const bf16* W = (const bf16*)(A->ws + WS_ROUT);
    const int lane = F.lane, fr = lane & 15, fq = lane >> 4;
    const int t0 = (F.blk * 4 + (F.wave & 3)) * 16;
    const bf16* hp = H + (size_t)(t0 + fr) * D + 8 * fq;
    f32x4 acc[3] = {{0.f, 0.f, 0.f, 0.f}, {0.f, 0.f, 0.f, 0.f}, {0.f, 0.f, 0.f, 0.f}};
    v4u r[6], rn[6]; v4u xh[8], xn[8];
#pragma unroll
    for (int s2 = 0; s2 < 8; ++s2) { xh[s2] = (v4u){0u, 0u, 0u, 0u}; xn[s2] = xh[s2]; }
#define RT_LDW(dst_, kc_) do { _Pragma("unroll") for (int j = 0; j < 6; ++j) { const int p = F.tid + 512 * j; dst_[j] = *(const GAS v4u*)(W + (size_t)(p >> 5) * D + (kc_) * KC + 8 * (p & 31)); } } while (0)
#define RT_STW(buf_, src_) do { _Pragma("unroll") for (int j = 0; j < 6; ++j) { const int p = F.tid + 512 * j; *(LAS v4u*)(wb + (buf_) * WBUF + (p >> 5) * WP + 16 * (p & 31)) = src_[j]; } } while (0)
#define RT_LDH(dst_, kc_) do { _Pragma("unroll") for (int s2 = 0; s2 < 8; ++s2) dst_[s2] = *(const GAS v4u*)(hp + (kc_) * KC + 32 * s2); } while (0)
    RT_LDW(r, 0); if (F.wave < 4) RT_LDH(xh, 0);
    RT_STW(0, r);
    __syncthreads();
#pragma unroll 1
    for (int kc = 0; kc < D / KC; ++kc) {
        const bool more = (kc + 1 < D / KC);
        if (more) { RT_LDW(rn, kc + 1); if (F.wave < 4) RT_LDH(xn, kc + 1); }
        if (F.wave < 4) { const LAS unsigned char* bw = wb + (kc & 1) * WBUF;
#pragma unroll
            for (int s2 = 0; s2 < 8; ++s2)
#pragma unroll
                for (int nt = 0; nt < 3; ++nt) { const LAS unsigned char* q = bw + (16 * nt + fr) * WP + 64 * s2 + 16 * fq;
                    acc[nt] = MFMA16(as_frag(*(const LAS v4u*)q), as_frag(xh[s2]), acc[nt]); acc[nt] = MFMA16(as_frag(*(const LAS v4u*)(q + 48 * WP)), as_frag(xh[s2]), acc[nt]); } }
        if (more) RT_STW((kc + 1) & 1, rn);
        __syncthreads();
#pragma unroll
        for (int s2 = 0; s2 < 8; ++s2) xh[s2] = xn[s2];
    }
#undef RT_LDW
#undef RT_STW
#undef RT_LDH
    if (F.wave < 4) {
        LAS float* my = lg + F.wave * (16 * 48);
#pragma unroll
        for (int nt = 0; nt < 3; ++nt)
#pragma unroll
            for (int i = 0; i < 4; ++i) my[fr * 48 + 16 * nt + 4 * fq + i] = acc[nt][i];
        LDS_WAIT();
        if (lane < 16) { const int t = t0 + lane; const LAS float* q = my + lane * 48;
            float gl[4]; int gi = 0; float gm = -3.4e38f;
#pragma unroll
            for (int j = 0; j < 4; ++j) { gl[j] = q[j] + A->in[I_RGB][l * 4 + j]; if (gl[j] > gm) { gm = gl[j]; gi = j; } }
            float gs = 0.f;
#pragma unroll
            for (int j = 0; j < 4; ++j) gs += __expf(gl[j] - gm);
            const float gval = 1.f / gs;
            float e1 = -3.4e38f, e2 = -3.4e38f; int i1 = 0, i2 = 0;
            const f32x4 eb0 = *(const GAS f32x4*)(A->in[I_REB] + l * 32 + 8 * gi), eb1 = *(const GAS f32x4*)(A->in[I_REB] + l * 32 + 8 * gi + 4);
            const float ebv[8] = {eb0.x, eb0.y, eb0.z, eb0.w, eb1.x, eb1.y, eb1.z, eb1.w};
#pragma unroll
            for (int j = 0; j < 8; ++j) { const float v = q[4 + 8 * gi + j] + ebv[j];
                if (v > e1) { e2 = e1; i2 = i1; e1 = v; i1 = j; } else if (v > e2) { e2 = v; i2 = j; } }
            const float w2 = gval / (1.f + __expf(e1 - e2)), w1 = gval - w2;
            const int id1 = 8 * gi + i1, id2 = 8 * gi + i2;
            ((i32x2*)(A->ws + WS_MISC + MI_ROUTE_E))[t] = (i32x2){id1, id2};
            ((f32x2*)(A->ws + WS_MISC + MI_ROUTE_W))[t] = (f32x2){w1, w2};
            __hip_atomic_fetch_add(&cnt[id1], 1, __ATOMIC_RELAXED, __HIP_MEMORY_SCOPE_WORKGROUP); __hip_atomic_fetch_add(&cnt[id2], 1, __ATOMIC_RELAXED, __HIP_MEMORY_SCOPE_WORKGROUP); }
        LDS_WAIT();
    }
    __syncthreads();
    if (F.tid < 32) ((int*)(A->ws + WS_MISC + MI_COUNTS))[F.blk * 32 + F.tid] = cnt[F.tid];
    __syncthreads();
}
DI void phase_dispatch(KArgs A, const Frame& F) {
    LAS int* tot = (LAS int*)(F.lds + RING_OFF);
    LAS int* pre = tot + 32; LAS int* pst = tot + 64; LAS int* part = tot + 96; LAS int* ids = part + 16 * 64; LAS int* dst = ids + 128;
    const int* counts = (const int*)(A->ws + WS_MISC + MI_COUNTS);
    { const int e = F.tid & 31, pt = F.tid >> 5; int s = 0, sp = 0;
      int cv_[16];
#pragma unroll
      for (int k = 0; k < 16; ++k) cv_[k] = counts[(pt * 16 + k) * 32 + e];
#pragma unroll
      for (int k = 0; k < 16; ++k) { const int bb = pt * 16 + k; s += cv_[k]; sp += (bb < F.blk) ? cv_[k] : 0; }
      part[pt * 64 + e] = s; part[pt * 64 + 32 + e] = sp; }
    __syncthreads();
    if (F.tid < 32) { int s = 0, sp = 0; for (int k = 0; k < 16; ++k) { s += part[k * 64 + F.tid]; sp += part[k * 64 + 32 + F.tid]; } tot[F.tid] = s; pre[F.tid] = sp; }
    if (F.tid >= 64 && F.tid < 64 + 64) { const int tk = F.tid - 64; const i32x2 e = ((const i32x2*)(A->ws + WS_MISC + MI_ROUTE_E))[F.blk * 64 + tk]; ids[2 * tk] = e.x; ids[2 * tk + 1] = e.y; }
    __syncthreads();
    if (F.tid == 0) { int s = 0; for (int e = 0; e < 32; ++e) { pst[e] = s; s += (tot[e] + 255) & ~255; }
        if (F.blk == 0) { int* te = (int*)(A->ws + WS_MISC + MI_TILEE); int tl = 0; for (int e = 0; e < 32; ++e) { const int n = (tot[e] + 255) >> 8; for (int k = 0; k < n; ++k) te[tl++] = e; } te[MAXTILES] = tl; } }
    __syncthreads();
    if (F.tid < 32) { int run = pst[F.tid] + pre[F.tid]; for (int a = 0; a < 128; ++a) if (ids[a] == F.tid) dst[a] = run++; }
    __syncthreads();
    if (F.tid < 64) { const int t = F.blk * 64 + F.tid; ((i32x2*)(A->ws + WS_MISC + MI_DEST))[t] = (i32x2){dst[2 * F.tid], dst[2 * F.tid + 1]};
        const f32x2 w = ((const f32x2*)(A->ws + WS_MISC + MI_ROUTE_W))[t]; float* rw = (float*)(A->ws + WS_MISC + MI_ROWW); rw[dst[2 * F.tid]] = w.x; rw[dst[2 * F.tid + 1]] = w.y; }
    const bf16* H = (const bf16*)(A->ws + WS_H); bf16* XB = (bf16*)(A->ws + WS_XB);
    for (int a = (F.tid >> 8); a < 128; a += 2) { const int t = F.blk * 64 + (a >> 1), c = (F.tid & 255) * 8;
        *(GAS v4u*)(XB + (size_t)dst[a] * D + c) = *(const GAS v4u*)(H + (size_t)t * D + c); }
    __syncthreads();
}
DI void phase_ln3(KArgs A, const Frame& F, int l, float* xout) {
    LAS float* ms = (LAS float*)(F.lds + RING_OFF);
    const bool next = (l + 1 < DEPTH);
    stage_mod(A, ms, l, 5, 1.f, F.tid);
    if (next) { stage_mod(A, ms + 4096, l + 1, 1, 1.f, F.tid); stage_mod(A, ms + 8192, l + 1, 0, 0.f, F.tid); }
    for (int i = F.tid; i < D; i += NT) { ms[12288 + i] = A->in[I_LNG][(size_t)(l * 2 + 1) * D + i]; ms[12288 + D + i] = A->in[I_LNB][(size_t)(l * 2 + 1) * D + i];
        ms[16384 + i] = A->in[I_LNG][(size_t)(l * 2 + 0) * D + i]; ms[16384 + D + i] = A->in[I_LNB][(size_t)(l * 2 + 0) * D + i]; }
    __syncthreads();
    const int gw = F.blk * NWAVES + F.wave, NGW = F.G * NWAVES;
    const f32x2* stats = (const f32x2*)(A->ws + WS_MISC + MI_STATS);
    const float* Z = (const float*)(A->ws + WS_Z); const bf16* YR = (const bf16*)(A->ws + WS_YR); bf16* H = (bf16*)(A->ws + WS_H);
    const i32x2* dest = (const i32x2*)(A->ws + WS_MISC + MI_DEST);
    for (int row0 = gw; row0 < T; row0 += 2 * NGW) { f32x4 v[2][8];
        const i32x2 d0 = dest[row0], d1 = dest[row0 + NGW];
#pragma unroll
        for (int r = 0; r < 2; ++r) { const GAS f32x4* zr = (const GAS f32x4*)(Z + (size_t)(row0 + r * NGW) * D) + F.lane;
#pragma unroll
            for (int j = 0; j < 8; ++j) v[r][j] = zr[64 * j]; }
#pragma unroll
        for (int r = 0; r < 2; ++r) { const int row = row0 + r * NGW, b = row >> 13; const i32x2 d = r ? d1 : d0; const f32x2 st = stats[row];
            const GAS v2u* y0 = (const GAS v2u*)(YR + (size_t)d.x * D) + F.lane; const GAS v2u* y1 = (const GAS v2u*)(YR + (size_t)d.y * D) + F.lane;
            v2u ya[8], yb[8];
#pragma unroll
            for (int j = 0; j < 8; ++j) { ya[j] = y0[64 * j]; yb[j] = y1[64 * j]; }
            __builtin_amdgcn_sched_barrier(0);
#pragma unroll
            for (int j = 0; j < 8; ++j) { const int c = 4 * (F.lane + 64 * j); const v2u a = ya[j], q = yb[j]; const f32x4 gt = *(const LAS f32x4*)(ms + b * 2048 + c);
                const f32x4 ym = {bf_lo(a.x) + bf_lo(q.x), bf_hi(a.x) + bf_hi(q.x), bf_lo(a.y) + bf_lo(q.y), bf_hi(a.y) + bf_hi(q.y)};
                const f32x4 x1 = (v[r][j] - st.x) * st.y * *(const LAS f32x4*)(ms + 16384 + c) + *(const LAS f32x4*)(ms + 16384 + D + c);
                v[r][j] = x1 * ALPHA + gt * ym; }
            float mean, rstd; row_stats(v[r], mean, rstd);
            GAS f32x4* xo = (GAS f32x4*)(xout + (size_t)row * D) + F.lane;
#pragma unroll
            for (int j = 0; j < 8; ++j) { const int c = 4 * (F.lane + 64 * j); v[r][j] = (v[r][j] - mean) * rstd * *(const LAS f32x4*)(ms + 12288 + c) + *(const LAS f32x4*)(ms + 12288 + D + c); xo[64 * j] = v[r][j]; }
            if (next) ada_store(v[r], ms + 4096 + b * 2048, ms + 8192 + b * 2048, H + (size_t)row * D, nullptr, F.lane);
            __builtin_amdgcn_sched_barrier(0); } }
    __syncthreads();
}

constexpr int NPH = 15;
#ifdef ONLY_PHASE
#define IN(k) ((((k) % NPH) == ONLY_PHASE) && lo <= (k) && (k) < hi)
#else
#define IN(k) (lo <= (k) && (k) < hi)
#endif
#ifndef REPMASK
#define REPMASK 0
#endif
#ifndef BARREP
#define BARREP 1
#endif
#define REP4A 1
#define REP4B 1
#define REP_S2 1
#define REP_PREP 1
#define REP_S5A 1
#define REP_S5C 1
#define REP_CONV 1
#define REP_ATT 1
#define REP_ST1 1
#define NREP(k) (1 + ((REPMASK >> (k)) & 1))
#define SEAM(k) do { if (IN(k) && IN((k) + 1)) { for (int br_ = 0; br_ < BARREP; ++br_) xcd_barrier(bar); } } while (0)
template <int l> DI void run_layer(KArgs A0, LAS unsigned char* lds, const XcdBarrier& bar, const int lo, const int hi, const int wv) {
    KArgs A = A0; Frame F;
    {
        constexpr int p0 = l * NPH;

        for (int rep_ = 0; rep_ < NREP(0); ++rep_) { A = launder(A0); F = mkframe(lds, wv); if (IN(p0 + 0) && l == 0) phase_wprep_a(A, F, l, F.blk * NWAVES + F.wave, F.G * NWAVES);
        if (NREP(0) > 1) __syncthreads(); } SEAM(p0 + 0);
        for (int rep_ = 0; rep_ < NREP(1); ++rep_) { A = launder(A0); F = mkframe(lds, wv); if (IN(p0 + 1) && l == 0) phase_ln_in(A, F, l);
        if (NREP(1) > 1) __syncthreads(); } SEAM(p0 + 1);
        for (int rep_ = 0; rep_ < NREP(2); ++rep_) { A = launder(A0); F = mkframe(lds, wv); if (IN(p0 + 2)) { pg8::Gemm g{(const bf16*)(A->ws + WS_H), (const bf16*)(A->ws + ws_win(l)), D}; pg8::StaticOrder S; S.init(T, NINP, F.G, F.blk);
            EpiP E{(bf16*)(A->ws + WS_P), NINP}; pg8::gemm_phase<EpiP, pg8::StaticOrder, true, true>(F.lds + RING_OFF, g, S, E, F.wave); }
        if (NREP(2) > 1) __syncthreads(); } SEAM(p0 + 2);
        for (int rep_ = 0; rep_ < NREP(3); ++rep_) { A = launder(A0); F = mkframe(lds, wv); if (IN(p0 + 3)) { for (int q_ = 0; q_ < REP_S5A; ++q_) s5_pass1_mfma(A, F, l); for (int q_ = 0; q_ < REP_PREP; ++q_) rwkv_prep_part(A, F, l, 0, F.G); }
        if (NREP(3) > 1) __syncthreads(); } SEAM(p0 + 3);
        for (int rep_ = 0; rep_ < NREP(4); ++rep_) { A = launder(A0); F = mkframe(lds, wv); if (IN(p0 + 4)) {
            if (F.blk < 8) s5_carry(A, F, l, 0);
            for (int q_ = 0; q_ < REP_ATT; ++q_) attn_part(A, F, l, 0, F.G, 0, 256);
            __syncthreads();
            { const int item = F.blk * NWAVES + F.wave; for (int q_ = 0; q_ < REP_ST1; ++q_) if (CKEN & 1) if (item < 2048) rwkv_chunk_stage1(A, F, item, (LAS float*)(F.lds + RING_OFF + F.wave * 16384)); } }
        if (NREP(4) > 1) __syncthreads(); } SEAM(p0 + 4);
        for (int rep_ = 0; rep_ < NREP(5); ++rep_) { A = launder(A0); F = mkframe(lds, wv); if (IN(p0 + 5)) {
            if (F.blk < S2WG) { for (int r2_ = 0; r2_ < REP_S2; ++r2_) if (F.wave < 2) rwkv_chunk_stage2(A, F, F.blk >> 1, 2 * (F.blk & 1) + F.wave); }
            else if (CHUNK_Y_TO_Z && F.blk < 72) rwkv_scan(A, F, F.blk - 8);
            else { constexpr int B0 = S2WG; const int nb = F.G - B0;
                if (F.wave < 4) { const int cw = (F.blk - B0) * 4 + F.wave, NCW = nb * 4;
                    for (int q_ = 0; q_ < REP_S5C; ++q_) s5_pass<true>(A, F, l, cw, NCW); for (int q_ = 0; q_ < REP_CONV; ++q_) conv_part(A, F, l, cw, NCW);
                    if (l + 1 < DEPTH) phase_wprep_a(A, F, l + 1, cw, NCW, 2); }
                else { const int mw = (F.blk - B0) * 4 + F.wave - 4, NMW = nb * 4;
                    for (int r4_ = 0; r4_ < REP4B; ++r4_) phase_wprep_b(A, F, l, mw, NMW);
                    if (l + 1 < DEPTH) phase_wprep_a(A, F, l + 1, mw, NMW, 1); } } }
        if (NREP(5) > 1) __syncthreads(); } SEAM(p0 + 5);
        for (int rep_ = 0; rep_ < NREP(6); ++rep_) { A = launder(A0); F = mkframe(lds, wv); if (IN(p0 + 6)) {
            const int item = F.blk * NWAVES + F.wave; if (item < 2048) rwkv_chunk_stage3(A, F, item, l); }
        if (NREP(6) > 1) __syncthreads(); } SEAM(p0 + 6);
        for (int rep_ = 0; rep_ < NREP(7); ++rep_) { A = launder(A0); F = mkframe(lds, wv); if (IN(p0 + 7)) {
            constexpr int GLUWG = 128;
            if (F.blk < GLUWG) { pg8::Gemm g{(const bf16*)(A->ws + WS_YS), (const bf16*)(A->ws + WS_GLU), 512}; pg8::StaticOrder S; S.init(T, 512, GLUWG, F.blk);
                EpiGlu E{(const bf16*)(A->ws + WS_YS), (bf16*)(A->ws + WS_YCAT), A->in[I_GLUB] + l * GW}; pg8::gemm_phase<EpiGlu, pg8::StaticOrder, true, true>(F.lds + RING_OFF, g, S, E, F.wave); } }
        if (NREP(7) > 1) __syncthreads(); } SEAM(p0 + 7);
        for (int rep_ = 0; rep_ < NREP(8); ++rep_) { A = launder(A0); F = mkframe(lds, wv); if (IN(p0 + 8)) { LAS float* g1p = (LAS float*)(F.lds + XTRA_OFF); stage_mod(A, g1p, l, 2, 1.f, F.tid); __syncthreads();
            pg8::Gemm g{(const bf16*)(A->ws + WS_YCAT), (const bf16*)(A->ws + WS_WOUT), D}; pg8::StaticOrder S; S.init(T, D, F.G, F.blk);
            const float* xin = (l == 0) ? A->in[I_X] : (const float*)A->out; EpiZ E{xin, (float*)(A->ws + WS_Z), g1p}; pg8::gemm_phase<EpiZ, pg8::StaticOrder, true, true>(F.lds + RING_OFF, g, S, E, F.wave); }
        if (NREP(8) > 1) __syncthreads(); } SEAM(p0 + 8);
        for (int rep_ = 0; rep_ < NREP(9); ++rep_) { A = launder(A0); F = mkframe(lds, wv); if (IN(p0 + 9)) phase_ln2(A, F, l);
        if (NREP(9) > 1) __syncthreads(); } SEAM(p0 + 9);
        for (int rep_ = 0; rep_ < NREP(10); ++rep_) { A = launder(A0); F = mkframe(lds, wv); if (IN(p0 + 10)) phase_router(A, F, l);
        if (NREP(10) > 1) __syncthreads(); } SEAM(p0 + 10);
        for (int rep_ = 0; rep_ < NREP(11); ++rep_) { A = launder(A0); F = mkframe(lds, wv); if (IN(p0 + 11)) phase_dispatch(A, F);
        if (NREP(11) > 1) __syncthreads(); } SEAM(p0 + 11);
        for (int rep_ = 0; rep_ < NREP(12); ++rep_) { A = launder(A0); F = mkframe(lds, wv); if (IN(p0 + 12)) { const int* te = (const int*)(A->ws + WS_MISC + MI_TILEE); pg8::Gemm g{(const bf16*)(A->ws + WS_XB), (const bf16*)(A->ws + WS_W13), D};
            pg8::GroupedOrder S{te[MAXTILES], 4, F.G, F.blk, te}; EpiMoeA E{(bf16*)(A->ws + WS_HMID)}; pg8::gemm_phase<EpiMoeA, pg8::GroupedOrder, true, true>(F.lds + RING_OFF, g, S, E, F.wave); }
        if (NREP(12) > 1) __syncthreads(); } SEAM(p0 + 12);
        for (int rep_ = 0; rep_ < NREP(13); ++rep_) { A = launder(A0); F = mkframe(lds, wv); if (IN(p0 + 13)) { const int* te = (const int*)(A->ws + WS_MISC + MI_TILEE); pg8::Gemm g{(const bf16*)(A->ws + WS_HMID), (const bf16*)(A->ws + WS_W2), DEXP};
            pg8::GroupedOrder S{te[MAXTILES], 8, F.G, F.blk, te}; EpiMoeB E{(bf16*)(A->ws + WS_YR), (const float*)(A->ws + WS_MISC + MI_ROWW)}; pg8::gemm_phase<EpiMoeB, pg8::GroupedOrder, true, true>(F.lds + RING_OFF, g, S, E, F.wave); }
        if (NREP(13) > 1) __syncthreads(); } SEAM(p0 + 13);
        for (int rep_ = 0; rep_ < NREP(14); ++rep_) { A = launder(A0); F = mkframe(lds, wv); if (IN(p0 + 14)) phase_ln3(A, F, l, A->out);
        if (NREP(14) > 1) __syncthreads(); } SEAM(p0 + 14);
    }
}
__global__ void __launch_bounds__(NT, 2) hybrid_fwd(Args Aval) {
    KArgs A0 = (KArgs)__builtin_amdgcn_kernarg_segment_ptr(); KArgs A = A0;
    extern __shared__ __attribute__((aligned(16))) unsigned char lds[];
    Frame F;
    F.lds = (LAS unsigned char*)lds;
    F.tid = threadIdx.x; F.lane = F.tid & 63; F.wave = __builtin_amdgcn_readfirstlane(F.tid >> 6);
    F.G = gridDim.x; F.blk = blockIdx.x;
    volatile LAS unsigned* MISC = (volatile LAS unsigned*)(F.lds + MISC_OFF);
    for (int u = F.tid; u < 1024 / 4; u += NT) ((LAS unsigned*)(F.lds + LDSCTL_OFF))[u] = 0u;
    __syncthreads();
    XcdBarrier bar = xcd_barrier_post((unsigned*)(A->ws + WS_CTL) + CW_BAR, MISC + 8);
    const int lo = A->ph_lo, hi = A->ph_hi;
    const int wv = F.wave;
    run_layer<0>(A0, (LAS unsigned char*)lds, bar, lo, hi, wv);
    run_layer<1>(A0, (LAS unsigned char*)lds, bar, lo, hi, wv);
}

#ifndef N_LAUNCH_MODE
#define N_LAUNCH_MODE 1
#endif
extern "C" void kernel_launch(void* const* d_in, const int* in_sizes, int n_in, void* d_out, int out_size, void* d_ws, size_t ws_size, hipStream_t stream) {
    static int grid = 0;
    if (grid == 0) {
        if (n_in != 39 || out_size != T * D || ws_size < WS_END) { fprintf(stderr, "kernel_launch: unexpected shapes (n_in %d, out %d, ws %zu)\n", n_in, out_size, ws_size); grid = -1; return; }
        int dev = 0, cus = 0, per_cu = 0;
        if (hipGetDevice(&dev) != hipSuccess || hipDeviceGetAttribute(&cus, hipDeviceAttributeMultiprocessorCount, dev) != hipSuccess) { grid = -1; return; }
        if (hipFuncSetAttribute((const void*)hybrid_fwd, hipFuncAttributeMaxDynamicSharedMemorySize, LDS_BYTES) != hipSuccess) { fprintf(stderr, "kernel_launch: hipFuncSetAttribute failed\n"); grid = -1; return; }
        if (hipOccupancyMaxActiveBlocksPerMultiprocessor(&per_cu, (const void*)hybrid_fwd, NT, LDS_BYTES) != hipSuccess || per_cu < 1) fprintf(stderr, "kernel_launch: occupancy query says %d\n", per_cu);
        (void)hipGetLastError();
        grid = cus;
        if (grid != 256) { fprintf(stderr, "kernel_launch: %d CUs; this kernel is built for 256\n", grid); grid = -1; return; }
    }
    if (grid < 0) return;
    Args a{};
    for (int i = 0; i < 39; ++i) a.in[i] = (const float*)d_in[i];
    a.out = (float*)d_out; a.ws = (unsigned char*)d_ws;
#if N_LAUNCH_MODE == 1
    (void)hipMemsetAsync((char*)d_ws + WS_CTL, 0, CTL_ZERO_BYTES, stream);
    a.ph_lo = 0; a.ph_hi = DEPTH * NPH;
    hipLaunchKernelGGL(hybrid_fwd, dim3(grid), dim3(NT), LDS_BYTES, stream, a);
#else
    for (int ph = 0; ph < DEPTH * NPH; ++ph) {
        if (ph == 1 * NPH + 1) continue;
        (void)hipMemsetAsync((char*)d_ws + WS_CTL, 0, CTL_ZERO_BYTES, stream);
        a.ph_lo = ph; a.ph_hi = ph + 1;
        hipLaunchKernelGGL(hybrid_fwd, dim3(grid), dim3(NT), LDS_BYTES, stream, a);
    }
#endif
}
```

```cpp
#include <hip/hip_runtime.h>
#include <cstdio>
#include <cstdint>
namespace pg8 {
#define PG8_LAS __attribute__((address_space(3)))
typedef unsigned short bf16_t;
typedef short bf16x8 __attribute__((ext_vector_type(8)));
typedef float f32x4 __attribute__((ext_vector_type(4)));
typedef unsigned u32x4 __attribute__((ext_vector_type(4)));
constexpr int BM = 256, BK = 64, HALF = 128, HTB = HALF * BK * 2  , STAGE_BYTES = 8 * HTB, NXCD = 8, WGM = 8;

__host__ __device__ __forceinline__ int lds_byte(int r, int c) { const int st = (r >> 4) * 2 + (c >> 5), rr = r & 15, cc = c & 31, ob = rr * 64 + cc * 2; return st * 1024 + (ob ^ (((ob >> 9) & 1) << 5)); }
__host__ __device__ __forceinline__ void stage_rc(int b, int& R, int& C) { const int st = b / 1024, sb = b % 1024, swz = sb ^ (((sb >> 9) & 1) << 5); R = (st >> 1) * 16 + swz / 64; C = (st & 1) * 32 + (swz % 64) / 2; }
__host__ __device__ __forceinline__ int perm32(int rho) { const int n = rho >> 4, i = rho & 15; return 8 * (i >> 2) + 4 * n + (i & 3); }


struct Unit { int pm, pn, po; };
struct Gemm { const bf16_t* A; const bf16_t* Bt; int K; };

struct StaticOrder {
    int nM, nN, nwg, G, c;
    __device__ void init(int M, int N, int G_, int c_) { nM = M / BM; nN = N / BM; nwg = nM * nN; G = G_; c = c_; }
    __device__ bool next(int i, Unit& u) const {
        const long L = (long)i * G + c; if (L >= nwg) return false;
        int wgid = (int)L; { const int q = nwg / NXCD, r = nwg % NXCD, xcd = wgid % NXCD, off = wgid / NXCD; wgid = (xcd < r ? xcd * (q + 1) : r * (q + 1) + (xcd - r) * q) + off; }
        const int nig = WGM * nN, gid = wgid / nig, fm = gid * WGM, gsz = (nM - fm) < WGM ? (nM - fm) : WGM;
        u.pm = fm + ((wgid % nig) % gsz); u.pn = (wgid % nig) / gsz; u.po = u.pn; return true;
    }
    __device__ __forceinline__ void a_ready(const Unit&) const {}
    __device__ __forceinline__ void done(const Unit&) const {}
};
struct GroupedOrder {
    int ntiles, npn, G, c; const int* tile_e;
    __device__ bool next(int i, Unit& u) const {
        const int idx = c >> 3, pn = idx % npn, rpx = (G >> 3) / npn, t = (i * 8 + (c & 7)) * rpx + idx / npn; if (t >= ntiles) return false;
        u.pm = t; u.po = pn; u.pn = tile_e[t] * npn + pn; return true;
    }
    __device__ __forceinline__ void a_ready(const Unit&) const {}
    __device__ __forceinline__ void done(const Unit&) const {}
};
__device__ __forceinline__ unsigned cvt_pk_bf16(float lo, float hi) { unsigned r; asm volatile("s_nop 0\n\tv_cvt_pk_bf16_f32 %0, %1, %2" : "=v"(r) : "v"(lo), "v"(hi)); return r; }
template <class Epi, class Sched, bool ALIGN_EPI = false, bool SP2 = false>
__device__ __forceinline__ void gemm_phase(PG8_LAS unsigned char* lds, const Gemm g, const Sched& S, const Epi& E, int wv) {
    int tid_ = (wv << 6) | (int)__builtin_amdgcn_mbcnt_hi(~0u, __builtin_amdgcn_mbcnt_lo(~0u, 0u)); asm volatile("" : "+v"(tid_));
    const int tid = tid_, wid = __builtin_amdgcn_readfirstlane(tid >> 6), lane = tid & 63, wr = wid >> 2, wc = wid & 3, fr = lane & 15, fq = lane >> 4;
    const int K = g.K, nt = K / BK;
    unsigned voffA[2], voffB[2];
#pragma unroll
    for (int i = 0; i < 2; ++i) { int R, C; stage_rc(tid * 16 + i * 8192, R, C); const int Rb = Epi::PERM ? ((R & ~31) + perm32(R & 31)) : R;
        voffA[i] = (unsigned)(R * K + C) * 2u; voffB[i] = (unsigned)(Rb * K + C) * 2u; }
    const size_t kstep = (size_t)(BK * 2);
    const size_t hstep = (size_t)HALF * K * 2;
    const size_t tstep = 2 * hstep;
    const unsigned ldsw = (unsigned)wid * 1024u;
    const int aoff = lds_byte(wr * 64 + fr, fq * 8), boff = lds_byte(wc * 32 + fr, fq * 8);
#define PG8_SA(b, h) (((b) * 2 + (h)) * HTB)
#define PG8_SB(b, h) ((4 + (b) * 2 + (h)) * HTB)
#define PG8_STAGE(bufoff, gbase, voff) do { _Pragma("unroll") for (int _i = 0; _i < 2; ++_i) \
        __builtin_amdgcn_global_load_lds((const unsigned*)((const char*)(gbase) + (voff)[_i]), (PG8_LAS unsigned*)(lds + (bufoff) + ldsw + _i * 8192), 16, 0, 0); } while (0)
#define PG8_LDA(dst, b, h) do { _Pragma("unroll") for (int m = 0; m < 4; ++m) _Pragma("unroll") for (int k = 0; k < 2; ++k) dst[m][k] = *(const PG8_LAS bf16x8*)(lds + PG8_SA(b, h) + aoff + m * 2048 + k * 1024); } while (0)
#define PG8_LDB(dst, b, h) do { _Pragma("unroll") for (int n = 0; n < 2; ++n) _Pragma("unroll") for (int k = 0; k < 2; ++k) dst[n][k] = *(const PG8_LAS bf16x8*)(lds + PG8_SB(b, h) + boff + n * 2048 + k * 1024); } while (0)
#define PG8_MMA(ai, bj, At, Bt) do { __builtin_amdgcn_s_setprio(1); _Pragma("unroll") for (int m = 0; m < 4; ++m) _Pragma("unroll") for (int n = 0; n < 2; ++n) _Pragma("unroll") for (int k = 0; k < 2; ++k) \
        acc[ai][bj][m][n] = __builtin_amdgcn_mfma_f32_16x16x32_bf16(Bt[n][k], At[m][k], acc[ai][bj][m][n], 0, 0, 0); __builtin_amdgcn_s_setprio(0); } while (0)
#define PG8_WAIT_V(n) asm volatile("s_waitcnt vmcnt(" #n ")" ::: "memory")
#define PG8_WAIT_L(n) asm volatile("s_waitcnt lgkmcnt(" #n ")" ::: "memory")
#define PG8_BAR __builtin_amdgcn_s_barrier()
#define PG8_SCHED __builtin_amdgcn_sched_barrier(0)
    Unit cur, nxt; int ui = 0;
    if (!S.next(0, cur)) return;
    f32x4 acc[2][2][4][2];
#pragma unroll
    for (int a = 0; a < 2; ++a)
#pragma unroll
        for (int b = 0; b < 2; ++b)
#pragma unroll
            for (int m = 0; m < 4; ++m)
#pragma unroll
                for (int n = 0; n < 2; ++n) acc[a][b][m][n] = (f32x4){0.f, 0.f, 0.f, 0.f};
    bf16x8 At[4][2], B0[2][2], B1[2][2];
    const char* cA = (const char*)g.A + (size_t)cur.pm * tstep; const char* cB = (const char*)g.Bt + (size_t)cur.pn * tstep;
    S.a_ready(cur);
    if constexpr (SP2) {
        PG8_STAGE(PG8_SB(0, 0), cB, voffB); PG8_STAGE(PG8_SB(0, 1), cB + hstep, voffB); PG8_STAGE(PG8_SA(0, 0), cA, voffA); PG8_STAGE(PG8_SA(0, 1), cA + hstep, voffA);
        if (wr == 1) PG8_BAR;
        PG8_WAIT_V(2); PG8_BAR;
        PG8_STAGE(PG8_SB(1, 0), cB + kstep, voffB); PG8_STAGE(PG8_SA(1, 0), cA + kstep, voffA); PG8_STAGE(PG8_SB(1, 1), cB + hstep + kstep, voffB);
        PG8_WAIT_V(6); PG8_BAR;
    } else {
        PG8_STAGE(PG8_SB(0, 0), cB, voffB); PG8_STAGE(PG8_SA(0, 0), cA, voffA); PG8_STAGE(PG8_SB(0, 1), cB + hstep, voffB); PG8_STAGE(PG8_SA(0, 1), cA + hstep, voffA);
        if (wr == 1) PG8_BAR;
        PG8_WAIT_V(4); PG8_BAR;
        PG8_STAGE(PG8_SB(1, 0), cB + kstep, voffB); PG8_STAGE(PG8_SA(1, 0), cA + kstep, voffA); PG8_STAGE(PG8_SB(1, 1), cB + hstep + kstep, voffB);
        PG8_WAIT_V(6); PG8_BAR;
    }
    for (;;) {
        const bool has_next = S.next(ui + 1, nxt);
        const char* nA = has_next ? (const char*)g.A + (size_t)nxt.pm * tstep : cA; const char* nB = has_next ? (const char*)g.Bt + (size_t)nxt.pn * tstep : cB;
        asm volatile(".p2align 8");
        for (int t = 0; t < nt; t += 2) {
            const bool last = (t == nt - 2);
            const char* a1 = cA + (size_t)(t + 1) * kstep;
            const char* a2 = last ? nA : cA + (size_t)(t + 2) * kstep; const char* b2 = last ? nB : cB + (size_t)(t + 2) * kstep;
            const char* a3 = a2 + kstep; const char* b3 = b2 + kstep;
            if (last && has_next) S.a_ready(nxt);
            if constexpr (SP2) {
            PG8_LDB(B0, 0, 0); PG8_LDB(B1, 0, 1); PG8_SCHED; PG8_LDA(At, 0, 0); PG8_STAGE(PG8_SA(1, 1), a1 + hstep, voffA);
            PG8_WAIT_V(8); PG8_WAIT_L(0); PG8_BAR; PG8_MMA(0, 0, At, B0); PG8_MMA(0, 1, At, B1); PG8_BAR; PG8_SCHED;
            PG8_LDA(At, 0, 1); PG8_STAGE(PG8_SB(0, 0), b2, voffB); PG8_STAGE(PG8_SB(0, 1), b2 + hstep, voffB); PG8_STAGE(PG8_SA(0, 0), a2, voffA);
            PG8_WAIT_V(8); PG8_WAIT_L(0); PG8_BAR; PG8_MMA(1, 0, At, B0); PG8_MMA(1, 1, At, B1); PG8_BAR; PG8_SCHED;
            PG8_LDB(B0, 1, 0); PG8_LDB(B1, 1, 1); PG8_SCHED; PG8_LDA(At, 1, 0); PG8_STAGE(PG8_SA(0, 1), a2 + hstep, voffA);
            PG8_WAIT_V(8); PG8_WAIT_L(0); PG8_BAR; PG8_MMA(0, 0, At, B0); PG8_MMA(0, 1, At, B1); PG8_BAR; PG8_SCHED;
            PG8_LDA(At, 1, 1); PG8_STAGE(PG8_SB(1, 0), b3, voffB); PG8_STAGE(PG8_SB(1, 1), b3 + hstep, voffB); PG8_STAGE(PG8_SA(1, 0), a3, voffA);
            PG8_WAIT_V(8); PG8_WAIT_L(0); PG8_BAR; PG8_MMA(1, 0, At, B0); PG8_MMA(1, 1, At, B1); PG8_BAR; PG8_SCHED;
            } else {
            PG8_LDB(B0, 0, 0); PG8_SCHED; PG8_LDA(At, 0, 0); PG8_STAGE(PG8_SA(1, 1), a1 + hstep, voffA);
            PG8_WAIT_L(8); PG8_BAR; PG8_WAIT_L(0); PG8_MMA(0, 0, At, B0); PG8_BAR; PG8_SCHED;
            PG8_LDB(B1, 0, 1); PG8_STAGE(PG8_SB(0, 0), b2, voffB);
            PG8_BAR; PG8_WAIT_L(0); PG8_MMA(0, 1, At, B1); PG8_BAR;
            PG8_LDA(At, 0, 1); PG8_STAGE(PG8_SA(0, 0), a2, voffA);
            PG8_BAR; PG8_WAIT_L(0); PG8_MMA(1, 0, At, B0); PG8_BAR; PG8_SCHED;
            PG8_STAGE(PG8_SB(0, 1), b2 + hstep, voffB);
            PG8_WAIT_V(6); PG8_BAR; PG8_MMA(1, 1, At, B1); PG8_BAR;
            PG8_LDB(B0, 1, 0); PG8_SCHED; PG8_LDA(At, 1, 0); PG8_STAGE(PG8_SA(0, 1), a2 + hstep, voffA);
            PG8_WAIT_L(8); PG8_BAR; PG8_WAIT_L(0); PG8_MMA(0, 0, At, B0); PG8_BAR; PG8_SCHED;
            PG8_LDB(B1, 1, 1); PG8_STAGE(PG8_SB(1, 0), b3, voffB);
            PG8_BAR; PG8_WAIT_L(0); PG8_MMA(0, 1, At, B1); PG8_BAR;
            PG8_LDA(At, 1, 1); PG8_STAGE(PG8_SA(1, 0), a3, voffA);
            PG8_BAR; PG8_WAIT_L(0); PG8_MMA(1, 0, At, B0); PG8_BAR; PG8_SCHED;
            PG8_STAGE(PG8_SB(1, 1), b3 + hstep, voffB);
            PG8_WAIT_V(6); PG8_BAR; PG8_MMA(1, 1, At, B1); PG8_BAR;
            }
        }
        if constexpr (ALIGN_EPI) { if (wr == 0) PG8_BAR; }
        if constexpr (!Epi::AFTER_DRAIN) { E(acc, cur, wr, wc, fr, fq); S.done(cur); }
        if (!has_next) break;
#pragma unroll
        for (int a = 0; a < 2; ++a)
#pragma unroll
            for (int b = 0; b < 2; ++b)
#pragma unroll
                for (int m = 0; m < 4; ++m)
#pragma unroll
                    for (int n = 0; n < 2; ++n) acc[a][b][m][n] = (f32x4){0.f, 0.f, 0.f, 0.f};
        cur = nxt; cA = nA; cB = nB; ++ui;
        if constexpr (ALIGN_EPI) { if (wr == 1) PG8_BAR; }
    }
    PG8_WAIT_V(0);
    if constexpr (!ALIGN_EPI) { if (wr == 0) PG8_BAR; }
    PG8_BAR;
    if constexpr (Epi::AFTER_DRAIN) { E.fused(acc, cur, wr, wc, fr, fq, lds, wid, lane); S.done(cur); }
#undef PG8_SA
#undef PG8_SB
#undef PG8_STAGE
#undef PG8_LDA
#undef PG8_LDB
#undef PG8_MMA
#undef PG8_WAIT_V
#undef PG8_WAIT_L
#undef PG8_BAR
#undef PG8_SCHED
}
}

constexpr int D = 2048, BATCH = 2, SEQ = 8192, T = BATCH * SEQ, DEPTH = 2, GW = 512;
constexpr int RW_OFF = 3 * GW, RW_COLS = 3 * GW + 96 + 96 + 128, ATT_OFF = RW_OFF + RW_COLS, S5_OFF = ATT_OFF + 512 + 256, NIN = S5_OFF + GW, NINP = 4864;
static_assert(NIN == 4672 && ATT_OFF == 3392 && S5_OFF == 4160, "column layout");
constexpr int NEXP = 32, DEXP = 512, MAXTILES = 160, MAXROWS = MAXTILES * 256;
constexpr float ALPHA = 1.41421356237f, LN_EPS = 1e-5f, GN_EPS = 64e-5f;
constexpr int NWAVES = 8, NT = 512;
constexpr int KS_MOD = 8;

constexpr size_t MiB = 1u << 20;
constexpr size_t WS_CTL = 0, CTL_ZERO_BYTES = 16384;
constexpr size_t WS_MODP = 1 * MiB;
constexpr size_t WS_MODF = 4 * MiB;
constexpr size_t WS_WIN = 5 * MiB;
constexpr size_t WS_WOUT = 24 * MiB;
constexpr size_t WS_GLU = 32 * MiB;
constexpr size_t WS_LORA = WS_GLU + MiB / 2;
constexpr size_t WS_ROUT = 33 * MiB;
constexpr size_t WS_S5C = WS_ROUT + MiB / 2;
constexpr size_t WS_MISC = 34 * MiB;
constexpr size_t WS_W13 = 36 * MiB;
constexpr size_t WS_W2 = 164 * MiB;
constexpr size_t WS_H = 228 * MiB;
constexpr size_t WS_Z = 292 * MiB;
constexpr size_t WS_P = 420 * MiB;
constexpr size_t WS_YCAT = 572 * MiB;
constexpr size_t WS_RW = 636 * MiB;
constexpr size_t WS_RWSC = 892 * MiB;
constexpr size_t WS_YS = 894 * MiB;
constexpr size_t WS_S5E = 910 * MiB;
constexpr size_t WS_S5X = 914 * MiB;
constexpr size_t WS_WIN2 = 918 * MiB;
constexpr size_t WS_LORA2 = 937 * MiB, WS_S5C2 = 938 * MiB;
constexpr size_t WS_CK = 939 * MiB;
constexpr size_t WS_END = 1164 * MiB;
constexpr size_t WS_XB = WS_P;
constexpr size_t WS_YR = WS_P;
constexpr size_t WS_HLO = WS_RW;
constexpr size_t WS_HMID = WS_RW + 64 * MiB;
static_assert(WS_P + (size_t)MAXROWS * 2048 * 2 <= WS_RW, "XB overlay");
constexpr size_t MI_COUNTS = 0;
constexpr size_t MI_TILEE = 64 * 1024;
constexpr size_t MI_ROUTE_E = 128 * 1024;
constexpr size_t MI_ROUTE_W = 256 * 1024;
constexpr size_t MI_DEST = 384 * 1024;
constexpr size_t MI_ROWW = 512 * 1024;
constexpr size_t MI_S5POW = 1280 * 1024;
constexpr size_t MI_S5BBF = MI_S5POW + 320 * 1024;
constexpr size_t MI_STATS = 1024 * 1024;
constexpr size_t S5C_LAM = 0;
constexpr size_t S5C_BB = 32 * 1024;
constexpr size_t S5C_CP = 32 * 1024 + 256 * 1024;
static_assert(S5C_CP + 32 * 16 * 128 * 2 <= MiB / 2, "S5C");
__device__ __forceinline__ constexpr size_t ws_win(int l) { return (l & 1) ? WS_WIN2 : WS_WIN; }
__device__ __forceinline__ constexpr size_t ws_lora(int l) { return (l & 1) ? WS_LORA2 : WS_LORA; }
__device__ __forceinline__ constexpr size_t ws_s5c(int l) { return (l & 1) ? WS_S5C2 : WS_S5C; }
constexpr int CW_BAR = 4096;
static_assert(3456 * 4 <= 16384, "barrier words fit the zeroed range");

constexpr int RING_OFF = 0, RING_BYTES = 131072;
constexpr int XTRA_OFF = RING_BYTES;
constexpr int LDSCTL_OFF = XTRA_OFF + 16384, MISC_OFF = LDSCTL_OFF + 320;
constexpr int LDS_BYTES = LDSCTL_OFF + 1024;
static_assert(LDS_BYTES <= 163840, "LDS");

#define GAS __attribute__((address_space(1)))
#define LAS __attribute__((address_space(3)))
#define DI __device__ __forceinline__
typedef unsigned short bf16;
typedef unsigned v4u __attribute__((ext_vector_type(4)));
typedef unsigned v2u __attribute__((ext_vector_type(2)));
typedef float f32x4 __attribute__((ext_vector_type(4)));
typedef float f32x2 __attribute__((ext_vector_type(2)));
typedef int i32x2 __attribute__((ext_vector_type(2)));
typedef short bf16x8 __attribute__((ext_vector_type(8)));
typedef GAS unsigned gu32;
#define RLX_AGENT __ATOMIC_RELAXED, __HIP_MEMORY_SCOPE_AGENT
#define LDS_WAIT() asm volatile("s_waitcnt lgkmcnt(0)" ::: "memory")
#define VM_WAIT() asm volatile("s_waitcnt vmcnt(0)" ::: "memory")
using pg8::cvt_pk_bf16;
typedef __bf16 bf2_t __attribute__((ext_vector_type(2)));
DI unsigned cvt_pk_safe(float lo, float hi) { const bf2_t r = __builtin_convertvector((f32x2){lo, hi}, bf2_t); return __builtin_bit_cast(unsigned, r); }
DI float bf_lo(unsigned u) { return __builtin_bit_cast(float, u << 16); }
DI float bf_hi(unsigned u) { return __builtin_bit_cast(float, u & 0xffff0000u); }
DI float bf1(bf16 b) { return __builtin_bit_cast(float, (unsigned)b << 16); }
DI float rcpf_(float x) { return __builtin_amdgcn_rcpf(x); }
DI float sigmoidf_(float x) { return rcpf_(1.f + __expf(-x)); }
DI float siluf_(float x) { return x * rcpf_(1.f + __expf(-x)); }
DI float tanhf_(float x) { const float e = __expf(-2.f * fabsf(x)); const float t = (1.f - e) * rcpf_(1.f + e); return x < 0.f ? -t : t; }
DI float gelu_tanh(float x) { const float u = 0.7978845608028654f * (x + 0.044715f * x * x * x); return 0.5f * x * (1.f + tanhf_(u)); }
template <int CTRL> DI float dppf(float x) { return __builtin_bit_cast(float, __builtin_amdgcn_update_dpp(0, __builtin_bit_cast(int, x), CTRL, 0xF, 0xF, true)); }
DI float allsum16(float x) { x += dppf<0xB1>(x); x += dppf<0x4E>(x); x += dppf<0x141>(x); x += dppf<0x140>(x); return x; }
DI float rdlane(float x, int l) { return __builtin_bit_cast(float, __builtin_amdgcn_readlane(__builtin_bit_cast(int, x), l)); }
DI float wave_sum(float v) { v = allsum16(v); return (rdlane(v, 0) + rdlane(v, 16)) + (rdlane(v, 32) + rdlane(v, 48)); }
DI bf16x8 as_frag(v4u v) { return __builtin_bit_cast(bf16x8, v); }
#define MFMA16(a, b, c) __builtin_amdgcn_mfma_f32_16x16x32_bf16((a), (b), (c), 0, 0, 0)

#define XB_TMO      128
#define XB_XCNT(j)  (256  + 64 * (j))
#define XB_XSUB(j)  (1280 + 64 * (j))
#define XB_XGEN(j)  (2304 + 64 * (j))
#define XB_TOP      3328
#define XB_TOPGEN   3392
#define XCD_BAR_WORDS 3456
#define XB_SPIN_CAP (1u << 18)
__device__ __forceinline__ unsigned xb_ld(unsigned* p)              { return __hip_atomic_load(p, __ATOMIC_RELAXED, __HIP_MEMORY_SCOPE_AGENT); }
__device__ __forceinline__ unsigned xb_add(unsigned* p, unsigned v) { return __hip_atomic_fetch_add(p, v, __ATOMIC_RELAXED, __HIP_MEMORY_SCOPE_AGENT); }
__device__ __forceinline__ unsigned xb_xcc_id() { return (unsigned)__builtin_amdgcn_s_getreg((3 << 11) | 20) & 0xFu; }
#define XB_SPIN(cond, bar) do { unsigned _sp = 0; while (cond) { __builtin_amdgcn_s_sleep(1); \
    if ((++_sp & 255u) == 0u) { if (xb_ld(&(bar)[XB_TMO])) break; if (_sp > XB_SPIN_CAP) { atomicAdd(&(bar)[XB_TMO], 1u); break; } } } } while (0)
struct XcdBarrier { unsigned* bar; unsigned x; volatile LAS unsigned* st; int wv; };
__device__ __forceinline__ XcdBarrier xcd_barrier_post(unsigned* bar, volatile LAS unsigned* st) {
    XcdBarrier b; b.bar = bar; b.x = xb_xcc_id(); b.st = st; b.wv = __builtin_amdgcn_readfirstlane((int)threadIdx.x >> 6);
    if (threadIdx.x == 0) (void)xb_add(&bar[XB_XCNT(b.x)], 1u);
    return b;
}
__device__ __forceinline__ void xcd_barrier_complete(unsigned* bar, unsigned x, unsigned& nloc, unsigned& nx) {
    const unsigned G = gridDim.x * gridDim.y * gridDim.z;
    unsigned sum, cnt, mine, sp = 0u;
    for (;;) {
        sum = 0u; cnt = 0u; mine = 0u;
#pragma unroll
        for (unsigned j = 0; j < 16; ++j) { const unsigned c = xb_ld(&bar[XB_XCNT(j)]); sum += c; cnt += (c > 0u) ? 1u : 0u; mine = (j == x) ? c : mine; }
        if (sum == G) break;
        __builtin_amdgcn_s_sleep(1);
        if ((++sp & 255u) == 0u) { if (xb_ld(&bar[XB_TMO])) break; if (sp > XB_SPIN_CAP) { atomicAdd(&bar[XB_TMO], 1u); break; } }
    }
    nloc = mine > 0u ? mine : 1u; nx = cnt > 0u ? cnt : 1u;
}
__device__ __forceinline__ void xcd_barrier(const XcdBarrier& b) {
    asm volatile("s_waitcnt vmcnt(0)" ::: "memory");
    __syncthreads();
    if (b.wv == 0 && __builtin_amdgcn_mbcnt_hi(~0u, __builtin_amdgcn_mbcnt_lo(~0u, 0u)) == 0u) {
        unsigned* bar = b.bar;
        __builtin_amdgcn_s_waitcnt(0);
        unsigned nloc = b.st[0], nx = b.st[1];
        if (nloc == 0u) { xcd_barrier_complete(bar, b.x, nloc, nx); b.st[0] = nloc; b.st[1] = nx; }
        const unsigned old = xb_add(&bar[XB_XSUB(b.x)], 1u);
        const unsigned gen = old / nloc;
        if (old + 1u == (gen + 1u) * nloc) {
            __builtin_amdgcn_fence(__ATOMIC_RELEASE, "agent");
            asm volatile("s_waitcnt vmcnt(0)" ::: "memory");
            const unsigned og = xb_add(&bar[XB_TOP], 1u);
            const unsigned tg = og / nx;
            if (og + 1u == (tg + 1u) * nx) xb_add(&bar[XB_TOPGEN], 1u);
            else XB_SPIN(xb_ld(&bar[XB_TOPGEN]) == tg, bar);
            __builtin_amdgcn_fence(__ATOMIC_ACQUIRE, "agent");
            xb_add(&bar[XB_XGEN(b.x)], 1u);
            asm volatile("s_waitcnt vmcnt(0)" ::: "memory");
        } else {
            XB_SPIN(xb_ld(&bar[XB_XGEN(b.x)]) == gen, bar);
            __builtin_amdgcn_fence(__ATOMIC_ACQUIRE, "agent");
            asm volatile("s_waitcnt vmcnt(0)" ::: "memory");
        }
    }
    __syncthreads();
}

struct Frame {
    LAS unsigned char* lds;
    int tid, lane, wave, G, blk;
};
struct Args { const float* in[39]; float* out; unsigned char* ws; int ph_lo, ph_hi; };
typedef const __attribute__((address_space(4))) Args* KArgs;
DI KArgs launder(KArgs p) { asm volatile("" : "+s"(p)); return p; }
enum { I_X = 0, I_C, I_WADA, I_BADA, I_LNG, I_LNB, I_WIN, I_WOUT, I_CONVW, I_MU, I_W0, I_W2, I_A0, I_A2, I_G2, I_KK, I_KA, I_RK, I_GNG, I_GNB,
       I_SINKS, I_RELB, I_LRE, I_LIM, I_LOGDT, I_BRE, I_BIM, I_CRE, I_CIM, I_S5D, I_GLUW, I_GLUB, I_RGW, I_RGB, I_REW, I_REB, I_MW1, I_MW3, I_MW2 };

DI Frame mkframe(LAS unsigned char* lds, int wv) {
    Frame F; int w_ = wv; asm volatile("" : "+s"(w_)); int t = (w_ << 6) | (int)__builtin_amdgcn_mbcnt_hi(~0u, __builtin_amdgcn_mbcnt_lo(~0u, 0u)); asm volatile("" : "+v"(t)); int g = gridDim.x, b = blockIdx.x; asm volatile("" : "+s"(g), "+s"(b));
    F.lds = lds; F.tid = t; F.lane = t & 63; F.wave = __builtin_amdgcn_readfirstlane(t >> 6); F.G = g; F.blk = b; return F;
}
DI float mod_val(KArgs A, int l, int b, int col) {
    const float* mp = (const float*)(A->ws + WS_MODP) + ((size_t)(l * KS_MOD) * 2 + b) * 12288 + col;
    float s = A->in[I_BADA][l * 12288 + col];
#pragma unroll
    for (int ks = 0; ks < KS_MOD; ++ks) s += mp[(size_t)ks * 2 * 12288];
    return s;
}
template <bool PARTIAL = false>
DI void stage_mod(KArgs A, LAS float* dst, int l, int which, float add, int tid) {
    const float* mf = (const float*)(A->ws + WS_MODF) + (size_t)l * 2 * 12288 + which * 2048;
    for (int i = tid; i < 2 * 2048; i += NT) { const int b = i >> 11, c = i & 2047; dst[i] = add + (PARTIAL ? mod_val(A, l, b, which * 2048 + c) : mf[b * 12288 + c]); }
}
DI void mod_finalize(KArgs A, const Frame& F, int l) {
    float* mf = (float*)(A->ws + WS_MODF) + (size_t)l * 2 * 12288;
    for (int i = F.blk * NT + F.tid; i < 2 * 12288; i += F.G * NT) { const int b = i / 12288, c = i % 12288; mf[i] = mod_val(A, l, b, c); }
}
constexpr int TSCR = 64 * 65 * 4;
DI void transpose_item(const float* W, int K, int N, bf16* WT, int k0, int n0, int drow0, LAS float* scr, int lane) {
    f32x4 r[16]; const int rs = lane >> 4, cj = 4 * (lane & 15);
#pragma unroll
    for (int i = 0; i < 16; ++i) r[i] = *(const GAS f32x4*)(W + (size_t)(k0 + 4 * i + rs) * N + n0 + cj);
#pragma unroll
    for (int i = 0; i < 16; ++i) { LAS float* d = scr + (4 * i + rs) * 65 + cj; d[0] = r[i].x; d[1] = r[i].y; d[2] = r[i].z; d[3] = r[i].w; }
    LDS_WAIT(); asm volatile("" ::: "memory");
    const int c = lane & 7;
#pragma unroll
    for (int j = 0; j < 8; ++j) { const int n = (lane >> 3) + 8 * j; const LAS float* q = scr + (8 * c) * 65 + n;
        v4u o; o.x = cvt_pk_bf16(q[0 * 65], q[1 * 65]); o.y = cvt_pk_bf16(q[2 * 65], q[3 * 65]); o.z = cvt_pk_bf16(q[4 * 65], q[5 * 65]); o.w = cvt_pk_bf16(q[6 * 65], q[7 * 65]);
        *(GAS v4u*)(WT + (size_t)(drow0 + n) * K + k0 + 8 * c) = o; }
    LDS_WAIT(); asm volatile("" ::: "memory");
}
DI void phase_wprep_a(KArgs A, const Frame& F, int l, int wid, int nw, int parts = 3) {
    LAS float* scr = (LAS float*)(F.lds + RING_OFF + F.wave * TSCR);
    const int gw = wid, NGW = nw;
    if (parts & 1) { const float* W = A->in[I_WIN] + (size_t)l * D * NIN; bf16* WT = (bf16*)(A->ws + ws_win(l));
      constexpr int NB = NIN / 64, ITEMS = (D / 64) * NB;
      for (int it = gw; it < ITEMS; it += NGW) { const int kb = it / NB, nb = it % NB; transpose_item(W, D, NIN, WT, 64 * kb, 64 * nb, 64 * nb, scr, F.lane); }
      for (int i = gw * 64 + F.lane; i < (NINP - NIN) * D / 8; i += NGW * 64) *(GAS v4u*)(WT + (size_t)NIN * D + (size_t)i * 8) = (v4u){0u, 0u, 0u, 0u};
    }
    if (!(parts & 2)) return;
    const int gt = wid * 64 + F.lane, NGT = nw * 64;
    { bf16* L0 = (bf16*)(A->ws + ws_lora(l)); bf16* L1 = L0 + 512 * 96; bf16* L2 = L1 + 512 * 96;
      const float* w2 = A->in[I_W2] + (size_t)l * 96 * 512; const float* a2 = A->in[I_A2] + (size_t)l * 96 * 512; const float* g2 = A->in[I_G2] + (size_t)l * 128 * 512;
      for (int i = gt; i < 512 * 96; i += NGT) { const int n = i / 96, k = i % 96; L0[i] = (bf16)(cvt_pk_bf16(w2[k * 512 + n], 0.f) & 0xffffu); L1[i] = (bf16)(cvt_pk_bf16(a2[k * 512 + n], 0.f) & 0xffffu); }
      for (int i = gt; i < 512 * 128; i += NGT) { const int n = i / 128, k = i % 128; L2[i] = (bf16)(cvt_pk_bf16(g2[k * 512 + n], 0.f) & 0xffffu); }
    }
    { unsigned char* sc = A->ws + ws_s5c(l);
      for (int i = gt; i < 32 * 64; i += NGT) { const int g = i >> 6;
          const float lr = A->in[I_LRE][l * 2048 + i], li = A->in[I_LIM][l * 2048 + i], dt = expf(A->in[I_LOGDT][l * 32 + g]);
          const float mag = expf(lr * dt), ar = mag * cosf(li * dt), ai = mag * sinf(li * dt);
          float pr = ar, pi = ai;
#pragma unroll
          for (int s = 0; s < 6; ++s) { const float nr = pr * pr - pi * pi, ni = 2.f * pr * pi; pr = nr; pi = ni; }
          ((f32x4*)(sc + S5C_LAM))[i] = (f32x4){ar, ai, pr, pi};
          const float den = lr * lr + li * li, zr = ((ar - 1.f) * lr + ai * li) / den, zi = (ai * lr - (ar - 1.f) * li) / den;
          float* bb = (float*)(sc + S5C_BB) + (size_t)i * 32;
          const float* brp = A->in[I_BRE] + ((size_t)l * 2048 + i) * 16; const float* bip = A->in[I_BIM] + ((size_t)l * 2048 + i) * 16;
          f32x4 brv[4], biv[4];
#pragma unroll
          for (int q = 0; q < 4; ++q) { brv[q] = *(const GAS f32x4*)(brp + 4 * q); biv[q] = *(const GAS f32x4*)(bip + 4 * q); }
          float bbv[32];
#pragma unroll
          for (int c = 0; c < 16; ++c) { const float br_ = brv[c >> 2][c & 3], bi_ = biv[c >> 2][c & 3]; bbv[c] = zr * br_ - zi * bi_; bbv[16 + c] = zr * bi_ + zi * br_; }
#pragma unroll
          for (int q = 0; q < 8; ++q) *(GAS f32x4*)(bb + 4 * q) = (f32x4){bbv[4 * q], bbv[4 * q + 1], bbv[4 * q + 2], bbv[4 * q + 3]};
          { f32x2* pw = (f32x2*)(A->ws + WS_MISC + MI_S5POW) + (size_t)i * 17; float qr = 1.f, qi = 0.f;
#pragma unroll 1
            for (int e = 0; e <= 16; ++e) { pw[e] = (f32x2){qr, qi}; const float nr = qr * ar - qi * ai, ni = qr * ai + qi * ar; qr = nr; qi = ni; } }
          { v2u* bfp = (v2u*)(A->ws + WS_MISC + MI_S5BBF); const int p = i & 63, nt = p >> 4, frl = p & 15;
#pragma unroll
            for (int ri = 0; ri < 2; ++ri)
#pragma unroll
                for (int q4 = 0; q4 < 4; ++q4) { const float* v = bbv + 16 * ri + 4 * q4;
                    const unsigned h0 = cvt_pk_bf16(v[0], v[1]), h1 = cvt_pk_bf16(v[2], v[3]);
                    const unsigned l0 = cvt_pk_bf16(v[0] - bf_lo(h0), v[1] - bf_hi(h0)), l1 = cvt_pk_bf16(v[2] - bf_lo(h1), v[3] - bf_hi(h1));
                    const size_t ix = ((size_t)((g * 4 + nt) * 2 + ri) * 2) * 64 + q4 * 16 + frl;
                    bfp[ix] = (v2u){h0, h1}; bfp[ix + 64] = (v2u){l0, l1}; } } }
      bf16* cp = (bf16*)(sc + S5C_CP);
      for (int i = gt; i < 32 * 16 * 128; i += NGT) { const int k = i & 127, gc = i >> 7, p = k >> 1;
          const float v = (k & 1) ? -A->in[I_CIM][((size_t)l * 512 + gc) * 64 + p] : A->in[I_CRE][((size_t)l * 512 + gc) * 64 + p];
          cp[i] = (bf16)(cvt_pk_bf16(v, 0.f) & 0xffffu); }
    }
    {
        constexpr int NCG = 12288 / 256, ITEMS = NCG * KS_MOD, ROWS = D / KS_MOD;
        for (int it = gw; it < ITEMS; it += NGW) {
            const int ll = l, r = it, cg = r / KS_MOD, ks = r % KS_MOD, col = cg * 256 + 4 * F.lane;
            const float* wp = A->in[I_WADA] + ((size_t)ll * D + ks * ROWS) * 12288 + col; const float* cv = A->in[I_C] + ks * ROWS;
            f32x4 a0 = {0.f, 0.f, 0.f, 0.f}, a1 = {0.f, 0.f, 0.f, 0.f};
            LAS float* sl = scr;
            static_assert(2 * ROWS * 4 <= TSCR, "silu table");
#pragma unroll
            for (int j = 0; j < 2 * ROWS / 64; ++j) { const int q = F.lane + 64 * j; sl[q] = siluf_(cv[(q / ROWS) * D + (q % ROWS)]); }
            LDS_WAIT(); asm volatile("" ::: "memory");
#pragma unroll 8
            for (int k = 0; k < ROWS; ++k) { const f32x4 w = *(const GAS f32x4*)(wp + (size_t)k * 12288); const float s0 = sl[k], s1 = sl[ROWS + k]; a0 += w * s0; a1 += w * s1; }
            LDS_WAIT(); asm volatile("" ::: "memory");
            float* mp = (float*)(A->ws + WS_MODP) + ((size_t)(ll * KS_MOD + ks) * 2) * 12288 + col;
            *(GAS f32x4*)mp = a0; *(GAS f32x4*)(mp + 12288) = a1;
        }
    }
}
DI void phase_wprep_b(KArgs A, const Frame& F, int l, int gw, int NGW) {
    LAS float* scr = (LAS float*)(F.lds + RING_OFF + F.wave * TSCR);
    constexpr int IT_O = (D / 64) * (D / 64), IT_G = (512 / 64) * (512 / 64), IT_13 = (D / 64) * (DEXP / 64), IT_2 = (DEXP / 64) * (D / 64);
    constexpr int TOTAL = IT_O + IT_G + NEXP * (2 * IT_13 + IT_2);
    for (int it = gw; it < TOTAL; it += NGW) {
        int r = it;
        if (r < IT_O) { const int nbk = D / 64, kb = r / nbk, nb = r % nbk; transpose_item(A->in[I_WOUT] + (size_t)l * D * D, D, D, (bf16*)(A->ws + WS_WOUT), 64 * kb, 64 * nb, 64 * nb, scr, F.lane); continue; } r -= IT_O;
        if (r < IT_G) { const int nbk = 512 / 64, kb = r / nbk, nb = r % nbk; transpose_item(A->in[I_GLUW] + (size_t)l * 512 * 512, 512, 512, (bf16*)(A->ws + WS_GLU), 64 * kb, 64 * nb, 64 * nb, scr, F.lane); continue; } r -= IT_G;
        const int e = r / (2 * IT_13 + IT_2); r %= (2 * IT_13 + IT_2);
        if (r < 2 * IT_13) { const int which = r / IT_13, rr = r % IT_13, nbk = DEXP / 64, kb = rr / nbk, nb = rr % nbk, n0 = 64 * nb;
            const float* W = A->in[which ? I_MW3 : I_MW1] + ((size_t)l * NEXP + e) * D * DEXP;
            const int drow0 = e * 1024 + (n0 >> 7) * 256 + which * 128 + (n0 & 127);
            transpose_item(W, D, DEXP, (bf16*)(A->ws + WS_W13), 64 * kb, n0, drow0, scr, F.lane); continue; }
        r -= 2 * IT_13;
        { const int nbk = D / 64, kb = r / nbk, nb = r % nbk; const float* W = A->in[I_MW2] + ((size_t)l * NEXP + e) * DEXP * D;
          transpose_item(W, DEXP, D, (bf16*)(A->ws + WS_W2), 64 * kb, 64 * nb, e * 2048 + 64 * nb, scr, F.lane); }
    }
    { bf16* hi = (bf16*)(A->ws + WS_ROUT); bf16* lo = hi + 48 * 2048;
      for (int i = gw * 64 + F.lane; i < 48 * 2048; i += NGW * 64) { const int j = i >> 11, k = i & 2047;
          float w = 0.f; if (j < 4) w = A->in[I_RGW][((size_t)l * D + k) * 4 + j]; else if (j < 36) w = A->in[I_REW][((size_t)l * D + k) * 32 + (j - 4)];
          const unsigned h = cvt_pk_bf16(w, 0.f) & 0xffffu; const float wl = w - bf_lo(h);
          hi[i] = (bf16)h; lo[i] = (bf16)(cvt_pk_bf16(wl, 0.f) & 0xffffu); } }
}

DI void row_stats(const f32x4 (&v)[8], float& mean, float& rstd) {
    float s = 0.f;
#pragma unroll
    for (int j = 0; j < 8; ++j) s += (v[j].x + v[j].y) + (v[j].z + v[j].w);
    mean = wave_sum(s) * (1.f / D); float s2 = 0.f;
#pragma unroll
    for (int j = 0; j < 8; ++j) { const f32x4 d = v[j] - mean; s2 += (d.x * d.x + d.y * d.y) + (d.z * d.z + d.w * d.w); }
    rstd = 1.f / sqrtf(wave_sum(s2) * (1.f / D) + LN_EPS);
}
DI void ada_store(const f32x4 (&v)[8], const LAS float* sc1p, const LAS float* sh, bf16* hrow, bf16* lorow, int lane) {
    float mean, rstd; row_stats(v, mean, rstd);
#pragma unroll
    for (int j = 0; j < 8; ++j) { const int c = 4 * (lane + 64 * j);
        const f32x4 a = *(const LAS f32x4*)(sc1p + c), b = *(const LAS f32x4*)(sh + c);
        const f32x4 h = (v[j] - mean) * rstd * a + b;
        v2u o; o.x = cvt_pk_bf16(h.x, h.y); o.y = cvt_pk_bf16(h.z, h.w);
        *(GAS v2u*)(hrow + c) = o;
        if (lorow) { v2u q; q.x = cvt_pk_bf16(h.x - bf_lo(o.x), h.y - bf_hi(o.x)); q.y = cvt_pk_bf16(h.z - bf_lo(o.y), h.w - bf_hi(o.y)); *(GAS v2u*)(lorow + c) = q; } }
}
DI void phase_ln_in(KArgs A, const Frame& F, int l) {
    LAS float* ms = (LAS float*)(F.lds + RING_OFF);
    stage_mod<true>(A, ms + 4096, l, 0, 0.f, F.tid); stage_mod<true>(A, ms, l, 1, 1.f, F.tid);
    mod_finalize(A, F, l);
    __syncthreads();
    const int gw = F.blk * NWAVES + F.wave, NGW = F.G * NWAVES;
    const float* x = A->in[I_X]; bf16* H = (bf16*)(A->ws + WS_H);
    for (int row0 = gw; row0 < T; row0 += 2 * NGW) { f32x4 v[2][8];
#pragma unroll
        for (int r = 0; r < 2; ++r) { const GAS f32x4* xr = (const GAS f32x4*)(x + (size_t)(row0 + r * NGW) * D) + F.lane;
#pragma unroll
            for (int j = 0; j < 8; ++j) v[r][j] = xr[64 * j]; }
#pragma unroll
        for (int r = 0; r < 2; ++r) { const int row = row0 + r * NGW, b = row >> 13; ada_store(v[r], ms + b * 2048, ms + 4096 + b * 2048, H + (size_t)row * D, nullptr, F.lane); } }
    __syncthreads();
}

struct EpiP {
    static constexpr bool PERM = true, AFTER_DRAIN = false;
    bf16* O; int ldc;
    DI void operator()(const f32x4 (&acc)[2][2][4][2], const pg8::Unit& u, int wr, int wc, int fr, int fq) const {
        const int row0 = u.pm * 256 + wr * 64 + fr, col0 = u.po * 256 + wc * 32 + 8 * fq;
#pragma unroll
        for (int ai = 0; ai < 2; ++ai)
#pragma unroll
            for (int m = 0; m < 4; ++m) { bf16* rowp = O + (size_t)(row0 + ai * 128 + m * 16) * ldc + col0;
#pragma unroll
                for (int bj = 0; bj < 2; ++bj) { const f32x4 v0 = acc[ai][bj][m][0], v1 = acc[ai][bj][m][1];
                    v4u w; w.x = cvt_pk_bf16(v0[0], v0[1]); w.y = cvt_pk_bf16(v0[2], v0[3]); w.z = cvt_pk_bf16(v1[0], v1[1]); w.w = cvt_pk_bf16(v1[2], v1[3]);
                    *(GAS v4u*)(rowp + bj * 128) = w; } }
    }
};
struct EpiGlu {
    static constexpr bool PERM = true, AFTER_DRAIN = false;
    const bf16* YS; bf16* O; const float* bias;
    DI void operator()(const f32x4 (&acc)[2][2][4][2], const pg8::Unit& u, int wr, int wc, int fr, int fq) const {
        const int row0 = u.pm * 256 + wr * 64 + fr, col0 = u.po * 256 + wc * 32 + 8 * fq;
        f32x4 bb[2][2];
#pragma unroll
        for (int bj = 0; bj < 2; ++bj) { bb[bj][0] = *(const GAS f32x4*)(bias + col0 + bj * 128); bb[bj][1] = *(const GAS f32x4*)(bias + col0 + bj * 128 + 4); }
#pragma unroll
        for (int ai = 0; ai < 2; ++ai) { v4u yv[4][2];
#pragma unroll
            for (int m = 0; m < 4; ++m)
#pragma unroll
                for (int bj = 0; bj < 2; ++bj) yv[m][bj] = *(const GAS v4u*)(YS + (size_t)(row0 + ai * 128 + m * 16) * 512 + col0 + bj * 128);
            __builtin_amdgcn_sched_barrier(0);
#pragma unroll
            for (int m = 0; m < 4; ++m) { const int row = row0 + ai * 128 + m * 16;
#pragma unroll
                for (int bj = 0; bj < 2; ++bj) { const int col = col0 + bj * 128;
                    const v4u y = yv[m][bj];
                    const f32x4 b0 = bb[bj][0], b1 = bb[bj][1];
                    const f32x4 v0 = acc[ai][bj][m][0] + b0, v1 = acc[ai][bj][m][1] + b1;
                    v4u w;
                    w.x = cvt_pk_bf16(bf_lo(y.x) * sigmoidf_(v0[0]), bf_hi(y.x) * sigmoidf_(v0[1]));
                    w.y = cvt_pk_bf16(bf_lo(y.y) * sigmoidf_(v0[2]), bf_hi(y.y) * sigmoidf_(v0[3]));
                    w.z = cvt_pk_bf16(bf_lo(y.z) * sigmoidf_(v1[0]), bf_hi(y.z) * sigmoidf_(v1[1]));
                    w.w = cvt_pk_bf16(bf_lo(y.w) * sigmoidf_(v1[2]), bf_hi(y.w) * sigmoidf_(v1[3]));
                    *(GAS v4u*)(O + (size_t)row * D + 1536 + col) = w; } }
            __builtin_amdgcn_sched_barrier(0); }
    }
};
struct EpiZ {
    static constexpr bool PERM = false, AFTER_DRAIN = false;
    const float* X; float* Z; const LAS float* g1p;
    DI void operator()(const f32x4 (&acc)[2][2][4][2], const pg8::Unit& u, int wr, int wc, int fr, int fq) const {
        const int row0 = u.pm * 256 + wr * 64 + fr, col0 = u.po * 256 + wc * 32 + 4 * fq; const int b = (u.pm * 256) >> 13;
        f32x4 gv[2][2];
#pragma unroll
        for (int bj = 0; bj < 2; ++bj)
#pragma unroll
            for (int n = 0; n < 2; ++n) gv[bj][n] = *(const LAS f32x4*)(g1p + b * 2048 + col0 + bj * 128 + n * 16);
#pragma unroll
        for (int ai = 0; ai < 2; ++ai) { f32x4 xv[4][2][2];
#pragma unroll
            for (int m = 0; m < 4; ++m) { const size_t ro = (size_t)(row0 + ai * 128 + m * 16) * D + col0;
#pragma unroll
                for (int bj = 0; bj < 2; ++bj)
#pragma unroll
                    for (int n = 0; n < 2; ++n) xv[m][bj][n] = *(const GAS f32x4*)(X + ro + bj * 128 + n * 16); }
            __builtin_amdgcn_sched_barrier(0);
#pragma unroll
            for (int m = 0; m < 4; ++m) { const size_t ro = (size_t)(row0 + ai * 128 + m * 16) * D + col0;
#pragma unroll
                for (int bj = 0; bj < 2; ++bj)
#pragma unroll
                    for (int n = 0; n < 2; ++n) *(GAS f32x4*)(Z + ro + bj * 128 + n * 16) = xv[m][bj][n] * ALPHA + gv[bj][n] * acc[ai][bj][m][n]; }
            __builtin_amdgcn_sched_barrier(0); }
    }
};
struct EpiMoeA {
    static constexpr bool PERM = true, AFTER_DRAIN = false;
    bf16* O;
    DI void operator()(const f32x4 (&acc)[2][2][4][2], const pg8::Unit& u, int wr, int wc, int fr, int fq) const {
        const int row0 = u.pm * 256 + wr * 64 + fr, col0 = u.po * 128 + wc * 32 + 8 * fq;
#pragma unroll
        for (int ai = 0; ai < 2; ++ai)
#pragma unroll
            for (int m = 0; m < 4; ++m) { const f32x4 a0 = acc[ai][0][m][0], a1 = acc[ai][0][m][1], b0 = acc[ai][1][m][0], b1 = acc[ai][1][m][1];
                v4u w; w.x = cvt_pk_bf16(siluf_(a0[0]) * b0[0], siluf_(a0[1]) * b0[1]); w.y = cvt_pk_bf16(siluf_(a0[2]) * b0[2], siluf_(a0[3]) * b0[3]);
                w.z = cvt_pk_bf16(siluf_(a1[0]) * b1[0], siluf_(a1[1]) * b1[1]); w.w = cvt_pk_bf16(siluf_(a1[2]) * b1[2], siluf_(a1[3]) * b1[3]);
                *(GAS v4u*)(O + (size_t)(row0 + ai * 128 + m * 16) * DEXP + col0) = w; }
    }
};
struct EpiMoeB {
    static constexpr bool PERM = true, AFTER_DRAIN = false;
    bf16* O; const float* roww;
    DI void operator()(const f32x4 (&acc)[2][2][4][2], const pg8::Unit& u, int wr, int wc, int fr, int fq) const {
        const int row0 = u.pm * 256 + wr * 64 + fr, col0 = u.po * 256 + wc * 32 + 8 * fq;
        float rws[2][4];
#pragma unroll
        for (int ai = 0; ai < 2; ++ai)
#pragma unroll
            for (int m = 0; m < 4; ++m) rws[ai][m] = roww[row0 + ai * 128 + m * 16];
        __builtin_amdgcn_sched_barrier(0);
#pragma unroll
        for (int ai = 0; ai < 2; ++ai)
#pragma unroll
            for (int m = 0; m < 4; ++m) { const int row = row0 + ai * 128 + m * 16; const float s = rws[ai][m]; bf16* rowp = O + (size_t)row * D + col0;
#pragma unroll
                for (int bj = 0; bj < 2; ++bj) { const f32x4 v0 = acc[ai][bj][m][0] * s, v1 = acc[ai][bj][m][1] * s;
                    v4u w; w.x = cvt_pk_bf16(v0[0], v0[1]); w.y = cvt_pk_bf16(v0[2], v0[3]); w.z = cvt_pk_bf16(v1[0], v1[1]); w.w = cvt_pk_bf16(v1[2], v1[3]);
                    *(GAS v4u*)(rowp + bj * 128) = w; } }
    }
};

DI void conv_part(KArgs A, const Frame& F, int l, int gw, int NGW) {
    const bf16* P = (const bf16*)(A->ws + WS_P); bf16* Y = (bf16*)(A->ws + WS_YCAT); const float* cw = A->in[I_CONVW] + (size_t)l * 3 * GW;
    for (int i = gw * 64 + F.lane; i < T * 64; i += NGW * 64) { const int t = i >> 6, c = (i & 63) * 8, ts = t & (SEQ - 1);
        const bf16* pr = P + (size_t)t * NINP + c;
        const bf16* pr1 = (ts >= 1) ? pr - NINP : pr; const bf16* pr2 = (ts >= 2) ? pr - 2 * NINP : pr;
        const v4u bg = *(const GAS v4u*)pr, c0 = *(const GAS v4u*)(pr + 512), h0 = *(const GAS v4u*)(pr + 1024);
        v4u c1 = *(const GAS v4u*)(pr1 + 512), h1 = *(const GAS v4u*)(pr1 + 1024), c2 = *(const GAS v4u*)(pr2 + 512), h2 = *(const GAS v4u*)(pr2 + 1024);
        if (ts < 1) { c1 = (v4u){0u, 0u, 0u, 0u}; h1 = c1; }
        if (ts < 2) { c2 = (v4u){0u, 0u, 0u, 0u}; h2 = c2; }
        const unsigned bgv[4] = {bg.x, bg.y, bg.z, bg.w}, c0v[4] = {c0.x, c0.y, c0.z, c0.w}, h0v[4] = {h0.x, h0.y, h0.z, h0.w}, c1v[4] = {c1.x, c1.y, c1.z, c1.w},
                       h1v[4] = {h1.x, h1.y, h1.z, h1.w}, c2v[4] = {c2.x, c2.y, c2.z, c2.w}, h2v[4] = {h2.x, h2.y, h2.z, h2.w};
        unsigned o[4];
#pragma unroll
        for (int k = 0; k < 4; ++k) {
            const float w0a = cw[c + 2 * k], w1a = cw[GW + c + 2 * k], w2a = cw[2 * GW + c + 2 * k], w0b = cw[c + 2 * k + 1], w1b = cw[GW + c + 2 * k + 1], w2b = cw[2 * GW + c + 2 * k + 1];
            const float ya = bf_lo(bgv[k]) * (w0a * bf_lo(c2v[k]) * bf_lo(h2v[k]) + w1a * bf_lo(c1v[k]) * bf_lo(h1v[k]) + w2a * bf_lo(c0v[k]) * bf_lo(h0v[k]));
            const float yb = bf_hi(bgv[k]) * (w0b * bf_hi(c2v[k]) * bf_hi(h2v[k]) + w1b * bf_hi(c1v[k]) * bf_hi(h1v[k]) + w2b * bf_hi(c0v[k]) * bf_hi(h0v[k]));
            o[k] = cvt_pk_bf16(ya, yb); }
        *(GAS v4u*)(Y + (size_t)t * D + c) = (v4u){o[0], o[1], o[2], o[3]}; }
}

constexpr int AK_PITCH = 144, AV_PITCH = 528;
constexpr int ATT_K_OFF = 0, ATT_V_OFF = 256 * AK_PITCH, ATT_B_OFF = ATT_V_OFF + 64 * AV_PITCH;
DI void attn_part(KArgs A, const Frame& F, int l, int blk0, int nblk, int item0, int item1) {
    const bf16* P = (const bf16*)(A->ws + WS_P); bf16* Y = (bf16*)(A->ws + WS_YCAT);
    LAS unsigned char* Ks = F.lds + RING_OFF + ATT_K_OFF; LAS unsigned char* Vs = F.lds + RING_OFF + ATT_V_OFF; LAS float* Bs = (LAS float*)(F.lds + RING_OFF + ATT_B_OFF);
    const int lane = F.lane, fr = lane & 15, fq = lane >> 4, w = F.wave;
    for (int item = item0 + (F.blk - blk0); item < item1; item += nblk) {
        const int b = item >> 7, g = (item >> 6) & 1, n = item & 63;
        const int tok0 = b * SEQ + 128 * (n - 1);
        float relb_v; { const int r = F.tid >> 7, rel = F.tid & 127;
          int bucket = rel; if (rel >= 16) { bucket = 16 + (int)(logf((float)rel * (1.f / 16.f)) / logf(8.f) * 16.f); bucket = bucket < 31 ? bucket : 31; }
          relb_v = A->in[I_RELB][bucket * 8 + 4 * g + r]; }
        const f32x4 sink4 = *(const GAS f32x4*)(A->in[I_SINKS] + l * 8 + 4 * g);
        for (int id = F.tid; id < 2048; id += NT) { const int key = id & 255, part = id >> 8; const bool ok = (n > 0) || (key >= 128);
            v4u kv = {0u, 0u, 0u, 0u}, vv = {0u, 0u, 0u, 0u};
            if (ok) { const bf16* src = P + (size_t)(tok0 + key) * NINP + ATT_OFF + 512 + 64 * g + 8 * part; kv = *(const GAS v4u*)src; vv = *(const GAS v4u*)(src + 128); }
            *(LAS v4u*)(Ks + key * AK_PITCH + 16 * part) = kv;
            LAS bf16* vd = (LAS bf16*)(Vs + (8 * part) * AV_PITCH) + key;
            vd[0 * (AV_PITCH / 2)] = (bf16)(vv.x & 0xffffu); vd[1 * (AV_PITCH / 2)] = (bf16)(vv.x >> 16); vd[2 * (AV_PITCH / 2)] = (bf16)(vv.y & 0xffffu); vd[3 * (AV_PITCH / 2)] = (bf16)(vv.y >> 16);
            vd[4 * (AV_PITCH / 2)] = (bf16)(vv.z & 0xffffu); vd[5 * (AV_PITCH / 2)] = (bf16)(vv.z >> 16); vd[6 * (AV_PITCH / 2)] = (bf16)(vv.w & 0xffffu); vd[7 * (AV_PITCH / 2)] = (bf16)(vv.w >> 16); }
        Bs[(F.tid >> 7) * 128 + (F.tid & 127)] = relb_v;
        __syncthreads();
        const int qi = 16 * w + fr, qtok = b * SEQ + 128 * n + qi;
        const bf16* qp0 = P + (size_t)qtok * NINP + ATT_OFF + 64 * (4 * g) + 8 * fq;
        v4u qn0 = *(const GAS v4u*)qp0, qn1 = *(const GAS v4u*)(qp0 + 32);
#pragma unroll 1
        for (int r = 0; r < 4; ++r) { const int h = 4 * g + r;
            const bf16x8 q0 = as_frag(qn0), q1 = as_frag(qn1);
            if (r < 3) { qn0 = *(const GAS v4u*)(qp0 + 64 * (r + 1)); qn1 = *(const GAS v4u*)(qp0 + 64 * (r + 1) + 32); }
            const float sink = (r == 0) ? sink4.x : (r == 1) ? sink4.y : (r == 2) ? sink4.z : sink4.w;
            f32x4 s[9]; float mx = sink;
#pragma unroll
            for (int kt = 0; kt < 9; ++kt) { const int nt = w + kt;
                const LAS unsigned char* kp = Ks + (16 * nt + fr) * AK_PITCH + 16 * fq;
                f32x4 acc = {0.f, 0.f, 0.f, 0.f};
                acc = MFMA16(as_frag(*(const LAS v4u*)kp), q0, acc); acc = MFMA16(as_frag(*(const LAS v4u*)(kp + 64)), q1, acc);
#pragma unroll
                for (int i = 0; i < 4; ++i) { const int j = 16 * nt + 4 * fq + i, rel = qi + 128 - j; const bool ok = (rel >= 0) && (rel < 128) && ((n > 0) || (j >= 128));
                    const float sc = ok ? acc[i] * 0.125f + Bs[r * 128 + (rel & 127)] : -1e30f; acc[i] = sc; mx = fmaxf(mx, sc); }
                s[kt] = acc; }
            mx = fmaxf(mx, __shfl_xor(mx, 16)); mx = fmaxf(mx, __shfl_xor(mx, 32));
            float den = 0.f;
#pragma unroll
            for (int kt = 0; kt < 9; ++kt)
#pragma unroll
                for (int i = 0; i < 4; ++i) { const float p = s[kt][i] > -1e29f ? __expf(s[kt][i] - mx) : 0.f; s[kt][i] = p; den += p; }
            den += __shfl_xor(den, 16); den += __shfl_xor(den, 32); den += __expf(sink - mx);
            const float inv = 1.f / den;
            f32x4 o[4];
#pragma unroll
            for (int dt = 0; dt < 4; ++dt) o[dt] = (f32x4){0.f, 0.f, 0.f, 0.f};
#pragma unroll
            for (int sp = 0; sp < 5; ++sp) { const int k0 = 2 * sp, k1 = 2 * sp + 1;
                v4u pf; pf.x = cvt_pk_bf16(s[k0][0], s[k0][1]); pf.y = cvt_pk_bf16(s[k0][2], s[k0][3]);
                if (k1 < 9) { pf.z = cvt_pk_bf16(s[k1 < 9 ? k1 : 8][0], s[k1 < 9 ? k1 : 8][1]); pf.w = cvt_pk_bf16(s[k1 < 9 ? k1 : 8][2], s[k1 < 9 ? k1 : 8][3]); } else { pf.z = 0u; pf.w = 0u; }
                int t0 = w + k0, t1 = w + k1; t1 = t1 < 16 ? t1 : 15;
#pragma unroll
                for (int dt = 0; dt < 4; ++dt) { const LAS unsigned char* vp = Vs + (16 * dt + fr) * AV_PITCH + 8 * fq;
                    const v2u va = *(const LAS v2u*)(vp + 32 * t0), vb = *(const LAS v2u*)(vp + 32 * t1);
                    o[dt] = MFMA16(as_frag((v4u){va.x, va.y, vb.x, vb.y}), as_frag(pf), o[dt]); } }
            bf16* op = Y + (size_t)qtok * D + 1024 + 64 * h + 4 * fq;
#pragma unroll
            for (int dt = 0; dt < 4; ++dt) { v2u ov; ov.x = cvt_pk_bf16(o[dt][0] * inv, o[dt][1] * inv); ov.y = cvt_pk_bf16(o[dt][2] * inv, o[dt][3] * inv); *(GAS v2u*)(op + 16 * dt) = ov; }
        }
        __syncthreads();
    }
}

DI void lerp8(const bf16* cur, const bf16* prv, bool has_prev, const float* mu, float (&o)[8]) {
    const v4u a = *(const GAS v4u*)cur; v4u b = {0u, 0u, 0u, 0u}; if (has_prev) b = *(const GAS v4u*)prv;
    const f32x4 m0 = *(const GAS f32x4*)mu, m1 = *(const GAS f32x4*)(mu + 4);
    const float av[8] = {bf_lo(a.x), bf_hi(a.x), bf_lo(a.y), bf_hi(a.y), bf_lo(a.z), bf_hi(a.z), bf_lo(a.w), bf_hi(a.w)};
    const float bv[8] = {bf_lo(b.x), bf_hi(b.x), bf_lo(b.y), bf_hi(b.y), bf_lo(b.z), bf_hi(b.z), bf_lo(b.w), bf_hi(b.w)};
    const float mv[8] = {m0.x, m0.y, m0.z, m0.w, m1.x, m1.y, m1.z, m1.w};
#pragma unroll
    for (int i = 0; i < 8; ++i) o[i] = av[i] + (bv[i] - av[i]) * mv[i];
}
DI void lerp4(const bf16* cur, const bf16* prv, bool has_prev, const float* mu, float (&o)[4]) {
    const v2u a = *(const GAS v2u*)cur; v2u b = {0u, 0u}; if (has_prev) b = *(const GAS v2u*)prv;
    const f32x4 m0 = *(const GAS f32x4*)mu;
    o[0] = bf_lo(a.x) + (bf_lo(b.x) - bf_lo(a.x)) * m0.x; o[1] = bf_hi(a.x) + (bf_hi(b.x) - bf_hi(a.x)) * m0.y;
    o[2] = bf_lo(a.y) + (bf_lo(b.y) - bf_lo(a.y)) * m0.z; o[3] = bf_hi(a.y) + (bf_hi(b.y) - bf_hi(a.y)) * m0.w;
}
constexpr size_t RWB = (size_t)T * GW;
constexpr int RP_L0 = 0, RP_L1 = 64 * 208, RP_L2 = 2 * 64 * 208, RP_PRM = RP_L2 + 64 * 272, RP_MUL = RP_PRM + 2048, RP_END = RP_MUL + 1280;
DI void rwkv_prep_part(KArgs A, const Frame& F, int l, int blk0, int nblk) {
    const bf16* P = (const bf16*)(A->ws + WS_P); float* RW = (float*)(A->ws + WS_RW); f32x4* SC = (f32x4*)(A->ws + WS_RWSC);
    const bf16* L0 = (const bf16*)(A->ws + ws_lora(l)); const bf16* L1 = L0 + 512 * 96; const bf16* L2 = L1 + 512 * 96;
    const float* mu = A->in[I_MU] + (size_t)l * RW_COLS;
    const int lane = F.lane, fr = lane & 15, fq = lane >> 4, h = (F.blk - blk0) & 7;
    LAS unsigned char* lb = F.lds + RING_OFF;
    for (int i = F.tid; i < 64 * 12; i += NT) { const int r = i / 12, p = i % 12;
        *(LAS v4u*)(lb + RP_L0 + r * 208 + 16 * p) = *(const GAS v4u*)(L0 + (size_t)(64 * h + r) * 96 + 8 * p); *(LAS v4u*)(lb + RP_L1 + r * 208 + 16 * p) = *(const GAS v4u*)(L1 + (size_t)(64 * h + r) * 96 + 8 * p); }
    for (int i = F.tid; i < 64 * 16; i += NT) { const int r = i >> 4, p = i & 15; *(LAS v4u*)(lb + RP_L2 + r * 272 + 16 * p) = *(const GAS v4u*)(L2 + (size_t)(64 * h + r) * 128 + 8 * p); }
    { LAS float* prm = (LAS float*)(lb + RP_PRM);
      if (F.tid < 64) { const int c = 64 * h + F.tid; prm[F.tid] = A->in[I_W0][l * GW + c]; prm[64 + F.tid] = A->in[I_A0][l * GW + c]; prm[128 + F.tid] = A->in[I_KK][l * GW + c]; prm[192 + F.tid] = A->in[I_KA][l * GW + c];
          prm[256 + F.tid] = A->in[I_RK][l * GW + c]; prm[320 + F.tid] = mu[c]; prm[384 + F.tid] = mu[512 + c]; prm[448 + F.tid] = mu[1024 + c]; }
      if (F.tid >= 128 && F.tid < 128 + 320) ((LAS float*)(lb + RP_MUL))[F.tid - 128] = mu[1536 + F.tid - 128]; }
    __syncthreads();
    const LAS float* prm = (const LAS float*)(lb + RP_PRM); const LAS float* mul = (const LAS float*)(lb + RP_MUL);
#pragma unroll 1
    for (int j = 0; j < 4; ++j) {
        const int tg = ((F.blk - blk0) >> 3) + 32 * (F.wave + 8 * j), t = tg * 16 + fr; const bool hp = (t & (SEQ - 1)) != 0;
        const bf16* pc = P + (size_t)t * NINP + RW_OFF; const bf16* pp = pc - NINP;
        v4u la[10], lp[10]; v2u xa[3][4], xb[3][4];
#pragma unroll
        for (int s2 = 0; s2 < 10; ++s2) { const int c = 1536 + 32 * s2 + 8 * fq; la[s2] = *(const GAS v4u*)(pc + c); lp[s2] = (v4u){0u, 0u, 0u, 0u}; if (hp) lp[s2] = *(const GAS v4u*)(pp + c); }
#pragma unroll
        for (int q = 0; q < 3; ++q)
#pragma unroll
            for (int nt = 0; nt < 4; ++nt) { const int c = 512 * q + 64 * h + 16 * nt + 4 * fq; xa[q][nt] = *(const GAS v2u*)(pc + c); xb[q][nt] = (v2u){0u, 0u}; if (hp) xb[q][nt] = *(const GAS v2u*)(pp + c); }
        bf16x8 fx[10];
#pragma unroll
        for (int s2 = 0; s2 < 10; ++s2) { const f32x4 m0 = *(const LAS f32x4*)(mul + 32 * s2 + 8 * fq), m1 = *(const LAS f32x4*)(mul + 32 * s2 + 8 * fq + 4);
            const v4u a = la[s2], b = lp[s2];
            float v[8] = {bf_lo(a.x), bf_hi(a.x), bf_lo(a.y), bf_hi(a.y), bf_lo(a.z), bf_hi(a.z), bf_lo(a.w), bf_hi(a.w)};
            const float bv[8] = {bf_lo(b.x), bf_hi(b.x), bf_lo(b.y), bf_hi(b.y), bf_lo(b.z), bf_hi(b.z), bf_lo(b.w), bf_hi(b.w)};
            const float mv[8] = {m0.x, m0.y, m0.z, m0.w, m1.x, m1.y, m1.z, m1.w};
#pragma unroll
            for (int i = 0; i < 8; ++i) { v[i] = v[i] + (bv[i] - v[i]) * mv[i]; if (s2 < 3) v[i] = tanhf_(v[i]); else if (s2 >= 6) v[i] = sigmoidf_(v[i]); }
            v4u o; o.x = cvt_pk_bf16(v[0], v[1]); o.y = cvt_pk_bf16(v[2], v[3]); o.z = cvt_pk_bf16(v[4], v[5]); o.w = cvt_pk_bf16(v[6], v[7]); fx[s2] = as_frag(o); }
        f32x4 r4[4], k4[4], v4[4];
#pragma unroll
        for (int nt = 0; nt < 4; ++nt) {
#define RP_LERP(dst_, q_) do { const f32x4 m_ = *(const LAS f32x4*)(prm + 320 + 64 * (q_) + 16 * nt + 4 * fq); const v2u a_ = xa[q_][nt], b_ = xb[q_][nt]; \
            dst_ = (f32x4){bf_lo(a_.x) + (bf_lo(b_.x) - bf_lo(a_.x)) * m_.x, bf_hi(a_.x) + (bf_hi(b_.x) - bf_hi(a_.x)) * m_.y, bf_lo(a_.y) + (bf_lo(b_.y) - bf_lo(a_.y)) * m_.z, bf_hi(a_.y) + (bf_hi(b_.y) - bf_hi(a_.y)) * m_.w}; } while (0)
            RP_LERP(r4[nt], 0); RP_LERP(k4[nt], 1); RP_LERP(v4[nt], 2);
#undef RP_LERP
        }
        float ss = 0.f;
#pragma unroll
        for (int nt = 0; nt < 4; ++nt) { const f32x4 kkw = *(const LAS f32x4*)(prm + 128 + 16 * nt + 4 * fq);
#pragma unroll
            for (int i = 0; i < 4; ++i) { const float kq = k4[nt][i] * kkw[i]; ss += kq * kq; } }
        ss += __shfl_xor(ss, 16); ss += __shfl_xor(ss, 32);
        const float inv = rcpf_(fmaxf(sqrtf(ss), 1e-12f));
        float br = 0.f, kr = 0.f, rkr = 0.f;
#pragma unroll
        for (int nt = 0; nt < 4; ++nt) { const int row = 16 * nt + fr;
            f32x4 aw = {0.f, 0.f, 0.f, 0.f}, ac = aw, ag = aw;
#pragma unroll
            for (int s2 = 0; s2 < 3; ++s2) { aw = MFMA16(as_frag(*(const LAS v4u*)(lb + RP_L0 + row * 208 + 64 * s2 + 16 * fq)), fx[s2], aw); ac = MFMA16(as_frag(*(const LAS v4u*)(lb + RP_L1 + row * 208 + 64 * s2 + 16 * fq)), fx[3 + s2], ac); }
#pragma unroll
            for (int s2 = 0; s2 < 4; ++s2) ag = MFMA16(as_frag(*(const LAS v4u*)(lb + RP_L2 + row * 272 + 64 * s2 + 16 * fq)), fx[6 + s2], ag);
            const int cl = 16 * nt + 4 * fq, c = 64 * h + cl;
            const f32x4 w0 = *(const LAS f32x4*)(prm + cl), a0 = *(const LAS f32x4*)(prm + 64 + cl), kkw = *(const LAS f32x4*)(prm + 128 + cl), kaw = *(const LAS f32x4*)(prm + 192 + cl), rkw = *(const LAS f32x4*)(prm + 256 + cl);
            f32x4 o_wr, o_kp, o_de, o_v, o_g, o_al, o_be;
#pragma unroll
            for (int i = 0; i < 4; ++i) {
                const float x = -(w0[i] + aw[i]);
                const float sp = (x > 20.f) ? x : __logf(1.f + __expf(x));
                const float wv = -sp - 0.5f, de = __expf(-__expf(wv));
                const float a = sigmoidf_(a0[i] + ac[i]);
                const float kn = k4[nt][i] * kkw[i] * inv, be = kn * a;
                const float kpv = k4[nt][i] * (1.f + (a - 1.f) * kaw[i]);
                o_al[i] = -kn; o_be[i] = be; o_de[i] = de; o_wr[i] = de * r4[nt][i]; o_kp[i] = kpv; o_v[i] = v4[nt][i]; o_g[i] = ag[i];
                br += be * r4[nt][i]; kr += kpv * r4[nt][i]; rkr += r4[nt][i] * kpv * rkw[i]; }
            const size_t o = (size_t)t * GW + c;
            *(GAS f32x4*)(RW + 1 * RWB + o) = o_de;
#define RW_ST16(k_, v_) *(GAS v2u*)((bf16*)(RW + (k_) * RWB) + o) = (v2u){cvt_pk_safe((v_)[0], (v_)[1]), cvt_pk_safe((v_)[2], (v_)[3])}
            RW_ST16(0, o_al); RW_ST16(2, o_wr); RW_ST16(3, o_kp); RW_ST16(4, o_be); RW_ST16(5, o_v); RW_ST16(6, o_g); }
#undef RW_ST16
        br += __shfl_xor(br, 16); br += __shfl_xor(br, 32); kr += __shfl_xor(kr, 16); kr += __shfl_xor(kr, 32); rkr += __shfl_xor(rkr, 16); rkr += __shfl_xor(rkr, 32);
        if (fq == 0) SC[(size_t)t * 8 + h] = (f32x4){br, kr, rkr, 0.f};
    }
    __syncthreads();
}

template <bool FINAL>
DI void s5_pass(KArgs A, const Frame& F, int l, int gw, int NGW) {
    const bf16* P = (const bf16*)(A->ws + WS_P); const unsigned char* sc = A->ws + ws_s5c(l);
    f32x2* E = (f32x2*)(A->ws + WS_S5E); const f32x2* X0 = (const f32x2*)(A->ws + WS_S5X); bf16* YS = (bf16*)(A->ws + WS_YS);
    const int lane = F.lane, fr = lane & 15, fq = lane >> 4;
    constexpr int XP = 272;
    LAS unsigned char* xs = F.lds + RING_OFF + F.wave * TSCR;
    static_assert(32 * XP <= TSCR, "S5 image");
    for (int item = gw; item < BATCH * 32 * 128; item += NGW) {
        const int b = item >> 12, g = (item >> 7) & 31, ch = item & 127, t0 = b * SEQ + 64 * ch;
        const f32x4 lam = ((const f32x4*)(sc + S5C_LAM))[g * 64 + lane];
        float bre[16], bim[16];
        { const f32x4* bp = (const f32x4*)((const float*)(sc + S5C_BB) + (size_t)(g * 64 + lane) * 32);
#pragma unroll
          for (int q = 0; q < 4; ++q) { const f32x4 a = bp[q], c = bp[4 + q]; bre[4 * q] = a.x; bre[4 * q + 1] = a.y; bre[4 * q + 2] = a.z; bre[4 * q + 3] = a.w; bim[4 * q] = c.x; bim[4 * q + 1] = c.y; bim[4 * q + 2] = c.z; bim[4 * q + 3] = c.w; } }
        const bf16* up = P + (size_t)(t0 + lane) * NINP + S5_OFF + 16 * g;
        const v4u u0 = *(const GAS v4u*)up, u1 = *(const GAS v4u*)(up + 8);
        const unsigned uw[8] = {u0.x, u0.y, u0.z, u0.w, u1.x, u1.y, u1.z, u1.w};
        float xr = 0.f, xi = 0.f;
        if (FINAL) { const f32x2 x0 = X0[(size_t)item * 64 + lane]; xr = x0.x; xi = x0.y; }
        bf16x8 cf[4];
        if (FINAL) {
#pragma unroll
            for (int s = 0; s < 4; ++s) cf[s] = as_frag(*(const GAS v4u*)((const bf16*)(sc + S5C_CP) + (size_t)(g * 16 + fr) * 128 + 32 * s + 8 * fq)); }
#pragma unroll 1
        for (int half = 0; half < 2; ++half) {
#pragma unroll 4
            for (int tt = 0; tt < 32; ++tt) { const int tl = half * 32 + tt;
                float br_ = 0.f, bi_ = 0.f;
#pragma unroll
                for (int k = 0; k < 8; ++k) { const unsigned uu = (unsigned)__builtin_amdgcn_readlane((int)uw[k], tl);
                    const float ua = bf_lo(uu), ub = bf_hi(uu);
                    br_ += bre[2 * k] * ua + bre[2 * k + 1] * ub; bi_ += bim[2 * k] * ua + bim[2 * k + 1] * ub; }
                const float nr = lam.x * xr - lam.y * xi + br_, ni = lam.x * xi + lam.y * xr + bi_; xr = nr; xi = ni;
                if (FINAL) *(LAS unsigned*)(xs + tt * XP + 4 * lane) = cvt_pk_bf16(xr, xi); }
            if (FINAL) {
                LDS_WAIT();
#pragma unroll
                for (int mt = 0; mt < 2; ++mt) { f32x4 acc = {0.f, 0.f, 0.f, 0.f};
#pragma unroll
                    for (int s = 0; s < 4; ++s) acc = MFMA16(cf[s], as_frag(*(const LAS v4u*)(xs + (16 * mt + fr) * XP + 64 * s + 16 * fq)), acc);
                    const int t = t0 + half * 32 + 16 * mt + fr, c = 16 * g + 4 * fq;
                    const v2u uq = *(const GAS v2u*)(P + (size_t)t * NINP + S5_OFF + c); const f32x4 dk = *(const GAS f32x4*)(A->in[I_S5D] + l * GW + c);
                    const float y0 = gelu_tanh(acc[0] + dk.x * bf_lo(uq.x)), y1 = gelu_tanh(acc[1] + dk.y * bf_hi(uq.x)), y2 = gelu_tanh(acc[2] + dk.z * bf_lo(uq.y)), y3 = gelu_tanh(acc[3] + dk.w * bf_hi(uq.y));
                    v2u o; o.x = cvt_pk_bf16(y0, y1); o.y = cvt_pk_bf16(y2, y3); *(GAS v2u*)(YS + (size_t)t * GW + c) = o; }
                LDS_WAIT();
            }
        }
        if (!FINAL) E[(size_t)item * 64 + lane] = (f32x2){xr, xi};
    }
}
typedef short bf16x4 __attribute__((ext_vector_type(4)));
DI void s5_pass1_mfma(KArgs A, const Frame& F, int l) {
    const bf16* P = (const bf16*)(A->ws + WS_P); f32x2* E = (f32x2*)(A->ws + WS_S5E);
    const f32x2* pw = (const f32x2*)(A->ws + WS_MISC + MI_S5POW); const v2u* bfp = (const v2u*)(A->ws + WS_MISC + MI_S5BBF);
    const int lane = F.lane, fr = lane & 15, fq = lane >> 4, gwv = F.blk * NWAVES + F.wave;
    if (gwv >= 2048) return;
    const int b = gwv >> 10, g = (gwv >> 5) & 31, cq = gwv & 31;
    const int t0 = b * SEQ + 256 * cq;
    bf16x4 uf[16];
#pragma unroll
    for (int tl = 0; tl < 16; ++tl) uf[tl] = __builtin_bit_cast(bf16x4, *(const GAS v2u*)(P + (size_t)(t0 + 16 * tl + fr) * NINP + S5_OFF + 16 * g + 4 * fq));
#pragma unroll 1
    for (int nt = 0; nt < 4; ++nt) {
        const f32x2* pp = pw + (size_t)(g * 64 + 16 * nt + fr) * 17;
        f32x2 w[4];
#pragma unroll
        for (int i = 0; i < 4; ++i) w[i] = pp[15 - 4 * fq - i];
        const f32x2 L16 = pp[16];
        bf16x4 bf[2][2];
#pragma unroll
        for (int ri = 0; ri < 2; ++ri)
#pragma unroll
            for (int hl = 0; hl < 2; ++hl) bf[ri][hl] = __builtin_bit_cast(bf16x4, bfp[((size_t)((g * 4 + nt) * 2 + ri) * 2 + hl) * 64 + lane]);
#pragma unroll
        for (int k = 0; k < 4; ++k) { float ar_ = 0.f, ai_ = 0.f;
#pragma unroll
            for (int tl = 0; tl < 4; ++tl) { f32x4 dr = {0.f, 0.f, 0.f, 0.f}, di = dr;
                dr = __builtin_amdgcn_mfma_f32_16x16x16bf16_1k(uf[4 * k + tl], bf[0][0], dr, 0, 0, 0); dr = __builtin_amdgcn_mfma_f32_16x16x16bf16_1k(uf[4 * k + tl], bf[0][1], dr, 0, 0, 0);
                di = __builtin_amdgcn_mfma_f32_16x16x16bf16_1k(uf[4 * k + tl], bf[1][0], di, 0, 0, 0); di = __builtin_amdgcn_mfma_f32_16x16x16bf16_1k(uf[4 * k + tl], bf[1][1], di, 0, 0, 0);
                float sr = ar_ * L16.x - ai_ * L16.y, si = ar_ * L16.y + ai_ * L16.x;
#pragma unroll
                for (int i = 0; i < 4; ++i) { sr += w[i].x * dr[i] - w[i].y * di[i]; si += w[i].x * di[i] + w[i].y * dr[i]; }
                ar_ = sr; ai_ = si; }
            ar_ += __shfl_xor(ar_, 16); ar_ += __shfl_xor(ar_, 32); ai_ += __shfl_xor(ai_, 16); ai_ += __shfl_xor(ai_, 32);
            const size_t item = ((size_t)(b * 32 + g) << 7) + 4 * cq + k;
            if (fq == 0) E[item * 64 + 16 * nt + fr] = (f32x2){ar_, ai_}; } }
}
DI void s5_carry(KArgs A, const Frame& F, int l, int blk0) {
    const int i = (F.blk - blk0) * NT + F.tid; if (i < 0 || i >= BATCH * 32 * 64) return;
    const int bg = i >> 6, p = i & 63, g = bg & 31;
    const f32x4 lam = ((const f32x4*)(A->ws + ws_s5c(l) + S5C_LAM))[g * 64 + p];
    const f32x2* E = (const f32x2*)(A->ws + WS_S5E) + (size_t)bg * 128 * 64 + p; f32x2* X0 = (f32x2*)(A->ws + WS_S5X) + (size_t)bg * 128 * 64 + p;
    float xr = 0.f, xi = 0.f;
#pragma unroll 1
    for (int c0 = 0; c0 < 128; c0 += 32) { f32x2 e[32];
#pragma unroll
        for (int k = 0; k < 32; ++k) e[k] = E[(size_t)(c0 + k) * 64];
#pragma unroll
        for (int k = 0; k < 32; ++k) { X0[(size_t)(c0 + k) * 64] = (f32x2){xr, xi}; const float nr = lam.z * xr - lam.w * xi + e[k].x, ni = lam.z * xi + lam.w * xr + e[k].y; xr = nr; xi = ni; } }
}

constexpr int SCH = 32;
constexpr int SB_VEC = 5 * SCH * 64 * 4, SB_V = SCH * 16 * 4, SB_SC = SCH * 8, SB_BYTES = SB_VEC + SB_V + SB_SC;
DI void rwkv_scan(KArgs A, const Frame& F, int blk_) {
    const int bh = blk_ >> 2, q = blk_ & 3, b = bh >> 3, h = bh & 7;
    const float* RW = (const float*)(A->ws + WS_RW); const f32x4* SC = (const f32x4*)(A->ws + WS_RWSC); float* Yo = (float*)(A->ws + WS_RW) + 7 * RWB;
    const int lane = F.lane, w = F.wave;
    const bool loader = (w >= 4); const int lt = F.tid - 256;
    const int rho = lane >> 4, kq = lane & 15;
    f32x2 sa = {0.f, 0.f}, sb = {0.f, 0.f};
    constexpr int NCH = SEQ / SCH;
#define SCAN_LOAD(c_) do { const size_t tb_ = (size_t)b * SEQ + (size_t)(c_) * SCH; \
        _Pragma("unroll") for (int i = 0; i < 4; ++i) { const int idx = lt + 256 * i, ai = idx >> 8, arr = ai + (ai > 0), rem = idx & 255, row = rem >> 3, c8 = rem & 7; \
            rvh[i] = *(const GAS v4u*)((const bf16*)(RW + (size_t)arr * RWB) + (tb_ + row) * GW + 64 * h + 8 * c8); } \
        _Pragma("unroll") for (int i = 0; i < 2; ++i) { const int idx = lt + 256 * i, row = idx >> 4, c4 = idx & 15; rvd[i] = *(const GAS f32x4*)(RW + 1 * RWB + (tb_ + row) * GW + 64 * h + 4 * c4); } \
        if (lt < 64) { const int row = lt >> 1, c8 = lt & 1; rvv = *(const GAS v4u*)((const bf16*)(RW + 5 * RWB) + (tb_ + row) * GW + 64 * h + 16 * q + 8 * c8); } \
        else if (lt >= 128 && lt < 128 + SCH) { rsc = SC[(tb_ + (lt - 128)) * 8 + h]; } } while (0)
#define SCAN_UNPK(d_, u_) do { *(LAS f32x4*)(d_) = (f32x4){bf_lo((u_).x), bf_hi((u_).x), bf_lo((u_).y), bf_hi((u_).y)}; *(LAS f32x4*)((d_) + 16) = (f32x4){bf_lo((u_).z), bf_hi((u_).z), bf_lo((u_).w), bf_hi((u_).w)}; } while (0)
#define SCAN_STORE(buf_) do { LAS unsigned char* base_ = F.lds + RING_OFF + (buf_) * SB_BYTES; \
        _Pragma("unroll") for (int i = 0; i < 4; ++i) { const int idx = lt + 256 * i, ai = idx >> 8, arr = ai + (ai > 0), rem = idx & 255, row = rem >> 3, c8 = rem & 7; \
            SCAN_UNPK(base_ + ((arr * SCH + row) * 64 + 8 * c8) * 4, rvh[i]); } \
        _Pragma("unroll") for (int i = 0; i < 2; ++i) { const int idx = lt + 256 * i; *(LAS f32x4*)(base_ + (1 * SCH * 64) * 4 + idx * 16) = rvd[i]; } \
        if (lt < 64) { SCAN_UNPK(base_ + SB_VEC + lt * 32, rvv); } \
        else if (lt >= 128 && lt < 128 + SCH) *(LAS f32x2*)(base_ + SB_VEC + SB_V + (lt - 128) * 8) = (f32x2){rsc.x, rsc.y}; } while (0)
#define SCAN_LD(P_, t_) do { const LAS unsigned char* p_ = base + (t_) * 256 + 16 * kq; \
        P_##al = *(const LAS f32x4*)(p_); P_##de = *(const LAS f32x4*)(p_ + 1 * SCH * 256); P_##wr = *(const LAS f32x4*)(p_ + 2 * SCH * 256); \
        P_##kp = *(const LAS f32x4*)(p_ + 3 * SCH * 256); P_##be = *(const LAS f32x4*)(p_ + 4 * SCH * 256); \
        P_##vt = *(const LAS float*)(base + SB_VEC + ((t_) * 16 + 4 * w + rho) * 4); P_##sc = *(const LAS f32x2*)(base + SB_VEC + SB_V + (t_) * 8); } while (0)
#define SCAN_STEP(P_, t_) do { \
        f32x2 pa2 = sa * (f32x2){P_##al.x, P_##al.y} + sb * (f32x2){P_##al.z, P_##al.w}, py2 = sa * (f32x2){P_##wr.x, P_##wr.y} + sb * (f32x2){P_##wr.z, P_##wr.w}; \
        float pa = allsum16(pa2.x + pa2.y), py = allsum16(py2.x + py2.y); \
        sa = sa * (f32x2){P_##de.x, P_##de.y} + (f32x2){P_##kp.x, P_##kp.y} * P_##vt + (f32x2){P_##be.x, P_##be.y} * pa; \
        sb = sb * (f32x2){P_##de.z, P_##de.w} + (f32x2){P_##kp.z, P_##kp.w} * P_##vt + (f32x2){P_##be.z, P_##be.w} * pa; \
        const float y_ = py + pa * P_##sc.x + P_##vt * P_##sc.y; ysel = (kq == ((t_) & 15)) ? y_ : ysel; } while (0)
    if (loader) { v4u rvh[4], rvv = {0u, 0u, 0u, 0u}; f32x4 rvd[2], rsc = {0.f, 0.f, 0.f, 0.f}; SCAN_LOAD(0); SCAN_STORE(0); }
    __syncthreads();
#pragma unroll 1
    for (int c = 0; c < NCH; ++c) {
        if (loader) {
            if (c + 1 < NCH) { v4u rvh[4], rvv = {0u, 0u, 0u, 0u}; f32x4 rvd[2], rsc = {0.f, 0.f, 0.f, 0.f}; SCAN_LOAD(c + 1); SCAN_STORE((c + 1) & 1); }
        } else {
            const LAS unsigned char* base = F.lds + RING_OFF + (c & 1) * SB_BYTES;
            const size_t tb = (size_t)b * SEQ + (size_t)c * SCH;
            float* yp = Yo + (tb + kq) * GW + 64 * h + 16 * q + 4 * w + rho;
            f32x4 A_al, A_de, A_wr, A_kp, A_be, B_al, B_de, B_wr, B_kp, B_be; float A_vt, B_vt; f32x2 A_sc, B_sc; float ysel = 0.f;
            SCAN_LD(A_, 0);
#pragma unroll
            for (int t = 0; t < SCH; t += 2) {
                SCAN_LD(B_, t + 1); __builtin_amdgcn_sched_barrier(0);
                SCAN_STEP(A_, t); __builtin_amdgcn_sched_barrier(0);
                if (t + 2 < SCH) SCAN_LD(A_, t + 2);
                __builtin_amdgcn_sched_barrier(0);
                SCAN_STEP(B_, t + 1); __builtin_amdgcn_sched_barrier(0);
                if ((t & 15) == 14) yp[(size_t)(t - 14) * GW] = ysel;
            }
        }
        __syncthreads();
    }
#undef SCAN_LD
#undef SCAN_STEP
}
#define CKEN 7
constexpr int S2WG = 32;
#define CK_SEL_MASK 0
#define CK_SEL_VAL 0
#ifndef CHUNK_Y_TO_Z
#define CHUNK_Y_TO_Z 0
#endif
constexpr int CK_BT = 0, CK_KT = 8192, CK_RT = 16384, CK_VT = 24576  , CK_WT = 32768  , CK_U0T = 40960  , CK_S0 = 49152  ,
              CK_MTH = 57344, CK_MTL = 65536  , CK_GT = 73728  ,
              CK_BTT = 90112  , CK_KTT = 98304  , CK_WTT = 106496  , CK_PC = 114688  , CK_STRIDE = 114944;
DI unsigned short bfbits(float x) { return (unsigned short)(cvt_pk_safe(x, 0.f) & 0xffffu); }
DI v4u ld16(const unsigned char* p) { return *(const GAS v4u*)p; }
DI v2u ld8(const unsigned char* p) { return *(const GAS v2u*)p; }
DI float ldfc(const float* p) { return *p; }
#define CK_SYNC() do { asm volatile("s_waitcnt vmcnt(0)" ::: "memory"); __builtin_amdgcn_fence(__ATOMIC_ACQUIRE, "agent"); asm volatile("s_waitcnt vmcnt(0)" ::: "memory"); } while (0)

DI void rwkv_chunk_stage1(KArgs A, const Frame& F, int item, LAS float* xs) {
    const int b = item >> 10, h = (item >> 7) & 7, c = item & 127, lane = F.lane, fr = lane & 15, fq = lane >> 4;
    const size_t t0 = (size_t)b * SEQ + 64 * c;
    const float* RW = (const float*)(A->ws + WS_RW);
    unsigned char* ck = A->ws + WS_CK + (size_t)item * CK_STRIDE;
    float* atf = (float*)(A->ws + WS_RW) + (size_t)(item >> 10) * 2 * RWB + RWB / 2 + (size_t)(item & 1023) * 4096;
    const float* dec = RW + 1 * RWB + t0 * GW + 64 * h + lane;
    const bf16* pal = (const bf16*)(RW + 0 * RWB) + t0 * GW + 64 * h + lane; const bf16* pwr = (const bf16*)(RW + 2 * RWB) + t0 * GW + 64 * h + lane;
    const bf16* pkp = (const bf16*)(RW + 3 * RWB) + t0 * GW + 64 * h + lane; const bf16* pbe = (const bf16*)(RW + 4 * RWB) + t0 * GW + 64 * h + lane;
    const bf16* pvv = (const bf16*)(RW + 5 * RWB) + t0 * GW + 64 * h + lane;
    unsigned btp[4], ktp[4];
    float P = 1.f;
    {
        unsigned short* oAT = (unsigned short*)(ck + CK_S0) + lane; unsigned short* oBT = (unsigned short*)(ck + CK_BT) + lane; unsigned short* oKT = (unsigned short*)(ck + CK_KT) + lane; unsigned short* oRT = (unsigned short*)(ck + CK_RT) + lane;
        float pb = 0.f, pk = 0.f;
#pragma unroll
        for (int t = 0; t < 64; ++t) {
            const float d = dec[(size_t)t * GW], al = bf1(pal[(size_t)t * GW]), wr = bf1(pwr[(size_t)t * GW]), kp = bf1(pkp[(size_t)t * GW]), be = bf1(pbe[(size_t)t * GW]);
            const float Pm = P; P *= d; const float Pi = 1.f / P;
            const float at = al * Pm, bt = be * Pi, kt = kp * Pi, rt = wr * Pm;
            atf[t * 64 + lane] = at;
            oAT[t * 64] = bfbits(at); oBT[t * 64] = bfbits(bt); oKT[t * 64] = bfbits(kt); oRT[t * 64] = bfbits(rt);
            if (t & 1) { btp[(t >> 1) & 3] = cvt_pk_safe(pb, bt); ktp[(t >> 1) & 3] = cvt_pk_safe(pk, kt);
                if ((t & 7) == 7) { *(GAS v4u*)(ck + CK_BTT + lane * 128 + 16 * (t >> 3)) = (v4u){btp[0], btp[1], btp[2], btp[3]}; *(GAS v4u*)(ck + CK_KTT + lane * 128 + 16 * (t >> 3)) = (v4u){ktp[0], ktp[1], ktp[2], ktp[3]}; } }
            else { pb = bt; pk = kt; }
            if ((t & 15) == 15) __builtin_amdgcn_sched_barrier(0);
        }
        *(GAS float*)((float*)(ck + CK_PC) + lane) = P;
    }
    __builtin_amdgcn_sched_barrier(0);
    {
#pragma unroll
        for (int q = 0; q < 8; ++q) { unsigned w[4];
#pragma unroll
            for (int e = 0; e < 4; ++e) w[e] = (unsigned)pvv[(size_t)(8 * q + 2 * e) * GW] | ((unsigned)pvv[(size_t)(8 * q + 2 * e + 1) * GW] << 16);
            *(GAS v4u*)(ck + CK_VT + lane * 128 + 16 * q) = (v4u){w[0], w[1], w[2], w[3]}; }
    }
    CK_SYNC();
#pragma unroll 1
    for (int tt = 0; tt < 4; ++tt) {
        const bf16x8 fa0 = as_frag(ld16(ck + CK_S0 + (16 * tt + fr) * 128 + 16 * fq)), fa1 = as_frag(ld16(ck + CK_S0 + (16 * tt + fr) * 128 + 64 + 16 * fq));
        f32x4 aak[4];
#pragma unroll
        for (int tj = 0; tj < 4; ++tj) { aak[tj] = (f32x4){0.f, 0.f, 0.f, 0.f};
            if (tj <= tt) {
                const unsigned char* rb = ck + CK_BT + (16 * tj + fr) * 128 + 16 * fq; const unsigned char* rk = ck + CK_KT + (16 * tj + fr) * 128 + 16 * fq;
                f32x4 dab = {0.f, 0.f, 0.f, 0.f}, dak = dab;
                dab = MFMA16(as_frag(ld16(rb)), fa0, dab); dab = MFMA16(as_frag(ld16(rb + 64)), fa1, dab);
                dak = MFMA16(as_frag(ld16(rk)), fa0, dak); dak = MFMA16(as_frag(ld16(rk + 64)), fa1, dak);
                if (tj == tt) {
#pragma unroll
                    for (int i = 0; i < 4; ++i) { const bool keep = (4 * fq + i) < fr; dab[i] = keep ? dab[i] : 0.f; dak[i] = keep ? dak[i] : 0.f; } }
                *(LAS f32x4*)(xs + (16 * tt + fr) * 64 + 16 * tj + 4 * fq) = dab;
                aak[tj] = dak; } }
        f32x4 ru[4] = {{0.f, 0.f, 0.f, 0.f}, {0.f, 0.f, 0.f, 0.f}, {0.f, 0.f, 0.f, 0.f}, {0.f, 0.f, 0.f, 0.f}};
#pragma unroll
        for (int s = 0; s < 2; ++s) { if (2 * s <= tt) {
            v4u pf; pf.x = cvt_pk_safe(aak[2 * s][0], aak[2 * s][1]); pf.y = cvt_pk_safe(aak[2 * s][2], aak[2 * s][3]); pf.z = cvt_pk_safe(aak[2 * s + 1][0], aak[2 * s + 1][1]); pf.w = cvt_pk_safe(aak[2 * s + 1][2], aak[2 * s + 1][3]);
#pragma unroll
            for (int tv = 0; tv < 4; ++tv) { const unsigned char* rv = ck + CK_VT + (16 * tv + fr) * 128 + 64 * s + 8 * fq; const v2u va = ld8(rv), vb = ld8(rv + 32);
                ru[tv] = MFMA16(as_frag((v4u){va.x, va.y, vb.x, vb.y}), as_frag(pf), ru[tv]); } } }
#pragma unroll
        for (int tv = 0; tv < 4; ++tv) *(GAS f32x4*)(ck + CK_MTH + ((16 * tt + fr) * 64 + 16 * tv + 4 * fq) * 4) = ru[tv];
    }
    CK_SYNC(); LDS_WAIT();
#define CK_SOLVE(x_) do { _Pragma("unroll") for (int t = 1; t < 64; ++t) { float acc_ = x_[t]; \
            _Pragma("unroll") for (int jb = 0; jb < t; jb += 4) { const f32x4 a4 = *(const LAS f32x4*)(xs + t * 64 + jb); \
                acc_ += a4.x * x_[jb]; if (jb + 1 < t) acc_ += a4.y * x_[jb + 1]; if (jb + 2 < t) acc_ += a4.z * x_[jb + 2]; if (jb + 3 < t) acc_ += a4.w * x_[jb + 3]; } \
            x_[t] = acc_; } } while (0)
    {
        float xw[64];
#pragma unroll
        for (int t = 0; t < 64; ++t) xw[t] = ldfc(atf + t * 64 + lane);
        CK_SOLVE(xw);
        unsigned short* oWT = (unsigned short*)(ck + CK_WT) + lane;
#pragma unroll
        for (int t = 0; t < 64; ++t) oWT[t * 64] = bfbits(xw[t]);
#pragma unroll
        for (int q = 0; q < 8; ++q) *(GAS v4u*)(ck + CK_WTT + lane * 128 + 16 * q) = (v4u){cvt_pk_safe(xw[8 * q], xw[8 * q + 1]), cvt_pk_safe(xw[8 * q + 2], xw[8 * q + 3]), cvt_pk_safe(xw[8 * q + 4], xw[8 * q + 5]), cvt_pk_safe(xw[8 * q + 6], xw[8 * q + 7])};
    }
    __builtin_amdgcn_sched_barrier(0);
    {
        float xu[64]; const float* ru = (const float*)(ck + CK_MTH) + lane;
#pragma unroll
        for (int t = 0; t < 64; ++t) xu[t] = ldfc(ru + t * 64);
        CK_SOLVE(xu);
#pragma unroll
        for (int q = 0; q < 8; ++q) *(GAS v4u*)(ck + CK_U0T + lane * 128 + 16 * q) = (v4u){cvt_pk_safe(xu[8 * q], xu[8 * q + 1]), cvt_pk_safe(xu[8 * q + 2], xu[8 * q + 3]), cvt_pk_safe(xu[8 * q + 4], xu[8 * q + 5]), cvt_pk_safe(xu[8 * q + 6], xu[8 * q + 7])};
    }
#undef CK_SOLVE
    CK_SYNC();
    const float* pc = (const float*)(ck + CK_PC);
#pragma unroll 1
    for (int t2 = 0; t2 < 4; ++t2) {
        const bf16x8 fb0 = as_frag(ld16(ck + CK_BTT + (16 * t2 + fr) * 128 + 16 * fq)), fb1 = as_frag(ld16(ck + CK_BTT + (16 * t2 + fr) * 128 + 64 + 16 * fq));
        const float pck = ldfc(pc + 16 * t2 + fr);
        unsigned hw[4][2];
#pragma unroll
        for (int t1 = 0; t1 < 4; ++t1) { const unsigned char* rw = ck + CK_WTT + (16 * t1 + fr) * 128 + 16 * fq;
            f32x4 d = {0.f, 0.f, 0.f, 0.f}; d = MFMA16(as_frag(ld16(rw)), fb0, d); d = MFMA16(as_frag(ld16(rw + 64)), fb1, d);
            float m[4];
#pragma unroll
            for (int i = 0; i < 4; ++i) { m[i] = (d[i] + ((t1 == t2 && 4 * fq + i == fr) ? 1.f : 0.f)) * pck; }
            hw[t1][0] = cvt_pk_safe(m[0], m[1]); hw[t1][1] = cvt_pk_safe(m[2], m[3]); }
#pragma unroll
        for (int sx = 0; sx < 2; ++sx) *(GAS v4u*)(ck + CK_MTH + ((t2 * 2 + sx) * 64 + lane) * 16) = (v4u){hw[2 * sx][0], hw[2 * sx][1], hw[2 * sx + 1][0], hw[2 * sx + 1][1]}; }
#pragma unroll 1
    for (int tv = 0; tv < 4; ++tv) {
        const unsigned char* ru = ck + CK_U0T + (16 * tv + fr) * 128 + 16 * fq; const unsigned char* rv = ck + CK_VT + (16 * tv + fr) * 128 + 16 * fq;
        const bf16x8 fu0 = as_frag(ld16(ru)), fu1 = as_frag(ld16(ru + 64)), fv0 = as_frag(ld16(rv)), fv1 = as_frag(ld16(rv + 64));
#pragma unroll
        for (int t2 = 0; t2 < 4; ++t2) { const unsigned char* rb = ck + CK_BTT + (16 * t2 + fr) * 128 + 16 * fq; const unsigned char* rk = ck + CK_KTT + (16 * t2 + fr) * 128 + 16 * fq;
            f32x4 d = {0.f, 0.f, 0.f, 0.f};
            d = MFMA16(as_frag(ld16(rb)), fu0, d); d = MFMA16(as_frag(ld16(rb + 64)), fu1, d); d = MFMA16(as_frag(ld16(rk)), fv0, d); d = MFMA16(as_frag(ld16(rk + 64)), fv1, d);
            const f32x4 pr = *(const GAS f32x4*)(pc + 16 * t2 + 4 * fq);
            *(GAS f32x4*)(ck + CK_GT + ((tv * 4 + t2) * 64 + lane) * 16) = d * pr; } }
}
DI void rwkv_chunk_stage2(KArgs A, const Frame& F, int bh, int vt) {
    const int lane = F.lane, fr = lane & 15, fq = lane >> 4;
    f32x4 acc[4] = {{0.f, 0.f, 0.f, 0.f}, {0.f, 0.f, 0.f, 0.f}, {0.f, 0.f, 0.f, 0.f}, {0.f, 0.f, 0.f, 0.f}};
    unsigned char* ck0 = A->ws + WS_CK + (size_t)(bh * 128) * CK_STRIDE;
    const unsigned voff = (unsigned)lane * 16u;
#define S2_GLD(d_, sb_, imm_) asm volatile("global_load_dwordx4 %0, %1, %2 offset:" #imm_ : "=&v"(d_) : "v"(voff), "s"(sb_) : "memory")
#define S2_LOAD(P_, c_) do { const unsigned char* ck_ = ck0 + (size_t)(c_) * CK_STRIDE; const unsigned char* sg = ck_ + CK_GT + vt * 4096; const unsigned char* sm0 = ck_ + CK_MTH; const unsigned char* sm1 = ck_ + CK_MTH + 4096; \
        S2_GLD(P_##g[0], sg, 0); S2_GLD(P_##g[1], sg, 1024); S2_GLD(P_##g[2], sg, 2048); S2_GLD(P_##g[3], sg, 3072); \
        S2_GLD(P_##m[0][0], sm0, 0); S2_GLD(P_##m[0][1], sm0, 1024); S2_GLD(P_##m[1][0], sm0, 2048); S2_GLD(P_##m[1][1], sm0, 3072); \
        S2_GLD(P_##m[2][0], sm1, 0); S2_GLD(P_##m[2][1], sm1, 1024); S2_GLD(P_##m[3][0], sm1, 2048); S2_GLD(P_##m[3][1], sm1, 3072); } while (0)
#define S2_WAIT(P_, N_) do { asm volatile("s_waitcnt vmcnt(" #N_ ")" : "+v"(P_##g[0]), "+v"(P_##g[1]), "+v"(P_##g[2]), "+v"(P_##g[3]), "+v"(P_##m[0][0]), "+v"(P_##m[0][1]), "+v"(P_##m[1][0]), "+v"(P_##m[1][1]), \
        "+v"(P_##m[2][0]), "+v"(P_##m[2][1]), "+v"(P_##m[3][0]), "+v"(P_##m[3][1]) :: "memory"); } while (0)
#define S2_STEP(P_, c_) do { unsigned char* ck_ = ck0 + (size_t)(c_) * CK_STRIDE; v4u sh[2]; \
        _Pragma("unroll") for (int s = 0; s < 2; ++s) { \
            const unsigned a0 = cvt_pk_safe(acc[2 * s][0], acc[2 * s][1]), a1 = cvt_pk_safe(acc[2 * s][2], acc[2 * s][3]), b0 = cvt_pk_safe(acc[2 * s + 1][0], acc[2 * s + 1][1]), b1 = cvt_pk_safe(acc[2 * s + 1][2], acc[2 * s + 1][3]); \
            sh[s] = (v4u){a0, a1, b0, b1}; \
            *(GAS v2u*)(ck_ + CK_S0 + (16 * vt + fr) * 128 + (32 * s + 4 * fq) * 2) = (v2u){a0, a1}; \
            *(GAS v2u*)(ck_ + CK_S0 + (16 * vt + fr) * 128 + (32 * s + 16 + 4 * fq) * 2) = (v2u){b0, b1}; } \
        _Pragma("unroll") for (int t2 = 0; t2 < 4; ++t2) { f32x4 d = P_##g[t2]; \
            d = MFMA16(as_frag(P_##m[t2][0]), as_frag(sh[0]), d); d = MFMA16(as_frag(P_##m[t2][1]), as_frag(sh[1]), d); acc[t2] = d; } } while (0)
    f32x4 Ag[4], Bg[4], Cg[4]; v4u Am[4][2], Bm[4][2], Cm[4][2];
    S2_LOAD(A, 0); S2_LOAD(B, 1); S2_LOAD(C, 2);
    S2_WAIT(A, 24); S2_STEP(A, 0); S2_LOAD(A, 3);
    S2_WAIT(B, 28); S2_STEP(B, 1); S2_LOAD(B, 4);
    S2_WAIT(C, 32); S2_STEP(C, 2); S2_LOAD(C, 5);
#pragma unroll 1
    for (int c = 3; c < 126; c += 3) {
        S2_WAIT(A, 32); S2_STEP(A, c); S2_LOAD(A, c + 3);
        S2_WAIT(B, 32); S2_STEP(B, c + 1); if (c + 4 < 128) S2_LOAD(B, c + 4);
        S2_WAIT(C, 32); S2_STEP(C, c + 2); if (c + 5 < 128) S2_LOAD(C, c + 5);
    }
    S2_WAIT(A, 0); S2_STEP(A, 126); S2_WAIT(B, 0); S2_STEP(B, 127);
#undef S2_GLD
#undef S2_LOAD
#undef S2_WAIT
#undef S2_STEP
}
DI void rwkv_chunk_stage3(KArgs A, const Frame& F, int item, int l) {
    const int b = item >> 10, h = (item >> 7) & 7, c = item & 127, lane = F.lane, fr = lane & 15, fq = lane >> 4;
    const size_t t0 = (size_t)b * SEQ + 64 * c;
    const unsigned char* ck = A->ws + WS_CK + (size_t)item * CK_STRIDE;
    const f32x4* SC = (const f32x4*)(A->ws + WS_RWSC); const bf16* Gt = (const bf16*)((const float*)(A->ws + WS_RW) + 6 * RWB) + t0 * GW + 64 * h; bf16* Yc = (bf16*)(A->ws + WS_YCAT) + t0 * D + 512 + 64 * h;
    float gng[4], gnb[4];
#pragma unroll
    for (int tv = 0; tv < 4; ++tv) { gng[tv] = A->in[I_GNG][l * GW + 64 * h + 16 * tv + fr]; gnb[tv] = A->in[I_GNB][l * GW + 64 * h + 16 * tv + fr]; }
    bf16x8 s0f[4][2], uf[4][2];
#pragma unroll
    for (int tv = 0; tv < 4; ++tv) { const unsigned char* rs = ck + CK_S0 + (16 * tv + fr) * 128 + 16 * fq; s0f[tv][0] = as_frag(ld16(rs)); s0f[tv][1] = as_frag(ld16(rs + 64)); }
#pragma unroll
    for (int tv = 0; tv < 4; ++tv) { f32x4 u[4];
#pragma unroll
        for (int tt = 0; tt < 4; ++tt) { const unsigned char* rw = ck + CK_WT + (16 * tt + fr) * 128 + 16 * fq;
            f32x4 d = {0.f, 0.f, 0.f, 0.f}; d = MFMA16(as_frag(ld16(rw)), s0f[tv][0], d); d = MFMA16(as_frag(ld16(rw + 64)), s0f[tv][1], d);
            const v2u u0 = ld8(ck + CK_U0T + (16 * tv + fr) * 128 + (16 * tt + 4 * fq) * 2);
            u[tt] = d + (f32x4){bf_lo(u0.x), bf_hi(u0.x), bf_lo(u0.y), bf_hi(u0.y)}; }
#pragma unroll
        for (int s = 0; s < 2; ++s) uf[tv][s] = as_frag((v4u){cvt_pk_safe(u[2 * s][0], u[2 * s][1]), cvt_pk_safe(u[2 * s][2], u[2 * s][3]), cvt_pk_safe(u[2 * s + 1][0], u[2 * s + 1][1]), cvt_pk_safe(u[2 * s + 1][2], u[2 * s + 1][3])}); }
#pragma unroll 1
    for (int tt = 0; tt < 4; ++tt) {
        const unsigned char* rr = ck + CK_RT + (16 * tt + fr) * 128 + 16 * fq; const bf16x8 fr0 = as_frag(ld16(rr)), fr1 = as_frag(ld16(rr + 64));
        float rk4[4]; unsigned short gq[4][4]; v2u vq[4];
#pragma unroll
        for (int i = 0; i < 4; ++i) rk4[i] = SC[(t0 + 16 * tt + 4 * fq + i) * 8 + h].z;
#pragma unroll
        for (int tv = 0; tv < 4; ++tv) { vq[tv] = ld8(ck + CK_VT + (16 * tv + fr) * 128 + (16 * tt + 4 * fq) * 2);
#pragma unroll
            for (int i = 0; i < 4; ++i) gq[tv][i] = Gt[(size_t)(16 * tt + 4 * fq + i) * GW + 16 * tv + fr]; }
        f32x4 arb[4], ark[4];
#pragma unroll
        for (int tj = 0; tj < 4; ++tj) { arb[tj] = (f32x4){0.f, 0.f, 0.f, 0.f}; ark[tj] = arb[tj];
            if (tj <= tt) { const unsigned char* rb = ck + CK_BT + (16 * tj + fr) * 128 + 16 * fq; const unsigned char* rk = ck + CK_KT + (16 * tj + fr) * 128 + 16 * fq;
                f32x4 db = {0.f, 0.f, 0.f, 0.f}, dk = db;
                db = MFMA16(as_frag(ld16(rb)), fr0, db); db = MFMA16(as_frag(ld16(rb + 64)), fr1, db); dk = MFMA16(as_frag(ld16(rk)), fr0, dk); dk = MFMA16(as_frag(ld16(rk + 64)), fr1, dk);
                if (tj == tt) {
#pragma unroll
                    for (int i = 0; i < 4; ++i) { const bool keep = (4 * fq + i) <= fr; db[i] = keep ? db[i] : 0.f; dk[i] = keep ? dk[i] : 0.f; } }
                arb[tj] = db; ark[tj] = dk; } }
        f32x4 y[4] = {{0.f, 0.f, 0.f, 0.f}, {0.f, 0.f, 0.f, 0.f}, {0.f, 0.f, 0.f, 0.f}, {0.f, 0.f, 0.f, 0.f}};
#pragma unroll
        for (int s = 0; s < 2; ++s) { if (2 * s <= tt) {
            const bf16x8 fb = as_frag((v4u){cvt_pk_safe(arb[2 * s][0], arb[2 * s][1]), cvt_pk_safe(arb[2 * s][2], arb[2 * s][3]), cvt_pk_safe(arb[2 * s + 1][0], arb[2 * s + 1][1]), cvt_pk_safe(arb[2 * s + 1][2], arb[2 * s + 1][3])});
            const bf16x8 fk = as_frag((v4u){cvt_pk_safe(ark[2 * s][0], ark[2 * s][1]), cvt_pk_safe(ark[2 * s][2], ark[2 * s][3]), cvt_pk_safe(ark[2 * s + 1][0], ark[2 * s + 1][1]), cvt_pk_safe(ark[2 * s + 1][2], ark[2 * s + 1][3])});
#pragma unroll
            for (int tv = 0; tv < 4; ++tv) { const unsigned char* rv = ck + CK_VT + (16 * tv + fr) * 128 + 64 * s + 8 * fq; const v2u va = ld8(rv), vb = ld8(rv + 32);
                y[tv] = MFMA16(fb, uf[tv][s], y[tv]); y[tv] = MFMA16(fk, as_frag((v4u){va.x, va.y, vb.x, vb.y}), y[tv]); } } }
#pragma unroll
        for (int tv = 0; tv < 4; ++tv) { y[tv] = MFMA16(fr0, s0f[tv][0], y[tv]); y[tv] = MFMA16(fr1, s0f[tv][1], y[tv]); }
#pragma unroll
        for (int i = 0; i < 4; ++i) {
            const float mean = allsum16((y[0][i] + y[1][i]) + (y[2][i] + y[3][i])) * (1.f / 64.f);
            const float d0 = y[0][i] - mean, d1 = y[1][i] - mean, d2 = y[2][i] - mean, d3 = y[3][i] - mean;
            const float rstd = 1.f / sqrtf(allsum16((d0 * d0 + d1 * d1) + (d2 * d2 + d3 * d3)) * (1.f / 64.f) + GN_EPS);
            const float dd[4] = {d0, d1, d2, d3};
#pragma unroll
            for (int tv = 0; tv < 4; ++tv) { const float vv = (i == 0) ? bf_lo(vq[tv].x) : (i == 1) ? bf_hi(vq[tv].x) : (i == 2) ? bf_lo(vq[tv].y) : bf_hi(vq[tv].y);
                const float r = (dd[tv] * rstd * gng[tv] + gnb[tv] + vv * rk4[i]) * bf1(gq[tv][i]);
                Yc[(size_t)(16 * tt + 4 * fq + i) * D + 16 * tv + fr] = bfbits(r); } }
    }
}

DI void rwkv_post_part(KArgs A, const Frame& F, int l, int blk0, int nblk) {
    const float* RW = (const float*)(A->ws + WS_RW); const f32x4* SC = (const f32x4*)(A->ws + WS_RWSC); bf16* Y = (bf16*)(A->ws + WS_YCAT);
    const int gw = (F.blk - blk0) * NWAVES + F.wave, NGW = nblk * NWAVES, c = 8 * F.lane, h = F.lane >> 3;
    const f32x4 g0 = *(const GAS f32x4*)(A->in[I_GNG] + l * GW + c), g1 = *(const GAS f32x4*)(A->in[I_GNG] + l * GW + c + 4), b0 = *(const GAS f32x4*)(A->in[I_GNB] + l * GW + c), b1 = *(const GAS f32x4*)(A->in[I_GNB] + l * GW + c + 4);
    for (int t = gw; t < T; t += NGW) { const size_t o = (size_t)t * GW + c;
        const float* ysrc = (CK_SEL_MASK && ((((t & (SEQ - 1)) >> 6) & CK_SEL_MASK) == CK_SEL_VAL)) ? (const float*)(A->ws + WS_Z) : RW + 7 * RWB;
        const f32x4 y0 = *(const GAS f32x4*)(ysrc + o), y1 = *(const GAS f32x4*)(ysrc + o + 4);
        const v4u vv8 = *(const GAS v4u*)((const bf16*)(RW + 5 * RWB) + o), gg8 = *(const GAS v4u*)((const bf16*)(RW + 6 * RWB) + o);
        const f32x4 v0 = {bf_lo(vv8.x), bf_hi(vv8.x), bf_lo(vv8.y), bf_hi(vv8.y)}, v1 = {bf_lo(vv8.z), bf_hi(vv8.z), bf_lo(vv8.w), bf_hi(vv8.w)},
                    q0 = {bf_lo(gg8.x), bf_hi(gg8.x), bf_lo(gg8.y), bf_hi(gg8.y)}, q1 = {bf_lo(gg8.z), bf_hi(gg8.z), bf_lo(gg8.w), bf_hi(gg8.w)};
        const float rkr = SC[(size_t)t * 8 + h].z;
        float s = (y0.x + y0.y) + (y0.z + y0.w) + (y1.x + y1.y) + (y1.z + y1.w);
        s += __shfl_xor(s, 1); s += __shfl_xor(s, 2); s += __shfl_xor(s, 4);
        const float mean = s * (1.f / 64.f); const f32x4 d0 = y0 - mean, d1 = y1 - mean;
        float s2 = (d0.x * d0.x + d0.y * d0.y) + (d0.z * d0.z + d0.w * d0.w) + (d1.x * d1.x + d1.y * d1.y) + (d1.z * d1.z + d1.w * d1.w);
        s2 += __shfl_xor(s2, 1); s2 += __shfl_xor(s2, 2); s2 += __shfl_xor(s2, 4);
        const float rstd = 1.f / sqrtf(s2 * (1.f / 64.f) + GN_EPS);
        const f32x4 r0 = (d0 * rstd * g0 + b0 + v0 * rkr) * q0, r1 = (d1 * rstd * g1 + b1 + v1 * rkr) * q1;
        v4u ov; ov.x = cvt_pk_bf16(r0.x, r0.y); ov.y = cvt_pk_bf16(r0.z, r0.w); ov.z = cvt_pk_bf16(r1.x, r1.y); ov.w = cvt_pk_bf16(r1.z, r1.w);
        *(GAS v4u*)(Y + (size_t)t * D + 512 + c) = ov; }
}

DI void phase_ln2(KArgs A, const Frame& F, int l) {
    if (l + 1 < DEPTH) mod_finalize(A, F, l + 1);
    LAS float* ms = (LAS float*)(F.lds + RING_OFF);
    stage_mod(A, ms + 4096, l, 3, 0.f, F.tid); stage_mod(A, ms, l, 4, 1.f, F.tid);
    for (int i = F.tid; i < D; i += NT) { ms[8192 + i] = A->in[I_LNG][(size_t)(l * 2 + 0) * D + i]; ms[8192 + D + i] = A->in[I_LNB][(size_t)(l * 2 + 0) * D + i]; }
    __syncthreads();
    const int gw = F.blk * NWAVES + F.wave, NGW = F.G * NWAVES;
    float* Z = (float*)(A->ws + WS_Z); bf16* H = (bf16*)(A->ws + WS_H);
    for (int row0 = gw; row0 < T; row0 += 2 * NGW) { f32x4 v[2][8];
#pragma unroll
        for (int r = 0; r < 2; ++r) { const GAS f32x4* zr = (const GAS f32x4*)(Z + (size_t)(row0 + r * NGW) * D) + F.lane;
#pragma unroll
            for (int j = 0; j < 8; ++j) v[r][j] = zr[64 * j]; }
#pragma unroll
        for (int r = 0; r < 2; ++r) { const int row = row0 + r * NGW, b = row >> 13;
            float mean, rstd; row_stats(v[r], mean, rstd);
            if (F.lane == 0) ((f32x2*)(A->ws + WS_MISC + MI_STATS))[row] = (f32x2){mean, rstd};
#pragma unroll
            for (int j = 0; j < 8; ++j) { const int c = 4 * (F.lane + 64 * j); v[r][j] = (v[r][j] - mean) * rstd * *(const LAS f32x4*)(ms + 8192 + c) + *(const LAS f32x4*)(ms + 8192 + D + c); }
            ada_store(v[r], ms + b * 2048, ms + 4096 + b * 2048, H + (size_t)row * D, nullptr, F.lane); } }
    __syncthreads();
}
DI void phase_router(KArgs A, const Frame& F, int l) {
    LAS int* cnt = (LAS int*)(F.lds + RING_OFF);
    LAS float* lg = (LAS float*)(F.lds + RING_OFF + 1024);
    constexpr int KC = 256, WP = KC * 2 + 16, WBUF = 96 * WP;
    LAS unsigned char* wb = F.lds + RING_OFF + 16384;
    static_assert(16384 + 2 * WBUF <= RING_BYTES, "router LDS");
    if (F.tid < 32) cnt[F.tid] = 0;
    const bf16* H = (const bf16*)(A->ws + WS_H);
    const bf16* W = (const bf16*)(A->ws + WS_ROUT);
    const int lane = F.lane, fr = lane & 15, fq = lane >> 4;
    const int t0 = (F.blk * 4 + (F.wave & 3)) * 16;
    const bf16* hp = H + (size_t)(t0 + fr) * D + 8 * fq;
    f32x4 acc[3] = {{0.f, 0.f, 0.f, 0.f}, {0.f, 0.f, 0.f, 0.f}, {0.f, 0.f, 0.f, 0.f}};
    v4u r[6], rn[6]; v4u xh[8], xn[8];
#pragma unroll
    for (int s2 = 0; s2 < 8; ++s2) { xh[s2] = (v4u){0u, 0u, 0u, 0u}; xn[s2] = xh[s2]; }
#define RT_LDW(dst_, kc_) do { _Pragma("unroll") for (int j = 0; j < 6; ++j) { const int p = F.tid + 512 * j; dst_[j] = *(const GAS v4u*)(W + (size_t)(p >> 5) * D + (kc_) * KC + 8 * (p & 31)); } } while (0)
#define RT_STW(buf_, src_) do { _Pragma("unroll") for (int j = 0; j < 6; ++j) { const int p = F.tid + 512 * j; *(LAS v4u*)(wb + (buf_) * WBUF + (p >> 5) * WP + 16 * (p & 31)) = src_[j]; } } while (0)
#define RT_LDH(dst_, kc_) do { _Pragma("unroll") for (int s2 = 0; s2 < 8; ++s2) dst_[s2] = *(const GAS v4u*)(hp + (kc_) * KC + 32 * s2); } while (0)
    RT_LDW(r, 0); if (F.wave < 4) RT_LDH(xh, 0);
    RT_STW(0, r);
    __syncthreads();
#pragma unroll 1
    for (int kc = 0; kc < D / KC; ++kc) {
        const bool more = (kc + 1 < D / KC);
        if (more) { RT_LDW(rn, kc + 1); if (F.wave < 4) RT_LDH(xn, kc + 1); }
        if (F.wave < 4) { const LAS unsigned char* bw = wb + (kc & 1) * WBUF;
#pragma unroll
            for (int s2 = 0; s2 < 8; ++s2)
#pragma unroll
                for (int nt = 0; nt < 3; ++nt) { const LAS unsigned char* q = bw + (16 * nt + fr) * WP + 64 * s2 + 16 * fq;
                    acc[nt] = MFMA16(as_frag(*(const LAS v4u*)q), as_frag(xh[s2]), acc[nt]); acc[nt] = MFMA16(as_frag(*(const LAS v4u*)(q + 48 * WP)), as_frag(xh[s2]), acc[nt]); } }
        if (more) RT_STW((kc + 1) & 1, rn);
        __syncthreads();
#pragma unroll
        for (int s2 = 0; s2 < 8; ++s2) xh[s2] = xn[s2];
    }
#undef RT_LDW
#undef RT_STW
#undef RT_LDH
    if (F.wave < 4) {
        LAS float* my = lg + F.wave * (16 * 48);
#pragma unroll
        for (int nt = 0; nt < 3; ++nt)
#pragma unroll
            for (int i = 0; i < 4; ++i) my[fr * 48 + 16 * nt + 4 * fq + i] = acc[nt][i];
        LDS_WAIT();
        if (lane < 16) { const int t = t0 + lane; const LAS float* q = my + lane * 48;
            float gl[4]; int gi = 0; float gm = -3.4e38f;
#pragma unroll
            for (int j = 0; j < 4; ++j) { gl[j] = q[j] + A->in[I_RGB][l * 4 + j]; if (gl[j] > gm) { gm = gl[j]; gi = j; } }
            float gs = 0.f;
#pragma unroll
            for (int j = 0; j < 4; ++j) gs += __expf(gl[j] - gm);
            const float gval = 1.f / gs;
            float e1 = -3.4e38f, e2 = -3.4e38f; int i1 = 0, i2 = 0;
            const f32x4 eb0 = *(const GAS f32x4*)(A->in[I_REB] + l * 32 + 8 * gi), eb1 = *(const GAS f32x4*)(A->in[I_REB] + l * 32 + 8 * gi + 4);
            const float ebv[8] = {eb0.x, eb0.y, eb0.z, eb0.w, eb1.x, eb1.y, eb1.z, eb1.w};
#pragma unroll
            for (int j = 0; j < 8; ++j) { const float v = q[4 + 8 * gi + j] + ebv[j];
                if (v > e1) { e2 = e1; i2 = i1; e1 = v; i1 = j; } else if (v > e2) { e2 = v; i2 = j; } }
            const float w2 = gval / (1.f + __expf(e1 - e2)), w1 = gval - w2;
            const int id1 = 8 * gi + i1, id2 = 8 * gi + i2;
            ((i32x2*)(A->ws + WS_MISC + MI_ROUTE_E))[t] = (i32x2){id1, id2};
            ((f32x2*)(A->ws + WS_MISC + MI_ROUTE_W))[t] = (f32x2){w1, w2};
            __hip_atomic_fetch_add(&cnt[id1], 1, __ATOMIC_RELAXED, __HIP_MEMORY_SCOPE_WORKGROUP); __hip_atomic_fetch_add(&cnt[id2], 1, __ATOMIC_RELAXED, __HIP_MEMORY_SCOPE_WORKGROUP); }
        LDS_WAIT();
    }
    __syncthreads();
    if (F.tid < 32) ((int*)(A->ws + WS_MISC + MI_COUNTS))[F.blk * 32 + F.tid] = cnt[F.tid];
    __syncthreads();
}
DI void phase_dispatch(KArgs A, const Frame& F) {
    LAS int* tot = (LAS int*)(F.lds + RING_OFF);
    LAS int* pre = tot + 32; LAS int* pst = tot + 64; LAS int* part = tot + 96; LAS int* ids = part + 16 * 64; LAS int* dst = ids + 128;
    const int* counts = (const int*)(A->ws + WS_MISC + MI_COUNTS);
    { const int e = F.tid & 31, pt = F.tid >> 5; int s = 0, sp = 0;
      int cv_[16];
#pragma unroll
      for (int k = 0; k < 16; ++k) cv_[k] = counts[(pt * 16 + k) * 32 + e];
#pragma unroll
      for (int k = 0; k < 16; ++k) { const int bb = pt * 16 + k; s += cv_[k]; sp += (bb < F.blk) ? cv_[k] : 0; }
      part[pt * 64 + e] = s; part[pt * 64 + 32 + e] = sp; }
    __syncthreads();
    if (F.tid < 32) { int s = 0, sp = 0; for (int k = 0; k < 16; ++k) { s += part[k * 64 + F.tid]; sp += part[k * 64 + 32 + F.tid]; } tot[F.tid] = s; pre[F.tid] = sp; }
    if (F.tid >= 64 && F.tid < 64 + 64) { const int tk = F.tid - 64; const i32x2 e = ((const i32x2*)(A->ws + WS_MISC + MI_ROUTE_E))[F.blk * 64 + tk]; ids[2 * tk] = e.x; ids[2 * tk + 1] = e.y; }
    __syncthreads();
    if (F.tid == 0) { int s = 0; for (int e = 0; e < 32; ++e) { pst[e] = s; s += (tot[e] + 255) & ~255; }
        if (F.blk == 0) { int* te = (int*)(A->ws + WS_MISC + MI_TILEE); int tl = 0; for (int e = 0; e < 32; ++e) { const int n = (tot[e] + 255) >> 8; for (int k = 0; k < n; ++k) te[tl++] = e; } te[MAXTILES] = tl; } }
    __syncthreads();
    if (F.tid < 32) { int run = pst[F.tid] + pre[F.tid]; for (int a = 0; a < 128; ++a) if (ids[a] == F.tid) dst[a] = run++; }
    __syncthreads();
    if (F.tid < 64) { const int t = F.blk * 64 + F.tid; ((i32x2*)(A->ws + WS_MISC + MI_DEST))[t] = (i32x2){dst[2 * F.tid], dst[2 * F.tid + 1]};
        const f32x2 w = ((const f32x2*)(A->ws + WS_MISC + MI_ROUTE_W))[t]; float* rw = (float*)(A->ws + WS_MISC + MI_ROWW); rw[dst[2 * F.tid]] = w.x; rw[dst[2 * F.tid + 1]] = w.y; }
    const bf16* H = (const bf16*)(A->ws + WS_H); bf16* XB = (bf16*)(A->ws + WS_XB);
    { const int c = (F.tid & 255) * 8, a0 = F.tid >> 8;
#pragma unroll 1
      for (int ab = 0; ab < 128; ab += 16) { v4u rv[8];
#pragma unroll
          for (int k = 0; k < 8; ++k) { const int a = ab + a0 + 2 * k; rv[k] = *(const GAS v4u*)(H + (size_t)(F.blk * 64 + (a >> 1)) * D + c); }
          __builtin_amdgcn_sched_barrier(0);
#pragma unroll
          for (int k = 0; k < 8; ++k) { const int a = ab + a0 + 2 * k; *(GAS v4u*)(XB + (size_t)dst[a] * D + c) = rv[k]; } } }
    __syncthreads();
}
DI void phase_ln3(KArgs A, const Frame& F, int l, float* xout) {
    LAS float* ms = (LAS float*)(F.lds + RING_OFF);
    const bool next = (l + 1 < DEPTH);
    stage_mod(A, ms, l, 5, 1.f, F.tid);
    if (next) { stage_mod(A, ms + 4096, l + 1, 1, 1.f, F.tid); stage_mod(A, ms + 8192, l + 1, 0, 0.f, F.tid); }
    for (int i = F.tid; i < D; i += NT) { ms[12288 + i] = A->in[I_LNG][(size_t)(l * 2 + 1) * D + i]; ms[12288 + D + i] = A->in[I_LNB][(size_t)(l * 2 + 1) * D + i];
        ms[16384 + i] = A->in[I_LNG][(size_t)(l * 2 + 0) * D + i]; ms[16384 + D + i] = A->in[I_LNB][(size_t)(l * 2 + 0) * D + i]; }
    __syncthreads();
    const int gw = F.blk * NWAVES + F.wave, NGW = F.G * NWAVES;
    const f32x2* stats = (const f32x2*)(A->ws + WS_MISC + MI_STATS);
    const float* Z = (const float*)(A->ws + WS_Z); const bf16* YR = (const bf16*)(A->ws + WS_YR); bf16* H = (bf16*)(A->ws + WS_H);
    const i32x2* dest = (const i32x2*)(A->ws + WS_MISC + MI_DEST);
    for (int row0 = gw; row0 < T; row0 += 2 * NGW) { f32x4 v[2][8];
        const i32x2 d0 = dest[row0], d1 = dest[row0 + NGW];
#pragma unroll
        for (int r = 0; r < 2; ++r) { const GAS f32x4* zr = (const GAS f32x4*)(Z + (size_t)(row0 + r * NGW) * D) + F.lane;
#pragma unroll
            for (int j = 0; j < 8; ++j) v[r][j] = zr[64 * j]; }
#pragma unroll
        for (int r = 0; r < 2; ++r) { const int row = row0 + r * NGW, b = row >> 13; const i32x2 d = r ? d1 : d0; const f32x2 st = stats[row];
            const GAS v2u* y0 = (const GAS v2u*)(YR + (size_t)d.x * D) + F.lane; const GAS v2u* y1 = (const GAS v2u*)(YR + (size_t)d.y * D) + F.lane;
            v2u ya[8], yb[8];
#pragma unroll
            for (int j = 0; j < 8; ++j) { ya[j] = y0[64 * j]; yb[j] = y1[64 * j]; }
            __builtin_amdgcn_sched_barrier(0);
#pragma unroll
            for (int j = 0; j < 8; ++j) { const int c = 4 * (F.lane + 64 * j); const v2u a = ya[j], q = yb[j]; const f32x4 gt = *(const LAS f32x4*)(ms + b * 2048 + c);
                const f32x4 ym = {bf_lo(a.x) + bf_lo(q.x), bf_hi(a.x) + bf_hi(q.x), bf_lo(a.y) + bf_lo(q.y), bf_hi(a.y) + bf_hi(q.y)};
                const f32x4 x1 = (v[r][j] - st.x) * st.y * *(const LAS f32x4*)(ms + 16384 + c) + *(const LAS f32x4*)(ms + 16384 + D + c);
                v[r][j] = x1 * ALPHA + gt * ym; }
            float mean, rstd; row_stats(v[r], mean, rstd);
            GAS f32x4* xo = (GAS f32x4*)(xout + (size_t)row * D) + F.lane;
#pragma unroll
            for (int j = 0; j < 8; ++j) { const int c = 4 * (F.lane + 64 * j); v[r][j] = (v[r][j] - mean) * rstd * *(const LAS f32x4*)(ms + 12288 + c) + *(const LAS f32x4*)(ms + 12288 + D + c); xo[64 * j] = v[r][j]; }
            if (next) ada_store(v[r], ms + 4096 + b * 2048, ms + 8192 + b * 2048, H + (size_t)row * D, nullptr, F.lane);
            __builtin_amdgcn_sched_barrier(0); } }
    __syncthreads();
}

constexpr int NPH = 15;
#ifdef ONLY_PHASE
#define IN(k) ((((k) % NPH) == ONLY_PHASE) && lo <= (k) && (k) < hi)
#else
#define IN(k) (lo <= (k) && (k) < hi)
#endif
#ifndef REPMASK
#define REPMASK 0
#endif
#ifndef BARREP
#define BARREP 1
#endif
#define REP4A 1
#define REP4B 1
#define REP_S2 1
#define REP_PREP 1
#define REP_S5A 1
#define REP_S5C 1
#define REP_CONV 1
#define REP_ATT 1
#define REP_ST1 1
#define NREP(k) (1 + ((REPMASK >> (k)) & 1))
#define SEAM(k) do { if (IN(k) && IN((k) + 1)) { for (int br_ = 0; br_ < BARREP; ++br_) xcd_barrier(bar); } } while (0)
template <int l> DI void run_layer(KArgs A0, LAS unsigned char* lds, const XcdBarrier& bar, const int lo, const int hi, const int wv) {
    KArgs A = A0; Frame F;
    {
        constexpr int p0 = l * NPH;

        for (int rep_ = 0; rep_ < NREP(0); ++rep_) { A = launder(A0); F = mkframe(lds, wv); if (IN(p0 + 0) && l == 0) phase_wprep_a(A, F, l, F.blk * NWAVES + F.wave, F.G * NWAVES);
        if (NREP(0) > 1) __syncthreads(); } if (l == 0) SEAM(p0 + 0);
        for (int rep_ = 0; rep_ < NREP(1); ++rep_) { A = launder(A0); F = mkframe(lds, wv); if (IN(p0 + 1) && l == 0) phase_ln_in(A, F, l);
        if (NREP(1) > 1) __syncthreads(); } if (l == 0) SEAM(p0 + 1);
        for (int rep_ = 0; rep_ < NREP(2); ++rep_) { A = launder(A0); F = mkframe(lds, wv); if (IN(p0 + 2)) { pg8::Gemm g{(const bf16*)(A->ws + WS_H), (const bf16*)(A->ws + ws_win(l)), D}; pg8::StaticOrder S; S.init(T, NINP, F.G, F.blk);
            EpiP E{(bf16*)(A->ws + WS_P), NINP}; pg8::gemm_phase<EpiP, pg8::StaticOrder, true, true>(F.lds + RING_OFF, g, S, E, F.wave); }
        if (NREP(2) > 1) __syncthreads(); } SEAM(p0 + 2);
        for (int rep_ = 0; rep_ < NREP(3); ++rep_) { A = launder(A0); F = mkframe(lds, wv); if (IN(p0 + 3)) { for (int q_ = 0; q_ < REP_S5A; ++q_) s5_pass1_mfma(A, F, l); for (int q_ = 0; q_ < REP_PREP; ++q_) rwkv_prep_part(A, F, l, 0, F.G); }
        if (NREP(3) > 1) __syncthreads(); } SEAM(p0 + 3);
        for (int rep_ = 0; rep_ < NREP(4); ++rep_) { A = launder(A0); F = mkframe(lds, wv); if (IN(p0 + 4)) {
            if (F.blk < 8) s5_carry(A, F, l, 0);
            for (int q_ = 0; q_ < REP_ATT; ++q_) attn_part(A, F, l, 0, F.G, 0, 256);
            __syncthreads();
            { const int item = F.blk * NWAVES + F.wave; for (int q_ = 0; q_ < REP_ST1; ++q_) if (CKEN & 1) if (item < 2048) rwkv_chunk_stage1(A, F, item, (LAS float*)(F.lds + RING_OFF + F.wave * 16384)); } }
        if (NREP(4) > 1) __syncthreads(); } SEAM(p0 + 4);
        for (int rep_ = 0; rep_ < NREP(5); ++rep_) { A = launder(A0); F = mkframe(lds, wv); if (IN(p0 + 5)) {
            if (F.blk < S2WG) { for (int r2_ = 0; r2_ < REP_S2; ++r2_) if (F.wave < 2) rwkv_chunk_stage2(A, F, F.blk >> 1, 2 * (F.blk & 1) + F.wave); }
            else if (CHUNK_Y_TO_Z && F.blk < 72) rwkv_scan(A, F, F.blk - 8);
            else { constexpr int B0 = S2WG; const int nb = F.G - B0;
                if (F.wave < 4) { const int cw = (F.blk - B0) * 4 + F.wave, NCW = nb * 4;
                    for (int q_ = 0; q_ < REP_S5C; ++q_) s5_pass<true>(A, F, l, cw, NCW); for (int q_ = 0; q_ < REP_CONV; ++q_) conv_part(A, F, l, cw, NCW);
                    if (l + 1 < DEPTH) phase_wprep_a(A, F, l + 1, cw, NCW, 2); }
                else { const int mw = (F.blk - B0) * 4 + F.wave - 4, NMW = nb * 4;
                    for (int r4_ = 0; r4_ < REP4B; ++r4_) phase_wprep_b(A, F, l, mw, NMW);
                    if (l + 1 < DEPTH) phase_wprep_a(A, F, l + 1, mw, NMW, 1); } } }
        if (NREP(5) > 1) __syncthreads(); } SEAM(p0 + 5);
        for (int rep_ = 0; rep_ < NREP(6); ++rep_) { A = launder(A0); F = mkframe(lds, wv); if (IN(p0 + 6)) {
            const int item = F.blk * NWAVES + F.wave; if (item < 2048) rwkv_chunk_stage3(A, F, item, l); }
        if (NREP(6) > 1) __syncthreads(); } SEAM(p0 + 6);
        for (int rep_ = 0; rep_ < NREP(7); ++rep_) { A = launder(A0); F = mkframe(lds, wv); if (IN(p0 + 7)) {
            constexpr int GLUWG = 128;
            if (F.blk < GLUWG) { pg8::Gemm g{(const bf16*)(A->ws + WS_YS), (const bf16*)(A->ws + WS_GLU), 512}; pg8::StaticOrder S; S.init(T, 512, GLUWG, F.blk);
                EpiGlu E{(const bf16*)(A->ws + WS_YS), (bf16*)(A->ws + WS_YCAT), A->in[I_GLUB] + l * GW}; pg8::gemm_phase<EpiGlu, pg8::StaticOrder, true, true>(F.lds + RING_OFF, g, S, E, F.wave); } }
        if (NREP(7) > 1) __syncthreads(); } SEAM(p0 + 7);
        for (int rep_ = 0; rep_ < NREP(8); ++rep_) { A = launder(A0); F = mkframe(lds, wv); if (IN(p0 + 8)) { LAS float* g1p = (LAS float*)(F.lds + XTRA_OFF); stage_mod(A, g1p, l, 2, 1.f, F.tid); __syncthreads();
            pg8::Gemm g{(const bf16*)(A->ws + WS_YCAT), (const bf16*)(A->ws + WS_WOUT), D}; pg8::StaticOrder S; S.init(T, D, F.G, F.blk);
            const float* xin = (l == 0) ? A->in[I_X] : (const float*)A->out; EpiZ E{xin, (float*)(A->ws + WS_Z), g1p}; pg8::gemm_phase<EpiZ, pg8::StaticOrder, true, true>(F.lds + RING_OFF, g, S, E, F.wave); }
        if (NREP(8) > 1) __syncthreads(); } SEAM(p0 + 8);
        for (int rep_ = 0; rep_ < NREP(9); ++rep_) { A = launder(A0); F = mkframe(lds, wv); if (IN(p0 + 9)) phase_ln2(A, F, l);
        if (NREP(9) > 1) __syncthreads(); } SEAM(p0 + 9);
        for (int rep_ = 0; rep_ < NREP(10); ++rep_) { A = launder(A0); F = mkframe(lds, wv); if (IN(p0 + 10)) phase_router(A, F, l);
        if (NREP(10) > 1) __syncthreads(); } SEAM(p0 + 10);
        for (int rep_ = 0; rep_ < NREP(11); ++rep_) { A = launder(A0); F = mkframe(lds, wv); if (IN(p0 + 11)) phase_dispatch(A, F);
        if (NREP(11) > 1) __syncthreads(); } SEAM(p0 + 11);
        for (int rep_ = 0; rep_ < NREP(12); ++rep_) { A = launder(A0); F = mkframe(lds, wv); if (IN(p0 + 12)) { const int* te = (const int*)(A->ws + WS_MISC + MI_TILEE); pg8::Gemm g{(const bf16*)(A->ws + WS_XB), (const bf16*)(A->ws + WS_W13), D};
            pg8::GroupedOrder S{te[MAXTILES], 4, F.G, F.blk, te}; EpiMoeA E{(bf16*)(A->ws + WS_HMID)}; pg8::gemm_phase<EpiMoeA, pg8::GroupedOrder, true, true>(F.lds + RING_OFF, g, S, E, F.wave); }
        if (NREP(12) > 1) __syncthreads(); } SEAM(p0 + 12);
        for (int rep_ = 0; rep_ < NREP(13); ++rep_) { A = launder(A0); F = mkframe(lds, wv); if (IN(p0 + 13)) { const int* te = (const int*)(A->ws + WS_MISC + MI_TILEE); pg8::Gemm g{(const bf16*)(A->ws + WS_HMID), (const bf16*)(A->ws + WS_W2), DEXP};
            pg8::GroupedOrder S{te[MAXTILES], 8, F.G, F.blk, te}; EpiMoeB E{(bf16*)(A->ws + WS_YR), (const float*)(A->ws + WS_MISC + MI_ROWW)}; pg8::gemm_phase<EpiMoeB, pg8::GroupedOrder, true, true>(F.lds + RING_OFF, g, S, E, F.wave); }
        if (NREP(13) > 1) __syncthreads(); } SEAM(p0 + 13);
        for (int rep_ = 0; rep_ < NREP(14); ++rep_) { A = launder(A0); F = mkframe(lds, wv); if (IN(p0 + 14)) phase_ln3(A, F, l, A->out);
        if (NREP(14) > 1) __syncthreads(); } SEAM(p0 + 14);
    }
}
__global__ void __launch_bounds__(NT, 2) hybrid_fwd(Args Aval) {
    KArgs A0 = (KArgs)__builtin_amdgcn_kernarg_segment_ptr(); KArgs A = A0;
    extern __shared__ __attribute__((aligned(16))) unsigned char lds[];
    Frame F;
    F.lds = (LAS unsigned char*)lds;
    F.tid = threadIdx.x; F.lane = F.tid & 63; F.wave = __builtin_amdgcn_readfirstlane(F.tid >> 6);
    F.G = gridDim.x; F.blk = blockIdx.x;
    volatile LAS unsigned* MISC = (volatile LAS unsigned*)(F.lds + MISC_OFF);
    for (int u = F.tid; u < 1024 / 4; u += NT) ((LAS unsigned*)(F.lds + LDSCTL_OFF))[u] = 0u;
    __syncthreads();
    XcdBarrier bar = xcd_barrier_post((unsigned*)(A->ws + WS_CTL) + CW_BAR, MISC + 8);
    const int lo = A->ph_lo, hi = A->ph_hi;
    asm volatile("s_nop 0\n\ts_nop 0\n\ts_nop 0\n\ts_nop 0");
    const int wv = F.wave;
    run_layer<0>(A0, (LAS unsigned char*)lds, bar, lo, hi, wv);
    run_layer<1>(A0, (LAS unsigned char*)lds, bar, lo, hi, wv);
}

#ifndef N_LAUNCH_MODE
#define N_LAUNCH_MODE 1
#endif
extern "C" void kernel_launch(void* const* d_in, const int* in_sizes, int n_in, void* d_out, int out_size, void* d_ws, size_t ws_size, hipStream_t stream) {
    static int grid = 0;
    if (grid == 0) {
        if (n_in != 39 || out_size != T * D || ws_size < WS_END) { fprintf(stderr, "kernel_launch: unexpected shapes (n_in %d, out %d, ws %zu)\n", n_in, out_size, ws_size); grid = -1; return; }
        int dev = 0, cus = 0, per_cu = 0;
        if (hipGetDevice(&dev) != hipSuccess || hipDeviceGetAttribute(&cus, hipDeviceAttributeMultiprocessorCount, dev) != hipSuccess) { grid = -1; return; }
        if (hipFuncSetAttribute((const void*)hybrid_fwd, hipFuncAttributeMaxDynamicSharedMemorySize, LDS_BYTES) != hipSuccess) { fprintf(stderr, "kernel_launch: hipFuncSetAttribute failed\n"); grid = -1; return; }
        if (hipOccupancyMaxActiveBlocksPerMultiprocessor(&per_cu, (const void*)hybrid_fwd, NT, LDS_BYTES) != hipSuccess || per_cu < 1) fprintf(stderr, "kernel_launch: occupancy query says %d\n", per_cu);
        (void)hipGetLastError();
        grid = cus;
        if (grid != 256) { fprintf(stderr, "kernel_launch: %d CUs; this kernel is built for 256\n", grid); grid = -1; return; }
    }
    if (grid < 0) return;
    Args a{};
    for (int i = 0; i < 39; ++i) a.in[i] = (const float*)d_in[i];
    a.out = (float*)d_out; a.ws = (unsigned char*)d_ws;
#if N_LAUNCH_MODE == 1
    (void)hipMemsetAsync((char*)d_ws + WS_CTL + (size_t)CW_BAR * 4, 0, CTL_ZERO_BYTES, stream);
    a.ph_lo = 0; a.ph_hi = DEPTH * NPH;
    hipLaunchKernelGGL(hybrid_fwd, dim3(grid), dim3(NT), LDS_BYTES, stream, a);
#else
    for (int ph = 0; ph < DEPTH * NPH; ++ph) {
        if (ph == 1 * NPH + 1) continue;
        (void)hipMemsetAsync((char*)d_ws + WS_CTL + (size_t)CW_BAR * 4, 0, CTL_ZERO_BYTES, stream);
        a.ph_lo = ph; a.ph_hi = ph + 1;
        hipLaunchKernelGGL(hybrid_fwd, dim3(grid), dim3(NT), LDS_BYTES, stream, a);
    }
#endif
}
```
